# Optimizing an MI355X kernel written in HIP

```python
import numpy as np
import jax
import jax.numpy as jnp
from jax import lax

D_MODEL = 2048
BATCH = 4
SEQ = 4096
DEPTH = 1

NSA_HEADS = 16
NSA_KV_HEADS = 4
NSA_GROUP = NSA_HEADS // NSA_KV_HEADS
NSA_HEAD_DIM = 64
NSA_Q_WIDTH = NSA_HEADS * NSA_HEAD_DIM
NSA_KV_WIDTH = NSA_KV_HEADS * NSA_HEAD_DIM
CMP_BLOCK = 32
CMP_STRIDE = 16
CMP_HIDDEN = 256
SLC_BLOCK = 64
SLC_TOPN = 16
WINDOW = 512
Q_BLOCK = 64

M_HEADS = 4
M_HEAD_DIM = 256
M_WIDTH = M_HEADS * M_HEAD_DIM
M_CHUNK = 64
CONV_WIDTH = 4

D_FF = 5632

EPS = 1e-6
NEG_INF = -1e30
FORCE_SCORE = 1e4

SPLIT_SIZES = (NSA_Q_WIDTH, 6 * NSA_KV_WIDTH, 3 * NSA_HEADS, 3 * M_WIDTH, M_HEADS, M_HEADS, M_WIDTH, 2 * D_MODEL)
IN_WIDTH = NSA_Q_WIDTH + 6 * NSA_KV_WIDTH + 3 * NSA_HEADS + 3 * M_WIDTH + 2 * M_HEADS + M_WIDTH + 2 * D_MODEL
F_GATE_START = NSA_Q_WIDTH + 6 * NSA_KV_WIDTH + 3 * NSA_HEADS + 3 * M_WIDTH + M_HEADS

kernel_name = "hybrid_nsa_mlstm_macaron_block"


def rms_norm(x, gain):
    x32 = x.astype(jnp.float32)
    y = x32 * lax.rsqrt(jnp.mean(x32 * x32, axis=-1, keepdims=True) + EPS)
    return (y * gain.astype(jnp.float32)).astype(x.dtype)


def swiglu(x, w_gate, w_up, w_down):
    return (jax.nn.silu(x @ w_gate) * (x @ w_up)) @ w_down


def masked_softmax(s, mask):
    s = jnp.where(mask, s.astype(jnp.float32), NEG_INF)
    return jax.nn.softmax(s, axis=-1) * mask


def split_columns(p):
    out, start = [], 0
    for size in SPLIT_SIZES:
        out.append(p[..., start:start + size])
        start += size
    return out


def causal_depthwise_conv(u, w, bias):
    c = u.shape[-1]
    out = lax.conv_general_dilated(u, w[:, None, :].astype(u.dtype), window_strides=(1,),
                                   padding=[(CONV_WIDTH - 1, 0)],
                                   dimension_numbers=("NWC", "WIO", "NWC"),
                                   feature_group_count=c)
    return out + bias


def compress_blocks(kv, pos_emb, w1, w2):
    b, g, s, d = kv.shape
    n_cmp = (s - CMP_BLOCK) // CMP_STRIDE + 1
    idx = np.arange(n_cmp)[:, None] * CMP_STRIDE + np.arange(CMP_BLOCK)[None, :]
    blocks = kv[:, :, idx, :] + pos_emb
    flat = blocks.reshape(b, g, n_cmp, CMP_BLOCK * d)
    return jax.nn.gelu(flat @ w1) @ w2


def nsa_attention(q, k_cmp, v_cmp, k_slc, v_slc, k_win, v_win, gates,
                  q_gain, kc_gain, ks_gain, kw_gain,
                  cmp_pos_k, cmp_w1_k, cmp_w2_k, cmp_pos_v, cmp_w1_v, cmp_w2_v):
    b, g, r, s, d = q.shape
    q = rms_norm(q, q_gain) * (d ** -0.5)
    t = np.arange(s)

    kc = rms_norm(compress_blocks(k_cmp, cmp_pos_k, cmp_w1_k, cmp_w2_k), kc_gain)
    vc = compress_blocks(v_cmp, cmp_pos_v, cmp_w1_v, cmp_w2_v)
    n_cmp = kc.shape[2]
    cmp_start = np.arange(n_cmp) * CMP_STRIDE
    cmp_mask = (cmp_start + CMP_BLOCK - 1)[None, :] <= t[:, None]
    p_cmp = masked_softmax(jnp.einsum("bgrsd,bgcd->bgrsc", q, kc), cmp_mask)
    o_cmp = jnp.einsum("bgrsc,bgcd->bgrsd", p_cmp.astype(vc.dtype), vc)

    n_slc = s // SLC_BLOCK
    blk = np.arange(n_slc)
    blk_start = blk * SLC_BLOCK
    overlap = ((cmp_start[:, None] < (blk_start + SLC_BLOCK)[None, :]) &
               ((cmp_start + CMP_BLOCK)[:, None] > blk_start[None, :])).astype(np.float32)
    imp = jnp.einsum("bgrsc,cn->bgsn", p_cmp, overlap)
    cur = t // SLC_BLOCK
    forced = (blk[None, :] == 0) | (blk[None, :] == cur[:, None]) | (blk[None, :] == cur[:, None] - 1)
    causal_blk = blk_start[None, :] <= t[:, None]
    imp = jnp.where(forced, FORCE_SCORE, jnp.where(causal_blk, imp, -1.0))
    n_sel = min(SLC_TOPN, n_slc)
    _, sel = lax.top_k(imp, n_sel)

    kb = rms_norm(k_slc, ks_gain).reshape(b, g, n_slc, SLC_BLOCK, d)
    vb = v_slc.reshape(b, g, n_slc, SLC_BLOCK, d)
    pad = ((0, 0), (0, 0), (WINDOW, 0), (0, 0))
    kw = jnp.pad(rms_norm(k_win, kw_gain), pad)
    vw = jnp.pad(v_win, pad)
    bi = jnp.arange(b)[:, None, None, None]
    gi = jnp.arange(g)[None, :, None, None]

    def query_block(i):
        s0 = i * Q_BLOCK
        tq = s0 + jnp.arange(Q_BLOCK)
        qi = lax.dynamic_slice_in_dim(q, s0, Q_BLOCK, axis=3)
        idx = lax.dynamic_slice_in_dim(sel, s0, Q_BLOCK, axis=2)
        ks = kb[bi, gi, idx]
        vs = vb[bi, gi, idx]
        kpos = idx[..., None] * SLC_BLOCK + jnp.arange(SLC_BLOCK)
        smask = (kpos <= tq[:, None, None]).reshape(b, g, 1, Q_BLOCK, n_sel * SLC_BLOCK)
        ss = jnp.einsum("bgrqd,bgqnld->bgrqnl", qi, ks).reshape(b, g, r, Q_BLOCK, n_sel * SLC_BLOCK)
        ps = masked_softmax(ss, smask).reshape(b, g, r, Q_BLOCK, n_sel, SLC_BLOCK)
        o_s = jnp.einsum("bgrqnl,bgqnld->bgrqd", ps.astype(vs.dtype), vs)
        kwi = lax.dynamic_slice_in_dim(kw, s0, Q_BLOCK + WINDOW, axis=2)
        vwi = lax.dynamic_slice_in_dim(vw, s0, Q_BLOCK + WINDOW, axis=2)
        wpos = s0 - WINDOW + jnp.arange(Q_BLOCK + WINDOW)
        wmask = ((wpos[None, :] <= tq[:, None]) & (wpos[None, :] > tq[:, None] - WINDOW)
                 & (wpos[None, :] >= 0))
        pw = masked_softmax(jnp.einsum("bgrqd,bgkd->bgrqk", qi, kwi), wmask)
        o_w = jnp.einsum("bgrqk,bgkd->bgrqd", pw.astype(vwi.dtype), vwi)
        return o_s, o_w

    o_slc, o_win = lax.map(query_block, jnp.arange(s // Q_BLOCK))
    o_slc = jnp.moveaxis(o_slc, 0, 3).reshape(b, g, r, s, d)
    o_win = jnp.moveaxis(o_win, 0, 3).reshape(b, g, r, s, d)

    gt = jax.nn.sigmoid(gates.astype(jnp.float32)).astype(q.dtype)
    return gt[..., 0:1] * o_cmp + gt[..., 1:2] * o_slc + gt[..., 2:3] * o_win


def mlstm_chunkwise(q, k, v, i_pre, f_pre):
    b, h, s, d = q.shape
    L = M_CHUNK
    nc = s // L
    q = q.reshape(b, h, nc, L, d)
    k = k.reshape(b, h, nc, L, d) * (d ** -0.5)
    v = v.reshape(b, h, nc, L, d)
    log_f = jax.nn.log_sigmoid(f_pre).reshape(b, h, nc, L)
    log_i = i_pre.reshape(b, h, nc, L)
    a = jnp.cumsum(log_f, axis=-1)
    g = a[..., -1]

    causal = np.tril(np.ones((L, L), dtype=bool))
    log_w = jnp.where(causal, a[..., :, None] - a[..., None, :] + log_i[..., None, :], NEG_INF)
    m_intra = jnp.max(log_w, axis=-1)
    w_intra = jnp.exp(log_w - m_intra[..., None]) * jnp.einsum("bhcjd,bhcsd->bhcjs", q, k)
    num_intra = jnp.einsum("bhcjs,bhcsd->bhcjd", w_intra, v)
    den_intra = jnp.sum(w_intra, axis=-1)

    log_u = g[..., None] - a + log_i

    def step(carry, xs):
        c_st, n_st, m_st = carry
        q_c, k_c, v_c, g_c, lu_c = xs
        num_inter = jnp.einsum("bhjd,bhde->bhje", q_c, c_st)
        den_inter = jnp.einsum("bhjd,bhd->bhj", q_c, n_st)
        m_new = jnp.maximum(g_c + m_st, jnp.max(lu_c, axis=-1))
        decay = jnp.exp(g_c + m_st - m_new)
        u = jnp.exp(lu_c - m_new[..., None])
        uk = u[..., None] * k_c
        c_new = decay[..., None, None] * c_st + jnp.einsum("bhsd,bhse->bhde", uk, v_c)
        n_new = decay[..., None] * n_st + jnp.sum(uk, axis=2)
        return (c_new, n_new, m_new), (num_inter, den_inter, m_st)

    init = (jnp.zeros((b, h, d, d), jnp.float32), jnp.zeros((b, h, d), jnp.float32),
            jnp.zeros((b, h), jnp.float32))
    xs = (jnp.moveaxis(q, 2, 0), jnp.moveaxis(k, 2, 0), jnp.moveaxis(v, 2, 0),
          jnp.moveaxis(g, 2, 0), jnp.moveaxis(log_u, 2, 0))
    _, (num_inter, den_inter, m_prev) = lax.scan(step, init, xs)
    num_inter = jnp.moveaxis(num_inter, 0, 2)
    den_inter = jnp.moveaxis(den_inter, 0, 2)
    m_prev = jnp.moveaxis(m_prev, 0, 2)

    log_inter = a + m_prev[..., None]
    m_comb = jnp.maximum(log_inter, m_intra)
    s_inter = jnp.exp(log_inter - m_comb)
    s_intra = jnp.exp(m_intra - m_comb)
    num = s_inter[..., None] * num_inter + s_intra[..., None] * num_intra
    den = s_inter * den_inter + s_intra * den_intra
    hcell = num / jnp.maximum(jnp.abs(den), jnp.exp(-m_comb))[..., None]
    return hcell.reshape(b, h, s, d)


def setup_inputs(seed: int = 0) -> dict:
    key = jax.random.key(seed)
    ks = jax.random.split(key, 40)
    L = DEPTH

    def nrm(k, shape, scale):
        return jax.random.normal(k, shape, jnp.float32) * scale

    def gain(k, shape):
        return 1.0 + 0.02 * jax.random.normal(k, shape, jnp.float32)

    b_in = nrm(ks[6], (L, IN_WIDTH), 0.02)
    b_in = b_in.at[:, F_GATE_START:F_GATE_START + M_HEADS].add(jnp.linspace(3.0, 6.0, M_HEADS))
    cmp_in = CMP_BLOCK * NSA_HEAD_DIM
    return {
        "x": nrm(ks[0], (BATCH, SEQ, D_MODEL), 1.0),
        "ffn1_norm": gain(ks[1], (L, D_MODEL)),
        "ffn1_w_gate": nrm(ks[2], (L, D_MODEL, D_FF), D_MODEL ** -0.5),
        "ffn1_w_up": nrm(ks[3], (L, D_MODEL, D_FF), D_MODEL ** -0.5),
        "ffn1_w_down": nrm(ks[4], (L, D_FF, D_MODEL), D_FF ** -0.5),
        "mix_norm": gain(ks[5], (L, D_MODEL)),
        "w_in": nrm(ks[7], (L, D_MODEL, IN_WIDTH), D_MODEL ** -0.5),
        "b_in": b_in,
        "nsa_q_gain": gain(ks[8], (L, NSA_HEAD_DIM)),
        "nsa_kc_gain": gain(ks[9], (L, NSA_HEAD_DIM)),
        "nsa_ks_gain": gain(ks[10], (L, NSA_HEAD_DIM)),
        "nsa_kw_gain": gain(ks[11], (L, NSA_HEAD_DIM)),
        "cmp_pos_k": nrm(ks[12], (L, CMP_BLOCK, NSA_HEAD_DIM), 0.1),
        "cmp_w1_k": nrm(ks[13], (L, cmp_in, CMP_HIDDEN), cmp_in ** -0.5),
        "cmp_w2_k": nrm(ks[14], (L, CMP_HIDDEN, NSA_HEAD_DIM), CMP_HIDDEN ** -0.5),
        "cmp_pos_v": nrm(ks[15], (L, CMP_BLOCK, NSA_HEAD_DIM), 0.1),
        "cmp_w1_v": nrm(ks[16], (L, cmp_in, CMP_HIDDEN), cmp_in ** -0.5),
        "cmp_w2_v": nrm(ks[17], (L, CMP_HIDDEN, NSA_HEAD_DIM), CMP_HIDDEN ** -0.5),
        "m_conv_w": nrm(ks[18], (L, CONV_WIDTH, 2 * M_WIDTH), CONV_WIDTH ** -0.5),
        "m_conv_b": nrm(ks[19], (L, 2 * M_WIDTH), 0.02),
        "m_out_gain": gain(ks[20], (L, M_HEADS, M_HEAD_DIM)),
        "w_branch_nsa": nrm(ks[21], (L, NSA_Q_WIDTH, D_MODEL), NSA_Q_WIDTH ** -0.5),
        "w_branch_mlstm": nrm(ks[22], (L, M_WIDTH, D_MODEL), M_WIDTH ** -0.5),
        "w_out": nrm(ks[23], (L, D_MODEL, D_MODEL), D_MODEL ** -0.5),
        "ffn2_norm": gain(ks[24], (L, D_MODEL)),
        "ffn2_w_gate": nrm(ks[25], (L, D_MODEL, D_FF), D_MODEL ** -0.5),
        "ffn2_w_up": nrm(ks[26], (L, D_MODEL, D_FF), D_MODEL ** -0.5),
        "ffn2_w_down": nrm(ks[27], (L, D_FF, D_MODEL), D_FF ** -0.5),
    }


def reference(x, ffn1_norm, ffn1_w_gate, ffn1_w_up, ffn1_w_down, mix_norm, w_in, b_in,
              nsa_q_gain, nsa_kc_gain, nsa_ks_gain, nsa_kw_gain,
              cmp_pos_k, cmp_w1_k, cmp_w2_k, cmp_pos_v, cmp_w1_v, cmp_w2_v,
              m_conv_w, m_conv_b, m_out_gain, w_branch_nsa, w_branch_mlstm, w_out,
              ffn2_norm, ffn2_w_gate, ffn2_w_up, ffn2_w_down):
    b, s, _ = x.shape
    G, R, dh = NSA_KV_HEADS, NSA_GROUP, NSA_HEAD_DIM
    for l in range(DEPTH):
        x = x + 0.5 * swiglu(rms_norm(x, ffn1_norm[l]), ffn1_w_gate[l], ffn1_w_up[l], ffn1_w_down[l])

        hn = rms_norm(x, mix_norm[l])
        proj = hn @ w_in[l] + b_in[l]
        p_q, p_kv, p_g, p_mqkv, p_mi, p_mf, p_mo, p_merge = split_columns(proj)

        q_n = p_q.reshape(b, s, G, R, dh).transpose(0, 2, 3, 1, 4)
        kv_n = p_kv.reshape(b, s, 6, G, dh).transpose(2, 0, 3, 1, 4)
        g_n = p_g.reshape(b, s, G, R, 3).transpose(0, 2, 3, 1, 4)
        o_nsa = nsa_attention(q_n, kv_n[0], kv_n[1], kv_n[2], kv_n[3], kv_n[4], kv_n[5], g_n,
                              nsa_q_gain[l], nsa_kc_gain[l], nsa_ks_gain[l], nsa_kw_gain[l],
                              cmp_pos_k[l], cmp_w1_k[l], cmp_w2_k[l],
                              cmp_pos_v[l], cmp_w1_v[l], cmp_w2_v[l])
        o_nsa = o_nsa.transpose(0, 3, 1, 2, 4).reshape(b, s, NSA_Q_WIDTH)

        qk_m = jax.nn.silu(causal_depthwise_conv(p_mqkv[..., :2 * M_WIDTH], m_conv_w[l], m_conv_b[l]))
        v_m = p_mqkv[..., 2 * M_WIDTH:]

        def heads(u):
            return u.reshape(b, s, M_HEADS, M_HEAD_DIM).transpose(0, 2, 1, 3).astype(jnp.float32)

        hcell = mlstm_chunkwise(heads(qk_m[..., :M_WIDTH]), heads(qk_m[..., M_WIDTH:]), heads(v_m),
                                p_mi.transpose(0, 2, 1).astype(jnp.float32),
                                p_mf.transpose(0, 2, 1).astype(jnp.float32))
        hcell = rms_norm(hcell.transpose(0, 2, 1, 3), m_out_gain[l]).reshape(b, s, M_WIDTH)
        h_m = (jax.nn.sigmoid(p_mo.astype(jnp.float32)) * hcell).astype(x.dtype)

        gates = jax.nn.sigmoid(p_merge.astype(jnp.float32)).astype(x.dtype)
        merged = gates[..., :D_MODEL] * (o_nsa @ w_branch_nsa[l]) + gates[..., D_MODEL:] * (h_m @ w_branch_mlstm[l])
        x = x + merged @ w_out[l]

        x = x + 0.5 * swiglu(rms_norm(x, ffn2_norm[l]), ffn2_w_gate[l], ffn2_w_up[l], ffn2_w_down[l])
    return x
```

```cpp
#include <hip/hip_runtime.h>
#include <hip/hip_cooperative_groups.h>
#include <cstdio>
#include <cstdint>
namespace cg = cooperative_groups;
#define MK_COOP 1
namespace pg8 {
#define PG8_LAS __attribute__((address_space(3)))
typedef unsigned short bf16_t;
typedef short bf16x8 __attribute__((ext_vector_type(8)));
typedef float f32x4 __attribute__((ext_vector_type(4)));
typedef unsigned u32x4 __attribute__((ext_vector_type(4)));
constexpr int BM = 256, BK = 64, HALF = 128, HTB = HALF * BK * 2  , STAGE_BYTES = 8 * HTB, NXCD = 8, WGM = 8;

__host__ __device__ __forceinline__ int lds_byte(int r, int c) { const int st = (r >> 4) * 2 + (c >> 5), rr = r & 15, cc = c & 31, ob = rr * 64 + cc * 2; return st * 1024 + (ob ^ (((ob >> 9) & 1) << 5)); }
__host__ __device__ __forceinline__ void stage_rc(int b, int& R, int& C) { const int st = b / 1024, sb = b % 1024, swz = sb ^ (((sb >> 9) & 1) << 5); R = (st >> 1) * 16 + swz / 64; C = (st & 1) * 32 + (swz % 64) / 2; }
__host__ __device__ __forceinline__ int perm32(int rho) { const int n = rho >> 4, i = rho & 15; return 8 * (i >> 2) + 4 * n + (i & 3); }

struct Unit { int pm, pn; };
struct Gemm { const bf16_t* A; const bf16_t* Bt; int M, N, K; };

struct StaticOrder {
    int nM, nN, nwg, G, c;
    __host__ __device__ void init(int M, int N, int G_, int c_) { nM = M / BM; nN = N / BM; nwg = nM * nN; G = G_; c = c_; }
    __host__ __device__ bool next(int i, Unit& u) const {
        const long L = (long)i * G + c; if (L >= nwg) return false;
        int wgid = (int)L; { const int q = nwg / NXCD, r = nwg % NXCD, xcd = wgid % NXCD, off = wgid / NXCD; wgid = (xcd < r ? xcd * (q + 1) : r * (q + 1) + (xcd - r) * q) + off; }
        const int nig = WGM * nN, gid = wgid / nig, fm = gid * WGM, gsz = (nM - fm) < WGM ? (nM - fm) : WGM;
        u.pm = fm + ((wgid % nig) % gsz); u.pn = (wgid % nig) / gsz; return true;
    }
    __device__ __forceinline__ void a_ready(const Unit&) const {}
    __device__ __forceinline__ void done(const Unit&) const {}
};

__device__ __forceinline__ unsigned cvt_pk_bf16(float lo, float hi) { unsigned r; asm volatile("v_cvt_pk_bf16_f32 %0, %1, %2" : "=v"(r) : "v"(lo), "v"(hi)); return r; }
typedef float f32x2 __attribute__((ext_vector_type(2)));
__device__ __forceinline__ float sigm(float x) { return 1.f / (1.f + __expf(-x)); }
__device__ __forceinline__ float gelu_tanh(float x) { const float u = 1.5957691216f * (x + 0.044715f * x * x * x); return x - x / (__expf(u) + 1.f); }
template <int MODE> struct EpiP {
    static constexpr bool PERM = true, AFTER_DRAIN = false;
    bf16_t* O; int ldc; const float* bias; const bf16_t* G; int ldg; float* SMo;
    __device__ __forceinline__ void operator()(const f32x4 (&acc)[2][2][4][2], const Unit& u, int wr, int wc, int fr, int fq) const {
        const int row0 = u.pm * BM + wr * 64 + fr;
        if constexpr (MODE == 0) {
            const int col = u.pn * 128 + wc * 32 + 8 * fq;
#pragma unroll
            for (int ai = 0; ai < 2; ++ai)
#pragma unroll
                for (int m = 0; m < 4; ++m) {
                    const int row = row0 + ai * HALF + m * 16; float o[8];
#pragma unroll
                    for (int n = 0; n < 2; ++n)
#pragma unroll
                        for (int i = 0; i < 4; ++i) { const float g = acc[ai][0][m][n][i], uu = acc[ai][1][m][n][i]; o[4 * n + i] = g * sigm(g) * uu; }
                    u32x4 w; w.x = cvt_pk_bf16(o[0], o[1]); w.y = cvt_pk_bf16(o[2], o[3]); w.z = cvt_pk_bf16(o[4], o[5]); w.w = cvt_pk_bf16(o[6], o[7]);
                    *(u32x4*)(O + (size_t)row * ldc + col) = w;
                }
        } else {
#pragma unroll
            for (int bj = 0; bj < 2; ++bj) {
                const int col = u.pn * BM + bj * HALF + wc * 32 + 8 * fq;
                f32x4 b0 = (f32x4){0.f, 0.f, 0.f, 0.f}, b1 = b0;
                if constexpr (MODE == 1 || MODE == 2) { b0 = *(const f32x4*)(bias + col); b1 = *(const f32x4*)(bias + col + 4); }
#pragma unroll
                for (int ai = 0; ai < 2; ++ai)
#pragma unroll
                    for (int m = 0; m < 4; ++m) {
                        const int row = row0 + ai * HALF + m * 16;
                        f32x4 v0 = acc[ai][bj][m][0] + b0, v1 = acc[ai][bj][m][1] + b1;
                        if constexpr (MODE == 1) {
                            if (SMo != nullptr && u.pn == 26 && bj == 0 && wc < 2) { float* sp = SMo + (size_t)row * 64 + wc * 32 + 8 * fq; *(f32x4*)sp = v0; *(f32x4*)(sp + 4) = v1; }
                        }
                        if constexpr (MODE == 2) {
#pragma unroll
                            for (int i = 0; i < 4; ++i) { v0[i] = sigm(v0[i]); v1[i] = sigm(v1[i]); }
                        }
                        if constexpr (MODE == 3) {
#pragma unroll
                            for (int i = 0; i < 4; ++i) { v0[i] = gelu_tanh(v0[i]); v1[i] = gelu_tanh(v1[i]); }
                        }
                        if constexpr (MODE == 4 || MODE == 5) {
                            const u32x4 gw = *(const u32x4*)(G + (size_t)row * ldg + (MODE == 5 ? 2048 : 0) + col);
                            const float g0 = __uint_as_float(gw.x << 16), g1 = __uint_as_float(gw.x & 0xffff0000u), g2 = __uint_as_float(gw.y << 16), g3 = __uint_as_float(gw.y & 0xffff0000u);
                            const float g4 = __uint_as_float(gw.z << 16), g5 = __uint_as_float(gw.z & 0xffff0000u), g6 = __uint_as_float(gw.w << 16), g7 = __uint_as_float(gw.w & 0xffff0000u);
                            v0 = v0 * (f32x4){g0, g1, g2, g3}; v1 = v1 * (f32x4){g4, g5, g6, g7};
                            if constexpr (MODE == 5) {
                                const u32x4 ow = *(const u32x4*)(O + (size_t)row * ldc + col);
                                v0 = v0 + (f32x4){__uint_as_float(ow.x << 16), __uint_as_float(ow.x & 0xffff0000u), __uint_as_float(ow.y << 16), __uint_as_float(ow.y & 0xffff0000u)};
                                v1 = v1 + (f32x4){__uint_as_float(ow.z << 16), __uint_as_float(ow.z & 0xffff0000u), __uint_as_float(ow.w << 16), __uint_as_float(ow.w & 0xffff0000u)};
                            }
                        }
                        u32x4 w; w.x = cvt_pk_bf16(v0[0], v0[1]); w.y = cvt_pk_bf16(v0[2], v0[3]); w.z = cvt_pk_bf16(v1[0], v1[1]); w.w = cvt_pk_bf16(v1[2], v1[3]);
                        *(u32x4*)(O + (size_t)row * ldc + col) = w;
                    }
            }
        }
    }
};
struct EpiResid {
    static constexpr bool PERM = false, AFTER_DRAIN = false;
    const float* res; float* out; int ldc; float scale;
    __device__ __forceinline__ void operator()(const f32x4 (&acc)[2][2][4][2], const Unit& u, int wr, int wc, int fr, int fq) const {
        const int row0 = u.pm * BM + wr * 64 + fr, col0 = u.pn * BM + wc * 32 + 4 * fq;
#pragma unroll
        for (int ai = 0; ai < 2; ++ai)
#pragma unroll
            for (int m = 0; m < 4; ++m) { const size_t off = (size_t)(row0 + ai * HALF + m * 16) * ldc + col0;
#pragma unroll
                for (int bj = 0; bj < 2; ++bj)
#pragma unroll
                    for (int n = 0; n < 2; ++n) { const f32x4 r = *(const f32x4*)(res + off + bj * HALF + n * 16); *(f32x4*)(out + off + bj * HALF + n * 16) = r + acc[ai][bj][m][n] * scale; } }
    }
};
template <class Epi, class Sched, bool ALIGN_EPI = false, bool SP2 = false>
__device__ __forceinline__ void gemm_phase(PG8_LAS unsigned char* lds, const Gemm g, const Sched& S, const Epi& E) {
    const int tid = threadIdx.x, wid = __builtin_amdgcn_readfirstlane(tid >> 6), lane = tid & 63, wr = wid >> 2, wc = wid & 3, fr = lane & 15, fq = lane >> 4;
    const int K = g.K, nt = K / BK;
    unsigned voffA[2], voffB[2];
#pragma unroll
    for (int i = 0; i < 2; ++i) { int R, C; stage_rc(tid * 16 + i * 8192, R, C); const int Rb = Epi::PERM ? ((R & ~31) + perm32(R & 31)) : R;
        voffA[i] = (unsigned)(R * K + C) * 2u; voffB[i] = (unsigned)(Rb * K + C) * 2u; }
    const size_t kstep = (size_t)(BK * 2);
    const size_t hstep = (size_t)HALF * K * 2;
    const size_t tstep = 2 * hstep;
    const unsigned ldsw = (unsigned)wid * 1024u;
    const int aoff = lds_byte(wr * 64 + fr, fq * 8), boff = lds_byte(wc * 32 + fr, fq * 8);
#define PG8_SA(b, h) (((b) * 2 + (h)) * HTB)
#define PG8_SB(b, h) ((4 + (b) * 2 + (h)) * HTB)
#define PG8_STAGE(bufoff, gbase, voff) do { _Pragma("unroll") for (int _i = 0; _i < 2; ++_i) \
        __builtin_amdgcn_global_load_lds((const unsigned*)((const char*)(gbase) + (voff)[_i]), (PG8_LAS unsigned*)(lds + (bufoff) + ldsw + _i * 8192), 16, 0, 0); } while (0)
#define PG8_LDA(dst, b, h) do { _Pragma("unroll") for (int m = 0; m < 4; ++m) _Pragma("unroll") for (int k = 0; k < 2; ++k) dst[m][k] = *(const PG8_LAS bf16x8*)(lds + PG8_SA(b, h) + aoff + m * 2048 + k * 1024); } while (0)
#define PG8_LDB(dst, b, h) do { _Pragma("unroll") for (int n = 0; n < 2; ++n) _Pragma("unroll") for (int k = 0; k < 2; ++k) dst[n][k] = *(const PG8_LAS bf16x8*)(lds + PG8_SB(b, h) + boff + n * 2048 + k * 1024); } while (0)
#define PG8_MMA(ai, bj, At, Bt) do { __builtin_amdgcn_s_setprio(1); _Pragma("unroll") for (int m = 0; m < 4; ++m) _Pragma("unroll") for (int n = 0; n < 2; ++n) _Pragma("unroll") for (int k = 0; k < 2; ++k) \
        acc[ai][bj][m][n] = __builtin_amdgcn_mfma_f32_16x16x32_bf16(Bt[n][k], At[m][k], acc[ai][bj][m][n], 0, 0, 0); __builtin_amdgcn_s_setprio(0); } while (0)
#define PG8_WAIT_V(n) asm volatile("s_waitcnt vmcnt(" #n ")" ::: "memory")
#define PG8_WAIT_L(n) asm volatile("s_waitcnt lgkmcnt(" #n ")" ::: "memory")
#define PG8_BAR __builtin_amdgcn_s_barrier()
#define PG8_SCHED __builtin_amdgcn_sched_barrier(0)
    Unit cur, nxt; int ui = 0;
    if (!S.next(0, cur)) return;
    f32x4 acc[2][2][4][2];
#pragma unroll
    for (int a = 0; a < 2; ++a)
#pragma unroll
        for (int b = 0; b < 2; ++b)
#pragma unroll
            for (int m = 0; m < 4; ++m)
#pragma unroll
                for (int n = 0; n < 2; ++n) acc[a][b][m][n] = (f32x4){0.f, 0.f, 0.f, 0.f};
    bf16x8 At[4][2], B0[2][2], B1[2][2];
    const char* cA = (const char*)g.A + (size_t)cur.pm * tstep; const char* cB = (const char*)g.Bt + (size_t)cur.pn * tstep;
    S.a_ready(cur);
    if constexpr (SP2) {
        PG8_STAGE(PG8_SB(0, 0), cB, voffB); PG8_STAGE(PG8_SB(0, 1), cB + hstep, voffB); PG8_STAGE(PG8_SA(0, 0), cA, voffA); PG8_STAGE(PG8_SA(0, 1), cA + hstep, voffA);
        if (wr == 1) PG8_BAR;
        PG8_WAIT_V(2); PG8_BAR;
        PG8_STAGE(PG8_SB(1, 0), cB + kstep, voffB); PG8_STAGE(PG8_SA(1, 0), cA + kstep, voffA); PG8_STAGE(PG8_SB(1, 1), cB + hstep + kstep, voffB);
        PG8_WAIT_V(6); PG8_BAR;
    } else {
        PG8_STAGE(PG8_SB(0, 0), cB, voffB); PG8_STAGE(PG8_SA(0, 0), cA, voffA); PG8_STAGE(PG8_SB(0, 1), cB + hstep, voffB); PG8_STAGE(PG8_SA(0, 1), cA + hstep, voffA);
        if (wr == 1) PG8_BAR;
        PG8_WAIT_V(4); PG8_BAR;
        PG8_STAGE(PG8_SB(1, 0), cB + kstep, voffB); PG8_STAGE(PG8_SA(1, 0), cA + kstep, voffA); PG8_STAGE(PG8_SB(1, 1), cB + hstep + kstep, voffB);
        PG8_WAIT_V(6); PG8_BAR;
    }
    for (;;) {
        const bool has_next = S.next(ui + 1, nxt);
        const char* nA = has_next ? (const char*)g.A + (size_t)nxt.pm * tstep : cA; const char* nB = has_next ? (const char*)g.Bt + (size_t)nxt.pn * tstep : cB;
        for (int t = 0; t < nt; t += 2) {
            const bool last = (t == nt - 2);
            const char* a1 = cA + (size_t)(t + 1) * kstep;
            const char* a2 = last ? nA : cA + (size_t)(t + 2) * kstep; const char* b2 = last ? nB : cB + (size_t)(t + 2) * kstep;
            const char* a3 = a2 + kstep; const char* b3 = b2 + kstep;
            if (last && has_next) S.a_ready(nxt);
            if constexpr (SP2) {
            PG8_LDB(B0, 0, 0); PG8_LDB(B1, 0, 1); PG8_SCHED; PG8_LDA(At, 0, 0); PG8_STAGE(PG8_SA(1, 1), a1 + hstep, voffA);
            PG8_WAIT_V(8); PG8_WAIT_L(0); PG8_BAR; PG8_MMA(0, 0, At, B0); PG8_MMA(0, 1, At, B1); PG8_BAR; PG8_SCHED;
            PG8_LDA(At, 0, 1); PG8_STAGE(PG8_SB(0, 0), b2, voffB); PG8_STAGE(PG8_SB(0, 1), b2 + hstep, voffB); PG8_STAGE(PG8_SA(0, 0), a2, voffA);
            PG8_WAIT_V(8); PG8_WAIT_L(0); PG8_BAR; PG8_MMA(1, 0, At, B0); PG8_MMA(1, 1, At, B1); PG8_BAR; PG8_SCHED;
            PG8_LDB(B0, 1, 0); PG8_LDB(B1, 1, 1); PG8_SCHED; PG8_LDA(At, 1, 0); PG8_STAGE(PG8_SA(0, 1), a2 + hstep, voffA);
            PG8_WAIT_V(8); PG8_WAIT_L(0); PG8_BAR; PG8_MMA(0, 0, At, B0); PG8_MMA(0, 1, At, B1); PG8_BAR; PG8_SCHED;
            PG8_LDA(At, 1, 1); PG8_STAGE(PG8_SB(1, 0), b3, voffB); PG8_STAGE(PG8_SB(1, 1), b3 + hstep, voffB); PG8_STAGE(PG8_SA(1, 0), a3, voffA);
            PG8_WAIT_V(8); PG8_WAIT_L(0); PG8_BAR; PG8_MMA(1, 0, At, B0); PG8_MMA(1, 1, At, B1); PG8_BAR; PG8_SCHED;
            } else {
            PG8_LDB(B0, 0, 0); PG8_SCHED; PG8_LDA(At, 0, 0); PG8_STAGE(PG8_SA(1, 1), a1 + hstep, voffA);
            PG8_WAIT_L(8); PG8_BAR; PG8_WAIT_L(0); PG8_MMA(0, 0, At, B0); PG8_BAR; PG8_SCHED;
            PG8_LDB(B1, 0, 1); PG8_STAGE(PG8_SB(0, 0), b2, voffB);
            PG8_BAR; PG8_WAIT_L(0); PG8_MMA(0, 1, At, B1); PG8_BAR;
            PG8_LDA(At, 0, 1); PG8_STAGE(PG8_SA(0, 0), a2, voffA);
            PG8_BAR; PG8_WAIT_L(0); PG8_MMA(1, 0, At, B0); PG8_BAR; PG8_SCHED;
            PG8_STAGE(PG8_SB(0, 1), b2 + hstep, voffB);
            PG8_WAIT_V(6); PG8_BAR; PG8_MMA(1, 1, At, B1); PG8_BAR;
            PG8_LDB(B0, 1, 0); PG8_SCHED; PG8_LDA(At, 1, 0); PG8_STAGE(PG8_SA(0, 1), a2 + hstep, voffA);
            PG8_WAIT_L(8); PG8_BAR; PG8_WAIT_L(0); PG8_MMA(0, 0, At, B0); PG8_BAR; PG8_SCHED;
            PG8_LDB(B1, 1, 1); PG8_STAGE(PG8_SB(1, 0), b3, voffB);
            PG8_BAR; PG8_WAIT_L(0); PG8_MMA(0, 1, At, B1); PG8_BAR;
            PG8_LDA(At, 1, 1); PG8_STAGE(PG8_SA(1, 0), a3, voffA);
            PG8_BAR; PG8_WAIT_L(0); PG8_MMA(1, 0, At, B0); PG8_BAR; PG8_SCHED;
            PG8_STAGE(PG8_SB(1, 1), b3 + hstep, voffB);
            PG8_WAIT_V(6); PG8_BAR; PG8_MMA(1, 1, At, B1); PG8_BAR;
            }
        }
        if constexpr (ALIGN_EPI) { if (wr == 0) PG8_BAR; }
        if constexpr (!Epi::AFTER_DRAIN) { E(acc, cur, wr, wc, fr, fq); S.done(cur); }
        if (!has_next) break;
#pragma unroll
        for (int a = 0; a < 2; ++a)
#pragma unroll
            for (int b = 0; b < 2; ++b)
#pragma unroll
                for (int m = 0; m < 4; ++m)
#pragma unroll
                    for (int n = 0; n < 2; ++n) acc[a][b][m][n] = (f32x4){0.f, 0.f, 0.f, 0.f};
        cur = nxt; cA = nA; cB = nB; ++ui;
        if constexpr (ALIGN_EPI) { if (wr == 1) PG8_BAR; }
    }
    PG8_WAIT_V(0);
    if constexpr (!ALIGN_EPI) { if (wr == 0) PG8_BAR; }
    PG8_BAR;
    if constexpr (Epi::AFTER_DRAIN) { E.fused(acc, cur, wr, wc, fr, fq, lds, wid, lane); S.done(cur); }
#undef PG8_SA
#undef PG8_SB
#undef PG8_STAGE
#undef PG8_LDA
#undef PG8_LDB
#undef PG8_MMA
#undef PG8_WAIT_V
#undef PG8_WAIT_L
#undef PG8_BAR
#undef PG8_SCHED
}
}
#define LAS __attribute__((address_space(3)))
typedef unsigned short bf16;
typedef unsigned v4u __attribute__((ext_vector_type(4)));
typedef unsigned v2u __attribute__((ext_vector_type(2)));
typedef float f32x4 __attribute__((ext_vector_type(4)));
typedef float f32x2 __attribute__((ext_vector_type(2)));
#define WSYNC() asm volatile("s_waitcnt lgkmcnt(0)" ::: "memory")

constexpr int NT = 512, NWV = 8;
constexpr int TOK = 16384, SEQ = 4096, DM = 2048, FF = 5632, NA = 6912, NB = 4096, INW = 10808;
constexpr int PA_Q = 0, PA_KV = 1024, PA_MQ = 2560, PA_MK = 3584, PA_MV = 4608, PA_MO = 5632, PA_SM = 6656;
constexpr float EPS = 1e-6f;
constexpr size_t MiB = 1u << 20;
constexpr size_t O_BIASA = 64 * 1024, O_BIASB = 128 * 1024, O_GG = 192 * 1024, O_GMX = 200 * 1024, O_DENI = 256 * 1024;
constexpr size_t O_WGU = 1 * MiB, O_WD = 45 * MiB, O_WINA = 67 * MiB, O_WINB = 94 * MiB, O_WBN = 110 * MiB, O_WBM = 114 * MiB, O_WOUT = 118 * MiB, O_WC1K = 126 * MiB, O_WC1V = 127 * MiB;
constexpr size_t O_MQK = 1 * MiB, O_HM = 1 * MiB;
constexpr size_t O_XN = 128 * MiB, O_PA = 192 * MiB, O_H = 192 * MiB, O_MG = 192 * MiB;
constexpr size_t O_ONSA = 408 * MiB, O_WT = 408 * MiB, O_HC = 440 * MiB, O_CBK = 440 * MiB, O_CBV = 456 * MiB, O_CHK = 424 * MiB, O_CHV = 426 * MiB;
constexpr size_t O_SM = 504 * MiB, O_KC = 508 * MiB, O_VC = 509 * MiB, O_SEL = 510 * MiB, O_GA = 510 * MiB + 512 * 1024, O_GLA = 510 * MiB + 768 * 1024, O_GPM = 511 * MiB;
constexpr size_t WS_NEED = 512 * MiB;
constexpr int LDS_BYTES = 147456;

struct Params { const float* in[28]; float* out; unsigned char* ws; int ph_lo, ph_hi; };

__device__ __forceinline__ float bf2f(unsigned short b) { return __uint_as_float(((unsigned)b) << 16); }
__device__ __forceinline__ unsigned f2bf(float f) { unsigned u = __builtin_bit_cast(unsigned, f); return (u + 0x7fffu + ((u >> 16) & 1u)) >> 16; }
__device__ __forceinline__ unsigned pk2(float lo, float hi) { return f2bf(lo) | (f2bf(hi) << 16); }
__device__ __forceinline__ float lo16(unsigned w) { return __uint_as_float(w << 16); }
__device__ __forceinline__ float hi16(unsigned w) { return __uint_as_float(w & 0xffff0000u); }
__device__ __forceinline__ float wave_sum(float v) {
#pragma unroll
    for (int o = 1; o < 64; o <<= 1) v += __shfl_xor(v, o);
    return v;
}
__device__ __forceinline__ float wave_max(float v) {
#pragma unroll
    for (int o = 1; o < 64; o <<= 1) v = fmaxf(v, __shfl_xor(v, o));
    return v;
}
__device__ __forceinline__ float sigmf(float x) { return 1.f / (1.f + __expf(-x)); }

__device__ __forceinline__ void tr_item(const float* W, int ldw, int K, int srccol  , bf16* WT, int outrow0, const float* kscale, float* scr, int k0, int lane) {
#pragma unroll 8
    for (int i = 0; i < 32; ++i) { const int kk = 2 * i + (lane >> 5); float v = 0.f; if (srccol >= 0) v = W[(size_t)(k0 + kk) * ldw + srccol]; if (kscale) v *= kscale[k0 + kk]; scr[kk * 33 + (lane & 31)] = v; }
    WSYNC();
    const int c = lane & 7;
#pragma unroll
    for (int j = 0; j < 4; ++j) { const int n = (lane >> 3) + 8 * j; const float* s = scr + (8 * c) * 33 + n;
        v4u o; o.x = pk2(s[0 * 33], s[1 * 33]); o.y = pk2(s[2 * 33], s[3 * 33]); o.z = pk2(s[4 * 33], s[5 * 33]); o.w = pk2(s[6 * 33], s[7 * 33]);
        *(v4u*)(WT + (size_t)(outrow0 + n) * K + k0 + 8 * c) = o; }
    WSYNC();
}
__device__ __forceinline__ void tr_plain(const float* W, int K, int N, bf16* WT, const float* kscale, float* scr, int item, int lane) {
    const int nblk = N / 32, kb = item / nblk, nb = item % nblk;
    tr_item(W, N, K, nb * 32 + (lane & 31), WT, nb * 32, kscale, scr, kb * 64, lane);
}
__device__ __forceinline__ void tr_gu(const float* Wg, const float* Wu, bf16* WT, const float* kscale, float* scr, int item, int lane) {
    const int nblk = (2 * FF) / 32, kb = item / nblk, nb = item % nblk, n0 = nb * 32, pn = n0 >> 8, within = n0 & 255;
    const float* W = (within >= 128) ? Wu : Wg;
    tr_item(W, FF, DM, pn * 128 + (within & 127) + (lane & 31), WT, n0, kscale, scr, kb * 64, lane);
}
__device__ __forceinline__ int ina_src(int n) {
    if (n < 2560) return n;
    if (n < 5632) return n + 48;
    if (n < 6656) return 5688 + (n - 5632);
    if (n < 6704) return 2560 + (n - 6656);
    if (n < 6708) return 5680 + (n - 6704);
    if (n < 6712) return 5684 + (n - 6708);
    return -1;
}
__device__ __forceinline__ void norm_row(const float* xrow, bf16* orow, int lane) {
    const f32x4* xr = (const f32x4*)xrow + lane; f32x4 v[8]; float s = 0.f;
#pragma unroll
    for (int j = 0; j < 8; ++j) { v[j] = xr[64 * j]; s += (v[j].x * v[j].x + v[j].y * v[j].y) + (v[j].z * v[j].z + v[j].w * v[j].w); }
    const float rstd = rsqrtf(wave_sum(s) * (1.f / DM) + EPS);
    v2u* o8 = (v2u*)orow + lane;
#pragma unroll
    for (int j = 0; j < 8; ++j) { v2u w; w.x = pk2(v[j].x * rstd, v[j].y * rstd); w.y = pk2(v[j].z * rstd, v[j].w * rstd); o8[64 * j] = w; }
}

__device__ __forceinline__ void phase_prologue(const Params& P, unsigned char* lds, int gw, int ngw, int wave, int lane, int tid) {
    unsigned char* ws = P.ws; float* scr = (float*)(lds + wave * 16384);
    constexpr int I_GU = 32 * 352, I_D = 88 * 64, I_A = 32 * 216, I_B = 32 * 128, I_BN = 16 * 64, I_O = 32 * 64, I_C = 32 * 8;
    constexpr int NITEMS = I_GU + I_D + I_A + I_B + 2 * I_BN + I_O + 2 * I_C;
    for (int it = gw; it < NITEMS; it += ngw) {
        int r = it;
        if (r < I_GU) { tr_gu(P.in[2], P.in[3], (bf16*)(ws + O_WGU), P.in[1], scr, r, lane); continue; } r -= I_GU;
        if (r < I_D) { tr_plain(P.in[4], FF, DM, (bf16*)(ws + O_WD), nullptr, scr, r, lane); continue; } r -= I_D;
        if (r < I_A) { const int nblk = NA / 32, kb = r / nblk, nb = r % nblk; tr_item(P.in[6], INW, DM, ina_src(nb * 32 + (lane & 31)), (bf16*)(ws + O_WINA), nb * 32, P.in[5], scr, kb * 64, lane); continue; } r -= I_A;
        if (r < I_B) { const int nblk = NB / 32, kb = r / nblk, nb = r % nblk; tr_item(P.in[6], INW, DM, 6712 + nb * 32 + (lane & 31), (bf16*)(ws + O_WINB), nb * 32, P.in[5], scr, kb * 64, lane); continue; } r -= I_B;
        if (r < I_BN) { tr_plain(P.in[21], 1024, DM, (bf16*)(ws + O_WBN), nullptr, scr, r, lane); continue; } r -= I_BN;
        if (r < I_BN) { tr_plain(P.in[22], 1024, DM, (bf16*)(ws + O_WBM), P.in[20], scr, r, lane); continue; } r -= I_BN;
        if (r < I_O) { tr_plain(P.in[23], DM, DM, (bf16*)(ws + O_WOUT), nullptr, scr, r, lane); continue; } r -= I_O;
        if (r < I_C) { tr_plain(P.in[13], 2048, 256, (bf16*)(ws + O_WC1K), nullptr, scr, r, lane); continue; } r -= I_C;
        tr_plain(P.in[16], 2048, 256, (bf16*)(ws + O_WC1V), nullptr, scr, r, lane);
    }
    { const int gt = gw * 64 + lane, ngt = ngw * 64; float* ba = (float*)(ws + O_BIASA); float* bb = (float*)(ws + O_BIASB);
      for (int n = gt; n < NA; n += ngt) { const int s = ina_src(n); ba[n] = s >= 0 ? P.in[7][s] : 0.f; }
      for (int n = gt; n < NB; n += ngt) bb[n] = P.in[7][6712 + n]; }
    for (int m = gw; m < TOK; m += ngw) norm_row(P.in[0] + (size_t)m * DM, (bf16*)(ws + O_XN) + (size_t)m * DM, lane);
}
__device__ __forceinline__ void phase_norm(const float* src, bf16* dst, int gw, int ngw, int lane) {
    for (int m = gw; m < TOK; m += ngw) norm_row(src + (size_t)m * DM, dst + (size_t)m * DM, lane);
}
__device__ __forceinline__ void phase_conv_ffn2(const Params& P, unsigned char* lds, int gw, int ngw, int wave, int lane) {
    float* scr = (float*)(lds + wave * 16384);
    constexpr int I_GU = 32 * 352, I_D = 88 * 64;
    for (int it = gw; it < I_GU + I_D; it += ngw) {
        if (it < I_GU) tr_gu(P.in[25], P.in[26], (bf16*)(P.ws + O_WGU), P.in[24], scr, it, lane);
        else tr_plain(P.in[27], FF, DM, (bf16*)(P.ws + O_WD), nullptr, scr, it - I_GU, lane);
    }
}

__device__ __forceinline__ void phase_prep(const Params& P, int gw, int ngw, int lane) {
    unsigned char* ws = P.ws; bf16* PA = (bf16*)(ws + O_PA);
    { const float qg = P.in[8][lane] * 0.125f, ksg = P.in[10][lane], kwg = P.in[11][lane];
      for (int m = gw; m < TOK; m += ngw) { bf16* pr = PA + (size_t)m * NA;
#pragma unroll 4
        for (int v = 0; v < 24; ++v) { const int col = (v < 16) ? (PA_Q + v * 64) : (v < 20 ? (PA_KV + 2 * 256 + (v - 16) * 64) : (PA_KV + 4 * 256 + (v - 20) * 64));
            const float gn = (v < 16) ? qg : (v < 20 ? ksg : kwg);
            const float x = bf2f(pr[col + lane]); const float ss = wave_sum(x * x); pr[col + lane] = (bf16)f2bf(x * rsqrtf(ss * (1.f / 64.f) + EPS) * gn); } } }
    { const size_t gt = (size_t)gw * 64 + lane, ngt = (size_t)ngw * 64; bf16* CBK = (bf16*)(ws + O_CBK); bf16* CBV = (bf16*)(ws + O_CBV);
      for (size_t idx = gt; idx < (size_t)4096 * 256; idx += ngt) { const int r = (int)(idx >> 8), k8 = (int)(idx & 255) * 8, l = k8 >> 6, d = k8 & 63;
        v4u ok = (v4u){0u, 0u, 0u, 0u}, ov = ok;
        if (r < 4080) { const int bg = r / 255, c = r % 255, b = bg >> 2, g = bg & 3; const bf16* src = PA + ((size_t)b * SEQ + 16 * c + l) * NA + PA_KV + g * 64 + d;
            const v4u kw = *(const v4u*)src, vw = *(const v4u*)(src + 256); const float* pk = P.in[12] + l * 64 + d; const float* pv = P.in[15] + l * 64 + d;
            ok.x = pk2(lo16(kw.x) + pk[0], hi16(kw.x) + pk[1]); ok.y = pk2(lo16(kw.y) + pk[2], hi16(kw.y) + pk[3]); ok.z = pk2(lo16(kw.z) + pk[4], hi16(kw.z) + pk[5]); ok.w = pk2(lo16(kw.w) + pk[6], hi16(kw.w) + pk[7]);
            ov.x = pk2(lo16(vw.x) + pv[0], hi16(vw.x) + pv[1]); ov.y = pk2(lo16(vw.y) + pv[2], hi16(vw.y) + pv[3]); ov.z = pk2(lo16(vw.z) + pv[4], hi16(vw.z) + pv[5]); ov.w = pk2(lo16(vw.w) + pv[6], hi16(vw.w) + pv[7]); }
        *(v4u*)(CBK + (size_t)r * 2048 + k8) = ok; *(v4u*)(CBV + (size_t)r * 2048 + k8) = ov; } }
    { const size_t gt = (size_t)gw * 64 + lane, ngt = (size_t)ngw * 64; bf16* MQK = (bf16*)(ws + O_MQK); const float* cw = P.in[18]; const float* cb = P.in[19];
      for (size_t idx = gt; idx < (size_t)TOK * 256; idx += ngt) { const int m = (int)(idx >> 8), c8 = (int)(idx & 255) * 8, t = m & (SEQ - 1);
        float a[8];
#pragma unroll
        for (int i = 0; i < 8; ++i) a[i] = cb[c8 + i];
#pragma unroll
        for (int j = 0; j < 4; ++j) { const int tt = t - 3 + j; if (tt >= 0) { const v4u w = *(const v4u*)(PA + (size_t)(m - 3 + j) * NA + PA_MQ + c8); const float* wj = cw + j * 2048 + c8;
            a[0] += wj[0] * lo16(w.x); a[1] += wj[1] * hi16(w.x); a[2] += wj[2] * lo16(w.y); a[3] += wj[3] * hi16(w.y); a[4] += wj[4] * lo16(w.z); a[5] += wj[5] * hi16(w.z); a[6] += wj[6] * lo16(w.w); a[7] += wj[7] * hi16(w.w); } }
#pragma unroll
        for (int i = 0; i < 8; ++i) a[i] = a[i] * sigmf(a[i]);
        v4u o; o.x = pk2(a[0], a[1]); o.y = pk2(a[2], a[3]); o.z = pk2(a[4], a[5]); o.w = pk2(a[6], a[7]);
        *(v4u*)(MQK + (size_t)m * 2048 + c8) = o; } }
    { const float* SM = (const float*)(ws + O_SM); float* GA = (float*)(ws + O_GA); float* GLA = (float*)(ws + O_GLA); float* GPM = (float*)(ws + O_GPM); float* GG = (float*)(ws + O_GG); float* GMX = (float*)(ws + O_GMX);
      for (int it = gw; it < 1024; it += ngw) { const int bh = it >> 6, c = it & 63, b = bh >> 2, h = bh & 3; const size_t m = (size_t)b * SEQ + 64 * c + lane;
        const float ip = SM[m * 64 + 48 + h], fp = SM[m * 64 + 52 + h];
        const float lf = fminf(fp, 0.f) - log1pf(__expf(-fabsf(fp)));
        float a = lf;
#pragma unroll
        for (int o = 1; o < 64; o <<= 1) { const float y = __shfl_up(a, o); if (lane >= o) a += y; }
        const float g = __shfl(a, 63); const float la = ip - a; const float mx = wave_max(g + la);
        float pm = la;
#pragma unroll
        for (int o = 1; o < 64; o <<= 1) { const float y = __shfl_up(pm, o); if (lane >= o) pm = fmaxf(pm, y); }
        const size_t o1 = (size_t)bh * SEQ + 64 * c + lane; GA[o1] = a; GLA[o1] = la; GPM[o1] = a + pm;
        if (lane == 0) { GG[it] = g; GMX[it] = mx; } } }
}

__device__ __forceinline__ void phase_cmp2(const Params& P, int gw, int ngw, int lane) {
    unsigned char* ws = P.ws;
    for (int it = gw; it < 2 * 4080; it += ngw) { const int kv = it / 4080, r = it % 4080; const bf16* ch = (const bf16*)(ws + (kv ? O_CHV : O_CHK)) + (size_t)r * 256; const float* w2 = P.in[kv ? 17 : 14];
        float acc = 0.f;
        for (int hh = 0; hh < 256; hh += 8) { const v4u w = *(const v4u*)(ch + hh);
            acc += lo16(w.x) * w2[(hh + 0) * 64 + lane]; acc += hi16(w.x) * w2[(hh + 1) * 64 + lane]; acc += lo16(w.y) * w2[(hh + 2) * 64 + lane]; acc += hi16(w.y) * w2[(hh + 3) * 64 + lane];
            acc += lo16(w.z) * w2[(hh + 4) * 64 + lane]; acc += hi16(w.z) * w2[(hh + 5) * 64 + lane]; acc += lo16(w.w) * w2[(hh + 6) * 64 + lane]; acc += hi16(w.w) * w2[(hh + 7) * 64 + lane]; }
        const int bg = r / 255, c = r % 255; float* dst = (float*)(ws + (kv ? O_VC : O_KC)) + ((size_t)bg * 256 + c) * 64;
        if (kv == 0) { const float ss = wave_sum(acc * acc); acc = acc * rsqrtf(ss * (1.f / 64.f) + EPS) * P.in[9][lane]; }
        dst[lane] = acc; }
}

__device__ __forceinline__ void mlstm_intra_item(const Params& P, unsigned char* lds, int it, int tid) {
    unsigned char* ws = P.ws; const int bh = it >> 6, c = it & 63, b = bh >> 2, h = bh & 3;
    bf16* QL = (bf16*)lds; bf16* KL = (bf16*)(lds + 33792); float* SCA = (float*)(lds + 67584);
    const bf16* MQK = (const bf16*)(ws + O_MQK); const size_t row0 = (size_t)b * SEQ + 64 * c;
    __syncthreads();
#pragma unroll
    for (int p = 0; p < 4; ++p) { const int idx = p * NT + tid, r = idx >> 5, c8 = (idx & 31) * 8; const bf16* src = MQK + (row0 + r) * 2048 + h * 256 + c8;
        *(v4u*)(QL + r * 264 + c8) = *(const v4u*)src; *(v4u*)(KL + r * 264 + c8) = *(const v4u*)(src + 1024); }
    float mprev = 0.f; { const float* GG = (const float*)(ws + O_GG) + bh * 64; const float* GMX = (const float*)(ws + O_GMX) + bh * 64; for (int cc = 0; cc < c; ++cc) mprev = fmaxf(GG[cc] + mprev, GMX[cc]); }
    if (tid < 64) { const size_t o1 = (size_t)bh * SEQ + 64 * c + tid; const float a = ((const float*)(ws + O_GA))[o1], la = ((const float*)(ws + O_GLA))[o1], mi = ((const float*)(ws + O_GPM))[o1];
        SCA[tid] = a; SCA[64 + tid] = la; SCA[128 + tid] = fmaxf(a + mprev, mi); }
    __syncthreads();
    const int j = tid >> 3, s0 = tid & 7; float d[8];
#pragma unroll
    for (int i = 0; i < 8; ++i) d[i] = 0.f;
    for (int d8 = 0; d8 < 256; d8 += 8) { const v4u qw = *(const v4u*)(QL + j * 264 + d8);
        const float q0 = lo16(qw.x), q1 = hi16(qw.x), q2 = lo16(qw.y), q3 = hi16(qw.y), q4 = lo16(qw.z), q5 = hi16(qw.z), q6 = lo16(qw.w), q7 = hi16(qw.w);
#pragma unroll
        for (int i = 0; i < 8; ++i) { const v4u kw = *(const v4u*)(KL + (s0 + 8 * i) * 264 + d8);
            d[i] += q0 * lo16(kw.x) + q1 * hi16(kw.x) + q2 * lo16(kw.y) + q3 * hi16(kw.y) + q4 * lo16(kw.z) + q5 * hi16(kw.z) + q6 * lo16(kw.w) + q7 * hi16(kw.w); } }
    const float aj = SCA[j], mc = SCA[128 + j]; float rs = 0.f; float* WT = (float*)(ws + O_WT) + (size_t)it * 4096 + j * 64;
#pragma unroll
    for (int i = 0; i < 8; ++i) { const int s = s0 + 8 * i; const float w = (s <= j) ? __expf(aj + SCA[64 + s] - mc) * d[i] * 0.0625f : 0.f; WT[s] = w; rs += w; }
    rs += __shfl_xor(rs, 1); rs += __shfl_xor(rs, 2); rs += __shfl_xor(rs, 4);
    if (s0 == 0) ((float*)(ws + O_DENI))[(size_t)bh * SEQ + 64 * c + j] = rs;
}

__device__ __forceinline__ void mlstm_scan_item(const Params& P, unsigned char* lds, int it, int tid) {
    unsigned char* ws = P.ws; const int bh = it >> 4, es = it & 15, b = bh >> 2, h = bh & 3;
    bf16* QL = (bf16*)lds; bf16* KL = (bf16*)(lds + 33792); float* VL = (float*)(lds + 67584); float* WL = (float*)(lds + 71680); float* CL = (float*)(lds + 88320); float* NL = (float*)(lds + 104704);
    float* SU = (float*)(lds + 105728); float* SSI = SU + 64; float* SMC = SU + 128; float* SDN = SU + 192;
    const bf16* MQK = (const bf16*)(ws + O_MQK); const bf16* PA = (const bf16*)(ws + O_PA); const float* WT = (const float*)(ws + O_WT); float* HC = (float*)(ws + O_HC);
    const float* GG = (const float*)(ws + O_GG) + bh * 64; const float* GMX = (const float*)(ws + O_GMX) + bh * 64;
    float C[8]; float nn = 0.f; float mst = 0.f;
#pragma unroll
    for (int i = 0; i < 8; ++i) C[i] = 0.f;
    const int ud = tid >> 1, ue = (tid & 1) * 8;
    const int oj = tid >> 3, oe = (tid & 7) * 2, oq = tid & 7;
    for (int c = 0; c < 64; ++c) {
        const size_t row0 = (size_t)b * SEQ + 64 * c;
        __syncthreads();
#pragma unroll
        for (int p = 0; p < 4; ++p) { const int idx = p * NT + tid, r = idx >> 5, c8 = (idx & 31) * 8; const bf16* src = MQK + (row0 + r) * 2048 + h * 256 + c8;
            *(v4u*)(QL + r * 264 + c8) = *(const v4u*)src; *(v4u*)(KL + r * 264 + c8) = *(const v4u*)(src + 1024); }
        { const v2u* vs = (const v2u*)(PA + (row0 + oj) * NA + PA_MV + h * 256 + es * 16 + oe); const unsigned w = *(const unsigned*)vs; VL[oj * 16 + oe] = lo16(w); VL[oj * 16 + oe + 1] = hi16(w); }
#pragma unroll
        for (int p = 0; p < 8; ++p) { const int idx = p * NT + tid; WL[(idx >> 6) * 65 + (idx & 63)] = WT[(size_t)(bh * 64 + c) * 4096 + idx]; }
        const float g = GG[c], mx = GMX[c]; const float mnew = fmaxf(g + mst, mx); const float dec = __expf(g + mst - mnew);
        if (tid < 64) { const size_t o1 = (size_t)bh * SEQ + 64 * c + tid; const float a = ((const float*)(ws + O_GA))[o1], la = ((const float*)(ws + O_GLA))[o1], mi = ((const float*)(ws + O_GPM))[o1];
            const float mc = fmaxf(a + mst, mi); SU[tid] = __expf(g + la - mnew) * 0.0625f; SSI[tid] = __expf(a + mst - mc); SMC[tid] = __expf(-mc); SDN[tid] = ((const float*)(ws + O_DENI))[o1]; }
#pragma unroll
        for (int i = 0; i < 8; ++i) CL[ud * 16 + ue + i] = C[i];
        if ((tid & 1) == 0) NL[ud] = nn;
        __syncthreads();
        { float n0 = 0.f, n1 = 0.f, dn = 0.f;
          for (int d8 = 0; d8 < 256; d8 += 8) { const v4u qw = *(const v4u*)(QL + oj * 264 + d8); float q[8] = {lo16(qw.x), hi16(qw.x), lo16(qw.y), hi16(qw.y), lo16(qw.z), hi16(qw.z), lo16(qw.w), hi16(qw.w)};
#pragma unroll
              for (int i = 0; i < 8; ++i) { const f32x2 cv = *(const f32x2*)(CL + (d8 + i) * 16 + oe); n0 += q[i] * cv.x; n1 += q[i] * cv.y; } }
          { const int db = oq * 32;
#pragma unroll
            for (int d8 = 0; d8 < 32; d8 += 8) { const v4u qw = *(const v4u*)(QL + oj * 264 + db + d8); const float* np = NL + db + d8;
                dn += lo16(qw.x) * np[0] + hi16(qw.x) * np[1] + lo16(qw.y) * np[2] + hi16(qw.y) * np[3] + lo16(qw.z) * np[4] + hi16(qw.z) * np[5] + lo16(qw.w) * np[6] + hi16(qw.w) * np[7]; } }
          dn += __shfl_xor(dn, 1); dn += __shfl_xor(dn, 2); dn += __shfl_xor(dn, 4);
          float i0 = 0.f, i1 = 0.f;
          for (int s = 0; s < 64; ++s) { const float w = WL[oj * 65 + s]; const f32x2 vv = *(const f32x2*)(VL + s * 16 + oe); i0 += w * vv.x; i1 += w * vv.y; }
          const float si = SSI[oj]; const float den = fmaxf(fabsf(si * dn + SDN[oj]), SMC[oj]); const float inv = 1.f / den;
          f32x2 o; o.x = (si * n0 + i0) * inv; o.y = (si * n1 + i1) * inv;
          *(f32x2*)(HC + (row0 + oj) * 1024 + h * 256 + es * 16 + oe) = o; }
        { float kacc = 0.f;
#pragma unroll
          for (int i = 0; i < 8; ++i) C[i] *= dec;
          for (int s = 0; s < 64; ++s) { const float kk = bf2f(KL[s * 264 + ud]) * SU[s]; kacc += kk; const f32x4 v0 = *(const f32x4*)(VL + s * 16 + ue), v1 = *(const f32x4*)(VL + s * 16 + ue + 4);
              C[0] += kk * v0.x; C[1] += kk * v0.y; C[2] += kk * v0.z; C[3] += kk * v0.w; C[4] += kk * v1.x; C[5] += kk * v1.y; C[6] += kk * v1.z; C[7] += kk * v1.w; }
          nn = dec * nn + kacc; }
        mst = mnew;
    }
}
__device__ __forceinline__ void attend_block(const bf16* Kb, const bf16* Vb, int base, int t, const float (&qreg)[64], float& mrun, float& lrun, float (&o)[4], float* ps, float* scl, int lane) {
    const int kk = lane >> 2, r = lane & 3; float s[4]; bool ok[4];
#pragma unroll
    for (int i = 0; i < 4; ++i) { const int key = base + 16 * i + kk; ok[i] = (key >= 0) && (key <= t); const int keyc = key < 0 ? 0 : key; const v4u* kr = (const v4u*)(Kb + (size_t)keyc * NA); float a = 0.f;
#pragma unroll
        for (int d8 = 0; d8 < 8; ++d8) { const v4u w = kr[d8];
            a += qreg[8 * d8 + 0] * lo16(w.x) + qreg[8 * d8 + 1] * hi16(w.x) + qreg[8 * d8 + 2] * lo16(w.y) + qreg[8 * d8 + 3] * hi16(w.y) + qreg[8 * d8 + 4] * lo16(w.z) + qreg[8 * d8 + 5] * hi16(w.z) + qreg[8 * d8 + 6] * lo16(w.w) + qreg[8 * d8 + 7] * hi16(w.w); }
        s[i] = ok[i] ? a : -1e30f; }
    float bm = fmaxf(fmaxf(s[0], s[1]), fmaxf(s[2], s[3]));
#pragma unroll
    for (int o2 = 4; o2 < 64; o2 <<= 1) bm = fmaxf(bm, __shfl_xor(bm, o2));
    const float mnew = fmaxf(mrun, bm); const float sc = __expf(mrun - mnew); float ls = 0.f;
#pragma unroll
    for (int i = 0; i < 4; ++i) { const float p = ok[i] ? __expf(s[i] - mnew) : 0.f; ls += p; ps[(16 * i + kk) * 4 + r] = p; }
#pragma unroll
    for (int o2 = 4; o2 < 64; o2 <<= 1) ls += __shfl_xor(ls, o2);
    lrun = lrun * sc + ls; mrun = mnew;
    if (kk == 0) scl[r] = sc;
    WSYNC();
    const f32x4 scv = *(const f32x4*)scl; o[0] *= scv.x; o[1] *= scv.y; o[2] *= scv.z; o[3] *= scv.w;
    const int b0 = base < 0 ? 0 : base;
#pragma unroll 8
    for (int key = 0; key < 64; ++key) { const int kr = base + key; const float v = bf2f(Vb[(size_t)(kr < 0 ? b0 : kr) * NA + lane]); const f32x4 pv = *(const f32x4*)(ps + key * 4);
        o[0] += pv.x * v; o[1] += pv.y * v; o[2] += pv.z * v; o[3] += pv.w * v; }
    WSYNC();
}
__device__ __forceinline__ void nsa_item(const Params& P, int item, float* wl, int lane) {
    unsigned char* ws = P.ws; const int t = item & (SEQ - 1), bg = item >> 12, b = bg >> 2, g = bg & 3; const size_t row = (size_t)b * SEQ + t;
    const bf16* PA = (const bf16*)(ws + O_PA); const bf16* PAr = PA + row * NA; const float* SMr = (const float*)(ws + O_SM) + row * 64;
    float* qs = wl; float* pall = wl + 256; float* psum = wl + 1280; float* vals = wl + 1536; float* ps = wl + 1600; float* scl = wl + 1856;
#pragma unroll
    for (int r = 0; r < 4; ++r) qs[r * 64 + lane] = bf2f(PAr[PA_Q + g * 256 + r * 64 + lane]);
    WSYNC();
    const int ncv = (t >= 31) ? ((t - 31) >> 4) + 1 : 0;
    float oc[4] = {0.f, 0.f, 0.f, 0.f}; float impv = 0.f;
    if (ncv > 0) {
        const float* KCb = (const float*)(ws + O_KC) + (size_t)bg * 256 * 64; const float* VCb = (const float*)(ws + O_VC) + (size_t)bg * 256 * 64;
        float s[4][4];
#pragma unroll
        for (int rd = 0; rd < 4; ++rd) { const int c = rd * 64 + lane; const bool okc = c < ncv; float a0 = 0.f, a1 = 0.f, a2 = 0.f, a3 = 0.f;
            if (rd * 64 < ncv) { const f32x4* kr = (const f32x4*)(KCb + (size_t)(okc ? c : 0) * 64);
#pragma unroll 4
                for (int d4 = 0; d4 < 16; ++d4) { const f32x4 kv = kr[d4]; const f32x4 q0 = *(const f32x4*)(qs + 4 * d4), q1 = *(const f32x4*)(qs + 64 + 4 * d4), q2 = *(const f32x4*)(qs + 128 + 4 * d4), q3 = *(const f32x4*)(qs + 192 + 4 * d4);
                    a0 += q0.x * kv.x + q0.y * kv.y + q0.z * kv.z + q0.w * kv.w; a1 += q1.x * kv.x + q1.y * kv.y + q1.z * kv.z + q1.w * kv.w;
                    a2 += q2.x * kv.x + q2.y * kv.y + q2.z * kv.z + q2.w * kv.w; a3 += q3.x * kv.x + q3.y * kv.y + q3.z * kv.z + q3.w * kv.w; } }
            s[rd][0] = okc ? a0 : -1e30f; s[rd][1] = okc ? a1 : -1e30f; s[rd][2] = okc ? a2 : -1e30f; s[rd][3] = okc ? a3 : -1e30f; }
        float pst[4] = {0.f, 0.f, 0.f, 0.f};
#pragma unroll
        for (int r = 0; r < 4; ++r) { const float mr = wave_max(fmaxf(fmaxf(s[0][r], s[1][r]), fmaxf(s[2][r], s[3][r]))); float e[4]; float ls = 0.f;
#pragma unroll
            for (int rd = 0; rd < 4; ++rd) { e[rd] = (rd * 64 + lane < ncv) ? __expf(s[rd][r] - mr) : 0.f; ls += e[rd]; }
            const float inv = 1.f / wave_sum(ls);
#pragma unroll
            for (int rd = 0; rd < 4; ++rd) { const float p = e[rd] * inv; pall[r * 256 + rd * 64 + lane] = p; pst[rd] += p; } }
#pragma unroll
        for (int rd = 0; rd < 4; ++rd) psum[rd * 64 + lane] = pst[rd];
        WSYNC();
#pragma unroll
        for (int k = -1; k <= 3; ++k) { const int c = 4 * lane + k; if (c >= 0 && c <= 254) impv += psum[c]; }
        for (int c = 0; c < ncv; ++c) { const float v = VCb[(size_t)c * 64 + lane]; oc[0] += pall[c] * v; oc[1] += pall[256 + c] * v; oc[2] += pall[512 + c] * v; oc[3] += pall[768 + c] * v; }
    }
    const int cur = t >> 6;
    const float val = (lane == 0 || lane == cur || lane == cur - 1) ? 1e4f : ((lane <= cur) ? impv : -1.f);
    vals[lane] = val; WSYNC();
    int rank = 0;
#pragma unroll 8
    for (int m = 0; m < 64; ++m) { const float vm = vals[m]; rank += (vm > val || (vm == val && m < lane)) ? 1 : 0; }
    unsigned long long mask = __ballot(rank < 16 && lane <= cur);
    float qreg[64]; { const int r = lane & 3;
#pragma unroll
        for (int d4 = 0; d4 < 16; ++d4) { const f32x4 q = *(const f32x4*)(qs + r * 64 + 4 * d4); qreg[4 * d4] = q.x; qreg[4 * d4 + 1] = q.y; qreg[4 * d4 + 2] = q.z; qreg[4 * d4 + 3] = q.w; } }
    const bf16* Pb = PA + (size_t)b * SEQ * NA;
    float osl[4] = {0.f, 0.f, 0.f, 0.f}; float ms = -1e30f, lsl = 0.f;
    { const bf16* Kb = Pb + PA_KV + 2 * 256 + g * 64; const bf16* Vb = Pb + PA_KV + 3 * 256 + g * 64;
      while (mask) { const int n = __builtin_ctzll(mask); mask &= mask - 1; attend_block(Kb, Vb, 64 * n, t, qreg, ms, lsl, osl, ps, scl, lane); } }
    float ow[4] = {0.f, 0.f, 0.f, 0.f}; float mw = -1e30f, lw = 0.f;
    { const bf16* Kb = Pb + PA_KV + 4 * 256 + g * 64; const bf16* Vb = Pb + PA_KV + 5 * 256 + g * 64;
      for (int i = 0; i < 8; ++i) { const int base = t - 511 + 64 * i; if (base + 63 < 0) continue; attend_block(Kb, Vb, base, t, qreg, mw, lw, ow, ps, scl, lane); } }
    if (lane < 4) { scl[lane] = 1.f / lsl; scl[4 + lane] = 1.f / lw; }
    WSYNC();
    bf16* ON = (bf16*)(ws + O_ONSA) + row * 1024 + g * 256;
#pragma unroll
    for (int r = 0; r < 4; ++r) { const int hd = g * 4 + r; const float g0 = sigmf(SMr[hd * 3 + 0]), g1 = sigmf(SMr[hd * 3 + 1]), g2 = sigmf(SMr[hd * 3 + 2]);
        ON[r * 64 + lane] = (bf16)f2bf(g0 * oc[r] + g1 * osl[r] * scl[r] + g2 * ow[r] * scl[4 + r]); }
    WSYNC();
}
__device__ __forceinline__ void hm_item(const Params& P, int it, int lane) {
    unsigned char* ws = P.ws; const int row = it >> 2, h = it & 3;
    const f32x4 hc = *(const f32x4*)((const float*)(ws + O_HC) + (size_t)row * 1024 + h * 256 + 4 * lane);
    const float ss = wave_sum(hc.x * hc.x + hc.y * hc.y + hc.z * hc.z + hc.w * hc.w); const float rstd = rsqrtf(ss * (1.f / 256.f) + EPS);
    const v2u mo = *(const v2u*)((const bf16*)(ws + O_PA) + (size_t)row * NA + PA_MO + h * 256 + 4 * lane);
    v2u o; o.x = pk2(sigmf(lo16(mo.x)) * hc.x * rstd, sigmf(hi16(mo.x)) * hc.y * rstd); o.y = pk2(sigmf(lo16(mo.y)) * hc.z * rstd, sigmf(hi16(mo.y)) * hc.w * rstd);
    *(v2u*)((bf16*)(ws + O_HM) + (size_t)row * 1024 + h * 256 + 4 * lane) = o;
}

constexpr int N_PHASES = 16;
__global__ void __launch_bounds__(NT, 2) mk_fwd(Params P) {
    extern __shared__ __attribute__((aligned(16))) unsigned char lds[];
    cg::grid_group grid = cg::this_grid();
    const int tid = threadIdx.x, lane = tid & 63, wave = __builtin_amdgcn_readfirstlane(tid >> 6);
    const int G = gridDim.x, bx = blockIdx.x, gw = bx * NWV + wave, ngw = G * NWV;
    unsigned char* ws = P.ws; const int lo = P.ph_lo, hi = P.ph_hi;
    PG8_LAS unsigned char* lds3 = (PG8_LAS unsigned char*)lds;
#define IN(k) (lo <= (k) && (k) < hi)
#define SEAM(k) do { if (IN(k) && IN((k) + 1)) grid.sync(); } while (0)
#define GEMM(EPI, Aoff, Boff, MM, NN, KK, E) do { pg8::Gemm g_{(const pg8::bf16_t*)(ws + (Aoff)), (const pg8::bf16_t*)(ws + (Boff)), (MM), (NN), (KK)}; pg8::StaticOrder S_; S_.init((MM), (NN), G, bx); \
        pg8::gemm_phase<EPI, pg8::StaticOrder, true, true>(lds3, g_, S_, (E)); } while (0)
    if (IN(0)) { phase_prologue(P, lds, gw, ngw, wave, lane, tid); } SEAM(0);
    if (IN(1)) { pg8::EpiP<0> E{(pg8::bf16_t*)(ws + O_H), FF, nullptr, nullptr, 0, nullptr}; GEMM(pg8::EpiP<0>, O_XN, O_WGU, TOK, 2 * FF, DM, E); } SEAM(1);
    if (IN(2)) { pg8::EpiResid E{P.in[0], P.out, DM, 0.5f}; GEMM(pg8::EpiResid, O_H, O_WD, TOK, DM, FF, E); } SEAM(2);
    if (IN(3)) { phase_norm(P.out, (bf16*)(ws + O_XN), gw, ngw, lane); } SEAM(3);
    if (IN(4)) { pg8::EpiP<1> E{(pg8::bf16_t*)(ws + O_PA), NA, (const float*)(ws + O_BIASA), nullptr, 0, (float*)(ws + O_SM)}; GEMM(pg8::EpiP<1>, O_XN, O_WINA, TOK, NA, DM, E); } SEAM(4);
    if (IN(5)) { phase_prep(P, gw, ngw, lane); } SEAM(5);
    if (IN(6)) {
        { pg8::EpiP<3> E{(pg8::bf16_t*)(ws + O_CHK), 256, nullptr, nullptr, 0, nullptr}; GEMM(pg8::EpiP<3>, O_CBK, O_WC1K, 4096, 256, 2048, E); }
        { pg8::EpiP<3> E{(pg8::bf16_t*)(ws + O_CHV), 256, nullptr, nullptr, 0, nullptr}; GEMM(pg8::EpiP<3>, O_CBV, O_WC1V, 4096, 256, 2048, E); }
        for (int it = bx; it < 1024; it += G) mlstm_intra_item(P, lds, it, tid);
    } SEAM(6);
    if (IN(7)) { phase_cmp2(P, gw, ngw, lane); for (int it = bx; it < 256; it += G) mlstm_scan_item(P, lds, it, tid); } SEAM(7);
    if (IN(8)) { float* wl = (float*)(lds + wave * 8192); for (int it = gw; it < 65536; it += ngw) nsa_item(P, it, wl, lane); for (int it = gw; it < 65536; it += ngw) hm_item(P, it, lane); } SEAM(8);
    if (IN(9)) { pg8::EpiP<2> E{(pg8::bf16_t*)(ws + O_MG), NB, (const float*)(ws + O_BIASB), nullptr, 0, nullptr}; GEMM(pg8::EpiP<2>, O_XN, O_WINB, TOK, NB, DM, E); } SEAM(9);
    if (IN(10)) { pg8::EpiP<4> E{(pg8::bf16_t*)(ws + O_XN), DM, nullptr, (const pg8::bf16_t*)(ws + O_MG), NB, nullptr}; GEMM(pg8::EpiP<4>, O_ONSA, O_WBN, TOK, DM, 1024, E); } SEAM(10);
    if (IN(11)) { pg8::EpiP<5> E{(pg8::bf16_t*)(ws + O_XN), DM, nullptr, (const pg8::bf16_t*)(ws + O_MG), NB, nullptr}; GEMM(pg8::EpiP<5>, O_HM, O_WBM, TOK, DM, 1024, E); } SEAM(11);
    if (IN(12)) { pg8::EpiResid E{P.out, P.out, DM, 1.0f}; GEMM(pg8::EpiResid, O_XN, O_WOUT, TOK, DM, DM, E); } SEAM(12);
    if (IN(13)) { phase_norm(P.out, (bf16*)(ws + O_XN), gw, ngw, lane); phase_conv_ffn2(P, lds, gw, ngw, wave, lane); } SEAM(13);
    if (IN(14)) { pg8::EpiP<0> E{(pg8::bf16_t*)(ws + O_H), FF, nullptr, nullptr, 0, nullptr}; GEMM(pg8::EpiP<0>, O_XN, O_WGU, TOK, 2 * FF, DM, E); } SEAM(14);
    if (IN(15)) { pg8::EpiResid E{P.out, P.out, DM, 0.5f}; GEMM(pg8::EpiResid, O_H, O_WD, TOK, DM, FF, E); }
#undef IN
#undef SEAM
#undef GEMM
}

#ifndef MK_COOP
#define MK_COOP 0
#endif
extern "C" void kernel_launch(void* const* d_in, const int* in_sizes, int n_in, void* d_out, int out_size, void* d_ws, size_t ws_size, hipStream_t stream) {
    static int grid = 0;
    if (grid == 0) {
        if (n_in != 28 || ws_size < WS_NEED) { fprintf(stderr, "kernel_launch: unexpected n_in %d / ws_size %zu\n", n_in, ws_size); grid = -1; return; }
        int dev = 0, cus = 0, per_cu = 0;
        hipGetDevice(&dev); hipDeviceGetAttribute(&cus, hipDeviceAttributeMultiprocessorCount, dev);
        hipFuncSetAttribute((const void*)mk_fwd, hipFuncAttributeMaxDynamicSharedMemorySize, LDS_BYTES);
        hipOccupancyMaxActiveBlocksPerMultiprocessor(&per_cu, (const void*)mk_fwd, NT, LDS_BYTES);
        (void)hipGetLastError();
        if (per_cu < 1) per_cu = 1;
        grid = cus * 1;
        if (grid < 8) grid = 256;
    }
    if (grid < 0) return;
    Params p{};
    for (int i = 0; i < 28; ++i) p.in[i] = (const float*)d_in[i];
    p.out = (float*)d_out; p.ws = (unsigned char*)d_ws;
#if MK_COOP
    p.ph_lo = 0; p.ph_hi = N_PHASES;
    void* args[] = {&p};
    hipError_t e = hipLaunchCooperativeKernel((const void*)mk_fwd, dim3(grid), dim3(NT), args, LDS_BYTES, stream);
    if (e != hipSuccess) fprintf(stderr, "cooperative launch failed: %s (grid %d)\n", hipGetErrorString(e), grid);
#else
    for (int k = 0; k < N_PHASES; ++k) { p.ph_lo = k; p.ph_hi = k + 1; hipLaunchKernelGGL(mk_fwd, dim3(grid), dim3(NT), LDS_BYTES, stream, p); }
#endif
}
```

```cpp
#include <hip/hip_runtime.h>
#include <hip/hip_cooperative_groups.h>
#include <cstdio>
#include <cstdint>
namespace cg = cooperative_groups;
#define MK_COOP 1
namespace pg8 {
#define PG8_LAS __attribute__((address_space(3)))
typedef unsigned short bf16_t;
typedef short bf16x8 __attribute__((ext_vector_type(8)));
typedef float f32x4 __attribute__((ext_vector_type(4)));
typedef unsigned u32x4 __attribute__((ext_vector_type(4)));
constexpr int BM = 256, BK = 64, HALF = 128, HTB = HALF * BK * 2  , STAGE_BYTES = 8 * HTB, NXCD = 8, WGM = 8;

__host__ __device__ __forceinline__ int lds_byte(int r, int c) { const int st = (r >> 4) * 2 + (c >> 5), rr = r & 15, cc = c & 31, ob = rr * 64 + cc * 2; return st * 1024 + (ob ^ (((ob >> 9) & 1) << 5)); }
__host__ __device__ __forceinline__ void stage_rc(int b, int& R, int& C) { const int st = b / 1024, sb = b % 1024, swz = sb ^ (((sb >> 9) & 1) << 5); R = (st >> 1) * 16 + swz / 64; C = (st & 1) * 32 + (swz % 64) / 2; }
__host__ __device__ __forceinline__ int perm32(int rho) { const int n = rho >> 4, i = rho & 15; return 8 * (i >> 2) + 4 * n + (i & 3); }

struct Unit { int pm, pn; };
struct Gemm { const bf16_t* A; const bf16_t* Bt; int M, N, K; };

struct StaticOrder {
    int nM, nN, nwg, G, c;
    __host__ __device__ void init(int M, int N, int G_, int c_) { nM = M / BM; nN = N / BM; nwg = nM * nN; G = G_; c = c_; }
    __host__ __device__ bool next(int i, Unit& u) const {
        const long L = (long)i * G + c; if (L >= nwg) return false;
        int wgid = (int)L; { const int q = nwg / NXCD, r = nwg % NXCD, xcd = wgid % NXCD, off = wgid / NXCD; wgid = (xcd < r ? xcd * (q + 1) : r * (q + 1) + (xcd - r) * q) + off; }
        const int nig = WGM * nN, gid = wgid / nig, fm = gid * WGM, gsz = (nM - fm) < WGM ? (nM - fm) : WGM;
        u.pm = fm + ((wgid % nig) % gsz); u.pn = (wgid % nig) / gsz; return true;
    }
    __device__ __forceinline__ void a_ready(const Unit&) const {}
    __device__ __forceinline__ void done(const Unit&) const {}
};

__device__ __forceinline__ unsigned cvt_pk_bf16(float lo, float hi) { unsigned r; asm volatile("v_cvt_pk_bf16_f32 %0, %1, %2" : "=v"(r) : "v"(lo), "v"(hi)); return r; }
typedef float f32x2 __attribute__((ext_vector_type(2)));
__device__ __forceinline__ float sigm(float x) { return 1.f / (1.f + __expf(-x)); }
__device__ __forceinline__ float gelu_tanh(float x) { const float u = 1.5957691216f * (x + 0.044715f * x * x * x); return x - x / (__expf(u) + 1.f); }
template <int MODE> struct EpiP {
    static constexpr bool PERM = true, AFTER_DRAIN = false;
    bf16_t* O; int ldc; const float* bias; const bf16_t* G; int ldg; float* SMo;
    __device__ __forceinline__ void operator()(const f32x4 (&acc)[2][2][4][2], const Unit& u, int wr, int wc, int fr, int fq) const {
        const int row0 = u.pm * BM + wr * 64 + fr;
        if constexpr (MODE == 0) {
            const int col = u.pn * 128 + wc * 32 + 8 * fq;
#pragma unroll
            for (int ai = 0; ai < 2; ++ai)
#pragma unroll
                for (int m = 0; m < 4; ++m) {
                    const int row = row0 + ai * HALF + m * 16; float o[8];
#pragma unroll
                    for (int n = 0; n < 2; ++n)
#pragma unroll
                        for (int i = 0; i < 4; ++i) { const float g = acc[ai][0][m][n][i], uu = acc[ai][1][m][n][i]; o[4 * n + i] = g * sigm(g) * uu; }
                    u32x4 w; w.x = cvt_pk_bf16(o[0], o[1]); w.y = cvt_pk_bf16(o[2], o[3]); w.z = cvt_pk_bf16(o[4], o[5]); w.w = cvt_pk_bf16(o[6], o[7]);
                    *(u32x4*)(O + (size_t)row * ldc + col) = w;
                }
        } else {
#pragma unroll
            for (int bj = 0; bj < 2; ++bj) {
                const int col = u.pn * BM + bj * HALF + wc * 32 + 8 * fq;
                f32x4 b0 = (f32x4){0.f, 0.f, 0.f, 0.f}, b1 = b0;
                if constexpr (MODE == 1 || MODE == 2) { b0 = *(const f32x4*)(bias + col); b1 = *(const f32x4*)(bias + col + 4); }
#pragma unroll
                for (int ai = 0; ai < 2; ++ai)
#pragma unroll
                    for (int m = 0; m < 4; ++m) {
                        const int row = row0 + ai * HALF + m * 16;
                        f32x4 v0 = acc[ai][bj][m][0] + b0, v1 = acc[ai][bj][m][1] + b1;
                        if constexpr (MODE == 1) {
                            if (SMo != nullptr && u.pn == 26 && bj == 0 && wc < 2) { float* sp = SMo + (size_t)row * 64 + wc * 32 + 8 * fq; *(f32x4*)sp = v0; *(f32x4*)(sp + 4) = v1; }
                        }
                        if constexpr (MODE == 2) {
#pragma unroll
                            for (int i = 0; i < 4; ++i) { v0[i] = sigm(v0[i]); v1[i] = sigm(v1[i]); }
                        }
                        if constexpr (MODE == 3) {
#pragma unroll
                            for (int i = 0; i < 4; ++i) { v0[i] = gelu_tanh(v0[i]); v1[i] = gelu_tanh(v1[i]); }
                        }
                        if constexpr (MODE == 4 || MODE == 5) {
                            const u32x4 gw = *(const u32x4*)(G + (size_t)row * ldg + (MODE == 5 ? 2048 : 0) + col);
                            const float g0 = __uint_as_float(gw.x << 16), g1 = __uint_as_float(gw.x & 0xffff0000u), g2 = __uint_as_float(gw.y << 16), g3 = __uint_as_float(gw.y & 0xffff0000u);
                            const float g4 = __uint_as_float(gw.z << 16), g5 = __uint_as_float(gw.z & 0xffff0000u), g6 = __uint_as_float(gw.w << 16), g7 = __uint_as_float(gw.w & 0xffff0000u);
                            v0 = v0 * (f32x4){g0, g1, g2, g3}; v1 = v1 * (f32x4){g4, g5, g6, g7};
                            if constexpr (MODE == 5) {
                                const u32x4 ow = *(const u32x4*)(O + (size_t)row * ldc + col);
                                v0 = v0 + (f32x4){__uint_as_float(ow.x << 16), __uint_as_float(ow.x & 0xffff0000u), __uint_as_float(ow.y << 16), __uint_as_float(ow.y & 0xffff0000u)};
                                v1 = v1 + (f32x4){__uint_as_float(ow.z << 16), __uint_as_float(ow.z & 0xffff0000u), __uint_as_float(ow.w << 16), __uint_as_float(ow.w & 0xffff0000u)};
                            }
                        }
                        u32x4 w; w.x = cvt_pk_bf16(v0[0], v0[1]); w.y = cvt_pk_bf16(v0[2], v0[3]); w.z = cvt_pk_bf16(v1[0], v1[1]); w.w = cvt_pk_bf16(v1[2], v1[3]);
                        *(u32x4*)(O + (size_t)row * ldc + col) = w;
                    }
            }
        }
    }
};
struct EpiResid {
    static constexpr bool PERM = false, AFTER_DRAIN = false;
    const float* res; float* out; int ldc; float scale;
    __device__ __forceinline__ void operator()(const f32x4 (&acc)[2][2][4][2], const Unit& u, int wr, int wc, int fr, int fq) const {
        const int row0 = u.pm * BM + wr * 64 + fr, col0 = u.pn * BM + wc * 32 + 4 * fq;
#pragma unroll
        for (int ai = 0; ai < 2; ++ai)
#pragma unroll
            for (int m = 0; m < 4; ++m) { const size_t off = (size_t)(row0 + ai * HALF + m * 16) * ldc + col0;
#pragma unroll
                for (int bj = 0; bj < 2; ++bj)
#pragma unroll
                    for (int n = 0; n < 2; ++n) { const f32x4 r = *(const f32x4*)(res + off + bj * HALF + n * 16); *(f32x4*)(out + off + bj * HALF + n * 16) = r + acc[ai][bj][m][n] * scale; } }
    }
};
template <class Epi, class Sched, bool ALIGN_EPI = false, bool SP2 = false>
__device__ __forceinline__ void gemm_phase(PG8_LAS unsigned char* lds, const Gemm g, const Sched& S, const Epi& E) {
    int tid_o = threadIdx.x; asm volatile("" : "+v"(tid_o));
    const int tid = tid_o, wid = __builtin_amdgcn_readfirstlane(tid >> 6), lane = tid & 63, wr = wid >> 2, wc = wid & 3, fr = lane & 15, fq = lane >> 4;
    const int K = g.K, nt = K / BK;
    unsigned voffA[2], voffB[2];
#pragma unroll
    for (int i = 0; i < 2; ++i) { int R, C; stage_rc(tid * 16 + i * 8192, R, C); const int Rb = Epi::PERM ? ((R & ~31) + perm32(R & 31)) : R;
        voffA[i] = (unsigned)(R * K + C) * 2u; voffB[i] = (unsigned)(Rb * K + C) * 2u; }
    const size_t kstep = (size_t)(BK * 2);
    const size_t hstep = (size_t)HALF * K * 2;
    const size_t tstep = 2 * hstep;
    const unsigned ldsw = (unsigned)wid * 1024u;
    const int aoff = lds_byte(wr * 64 + fr, fq * 8), boff = lds_byte(wc * 32 + fr, fq * 8);
#define PG8_SA(b, h) (((b) * 2 + (h)) * HTB)
#define PG8_SB(b, h) ((4 + (b) * 2 + (h)) * HTB)
#define PG8_STAGE(bufoff, gbase, voff) do { _Pragma("unroll") for (int _i = 0; _i < 2; ++_i) \
        __builtin_amdgcn_global_load_lds((const unsigned*)((const char*)(gbase) + (voff)[_i]), (PG8_LAS unsigned*)(lds + (bufoff) + ldsw + _i * 8192), 16, 0, 0); } while (0)
#define PG8_LDA(dst, b, h) do { _Pragma("unroll") for (int m = 0; m < 4; ++m) _Pragma("unroll") for (int k = 0; k < 2; ++k) dst[m][k] = *(const PG8_LAS bf16x8*)(lds + PG8_SA(b, h) + aoff + m * 2048 + k * 1024); } while (0)
#define PG8_LDB(dst, b, h) do { _Pragma("unroll") for (int n = 0; n < 2; ++n) _Pragma("unroll") for (int k = 0; k < 2; ++k) dst[n][k] = *(const PG8_LAS bf16x8*)(lds + PG8_SB(b, h) + boff + n * 2048 + k * 1024); } while (0)
#define PG8_MMA(ai, bj, At, Bt) do { __builtin_amdgcn_s_setprio(1); _Pragma("unroll") for (int m = 0; m < 4; ++m) _Pragma("unroll") for (int n = 0; n < 2; ++n) _Pragma("unroll") for (int k = 0; k < 2; ++k) \
        acc[ai][bj][m][n] = __builtin_amdgcn_mfma_f32_16x16x32_bf16(Bt[n][k], At[m][k], acc[ai][bj][m][n], 0, 0, 0); __builtin_amdgcn_s_setprio(0); } while (0)
#define PG8_WAIT_V(n) asm volatile("s_waitcnt vmcnt(" #n ")" ::: "memory")
#define PG8_WAIT_L(n) asm volatile("s_waitcnt lgkmcnt(" #n ")" ::: "memory")
#define PG8_BAR __builtin_amdgcn_s_barrier()
#define PG8_SCHED __builtin_amdgcn_sched_barrier(0)
    Unit cur, nxt; int ui = 0;
    if (!S.next(0, cur)) return;
    f32x4 acc[2][2][4][2];
#pragma unroll
    for (int a = 0; a < 2; ++a)
#pragma unroll
        for (int b = 0; b < 2; ++b)
#pragma unroll
            for (int m = 0; m < 4; ++m)
#pragma unroll
                for (int n = 0; n < 2; ++n) acc[a][b][m][n] = (f32x4){0.f, 0.f, 0.f, 0.f};
    bf16x8 At[4][2], B0[2][2], B1[2][2];
    const char* cA = (const char*)g.A + (size_t)cur.pm * tstep; const char* cB = (const char*)g.Bt + (size_t)cur.pn * tstep;
    S.a_ready(cur);
    if constexpr (SP2) {
        PG8_STAGE(PG8_SB(0, 0), cB, voffB); PG8_STAGE(PG8_SB(0, 1), cB + hstep, voffB); PG8_STAGE(PG8_SA(0, 0), cA, voffA); PG8_STAGE(PG8_SA(0, 1), cA + hstep, voffA);
        if (wr == 1) PG8_BAR;
        PG8_WAIT_V(2); PG8_BAR;
        PG8_STAGE(PG8_SB(1, 0), cB + kstep, voffB); PG8_STAGE(PG8_SA(1, 0), cA + kstep, voffA); PG8_STAGE(PG8_SB(1, 1), cB + hstep + kstep, voffB);
        PG8_WAIT_V(6); PG8_BAR;
    } else {
        PG8_STAGE(PG8_SB(0, 0), cB, voffB); PG8_STAGE(PG8_SA(0, 0), cA, voffA); PG8_STAGE(PG8_SB(0, 1), cB + hstep, voffB); PG8_STAGE(PG8_SA(0, 1), cA + hstep, voffA);
        if (wr == 1) PG8_BAR;
        PG8_WAIT_V(4); PG8_BAR;
        PG8_STAGE(PG8_SB(1, 0), cB + kstep, voffB); PG8_STAGE(PG8_SA(1, 0), cA + kstep, voffA); PG8_STAGE(PG8_SB(1, 1), cB + hstep + kstep, voffB);
        PG8_WAIT_V(6); PG8_BAR;
    }
    for (;;) {
        const bool has_next = S.next(ui + 1, nxt);
        const char* nA = has_next ? (const char*)g.A + (size_t)nxt.pm * tstep : cA; const char* nB = has_next ? (const char*)g.Bt + (size_t)nxt.pn * tstep : cB;
        for (int t = 0; t < nt; t += 2) {
            const bool last = (t == nt - 2);
            const char* a1 = cA + (size_t)(t + 1) * kstep;
            const char* a2 = last ? nA : cA + (size_t)(t + 2) * kstep; const char* b2 = last ? nB : cB + (size_t)(t + 2) * kstep;
            const char* a3 = a2 + kstep; const char* b3 = b2 + kstep;
            if (last && has_next) S.a_ready(nxt);
            if constexpr (SP2) {
            PG8_LDB(B0, 0, 0); PG8_LDB(B1, 0, 1); PG8_SCHED; PG8_LDA(At, 0, 0); PG8_STAGE(PG8_SA(1, 1), a1 + hstep, voffA);
            PG8_WAIT_V(8); PG8_WAIT_L(0); PG8_BAR; PG8_MMA(0, 0, At, B0); PG8_MMA(0, 1, At, B1); PG8_BAR; PG8_SCHED;
            PG8_LDA(At, 0, 1); PG8_STAGE(PG8_SB(0, 0), b2, voffB); PG8_STAGE(PG8_SB(0, 1), b2 + hstep, voffB); PG8_STAGE(PG8_SA(0, 0), a2, voffA);
            PG8_WAIT_V(8); PG8_WAIT_L(0); PG8_BAR; PG8_MMA(1, 0, At, B0); PG8_MMA(1, 1, At, B1); PG8_BAR; PG8_SCHED;
            PG8_LDB(B0, 1, 0); PG8_LDB(B1, 1, 1); PG8_SCHED; PG8_LDA(At, 1, 0); PG8_STAGE(PG8_SA(0, 1), a2 + hstep, voffA);
            PG8_WAIT_V(8); PG8_WAIT_L(0); PG8_BAR; PG8_MMA(0, 0, At, B0); PG8_MMA(0, 1, At, B1); PG8_BAR; PG8_SCHED;
            PG8_LDA(At, 1, 1); PG8_STAGE(PG8_SB(1, 0), b3, voffB); PG8_STAGE(PG8_SB(1, 1), b3 + hstep, voffB); PG8_STAGE(PG8_SA(1, 0), a3, voffA);
            PG8_WAIT_V(8); PG8_WAIT_L(0); PG8_BAR; PG8_MMA(1, 0, At, B0); PG8_MMA(1, 1, At, B1); PG8_BAR; PG8_SCHED;
            } else {
            PG8_LDB(B0, 0, 0); PG8_SCHED; PG8_LDA(At, 0, 0); PG8_STAGE(PG8_SA(1, 1), a1 + hstep, voffA);
            PG8_WAIT_L(8); PG8_BAR; PG8_WAIT_L(0); PG8_MMA(0, 0, At, B0); PG8_BAR; PG8_SCHED;
            PG8_LDB(B1, 0, 1); PG8_STAGE(PG8_SB(0, 0), b2, voffB);
            PG8_BAR; PG8_WAIT_L(0); PG8_MMA(0, 1, At, B1); PG8_BAR;
            PG8_LDA(At, 0, 1); PG8_STAGE(PG8_SA(0, 0), a2, voffA);
            PG8_BAR; PG8_WAIT_L(0); PG8_MMA(1, 0, At, B0); PG8_BAR; PG8_SCHED;
            PG8_STAGE(PG8_SB(0, 1), b2 + hstep, voffB);
            PG8_WAIT_V(6); PG8_BAR; PG8_MMA(1, 1, At, B1); PG8_BAR;
            PG8_LDB(B0, 1, 0); PG8_SCHED; PG8_LDA(At, 1, 0); PG8_STAGE(PG8_SA(0, 1), a2 + hstep, voffA);
            PG8_WAIT_L(8); PG8_BAR; PG8_WAIT_L(0); PG8_MMA(0, 0, At, B0); PG8_BAR; PG8_SCHED;
            PG8_LDB(B1, 1, 1); PG8_STAGE(PG8_SB(1, 0), b3, voffB);
            PG8_BAR; PG8_WAIT_L(0); PG8_MMA(0, 1, At, B1); PG8_BAR;
            PG8_LDA(At, 1, 1); PG8_STAGE(PG8_SA(1, 0), a3, voffA);
            PG8_BAR; PG8_WAIT_L(0); PG8_MMA(1, 0, At, B0); PG8_BAR; PG8_SCHED;
            PG8_STAGE(PG8_SB(1, 1), b3 + hstep, voffB);
            PG8_WAIT_V(6); PG8_BAR; PG8_MMA(1, 1, At, B1); PG8_BAR;
            }
        }
        if constexpr (ALIGN_EPI) { if (wr == 0) PG8_BAR; }
        if constexpr (!Epi::AFTER_DRAIN) { E(acc, cur, wr, wc, fr, fq); S.done(cur); }
        if (!has_next) break;
#pragma unroll
        for (int a = 0; a < 2; ++a)
#pragma unroll
            for (int b = 0; b < 2; ++b)
#pragma unroll
                for (int m = 0; m < 4; ++m)
#pragma unroll
                    for (int n = 0; n < 2; ++n) acc[a][b][m][n] = (f32x4){0.f, 0.f, 0.f, 0.f};
        cur = nxt; cA = nA; cB = nB; ++ui;
        if constexpr (ALIGN_EPI) { if (wr == 1) PG8_BAR; }
    }
    PG8_WAIT_V(0);
    if constexpr (!ALIGN_EPI) { if (wr == 0) PG8_BAR; }
    PG8_BAR;
    if constexpr (Epi::AFTER_DRAIN) { E.fused(acc, cur, wr, wc, fr, fq, lds, wid, lane); S.done(cur); }
#undef PG8_SA
#undef PG8_SB
#undef PG8_STAGE
#undef PG8_LDA
#undef PG8_LDB
#undef PG8_MMA
#undef PG8_WAIT_V
#undef PG8_WAIT_L
#undef PG8_BAR
#undef PG8_SCHED
}
}
#define LAS __attribute__((address_space(3)))
typedef unsigned short bf16;
typedef unsigned v4u __attribute__((ext_vector_type(4)));
typedef unsigned v2u __attribute__((ext_vector_type(2)));
typedef float f32x4 __attribute__((ext_vector_type(4)));
typedef float f32x2 __attribute__((ext_vector_type(2)));
#define WSYNC() asm volatile("s_waitcnt lgkmcnt(0)" ::: "memory")

constexpr int NT = 512, NWV = 8;
constexpr int TOK = 16384, SEQ = 4096, DM = 2048, FF = 5632, NA = 6912, NB = 4096, INW = 10808;
constexpr int PA_Q = 0, PA_KV = 1024, PA_MQ = 2560, PA_MK = 3584, PA_MV = 4608, PA_MO = 5632, PA_SM = 6656;
constexpr float EPS = 1e-6f;
constexpr size_t MiB = 1u << 20;
constexpr size_t O_BIASA = 64 * 1024, O_BIASB = 128 * 1024, O_GG = 192 * 1024, O_GMX = 200 * 1024, O_DENI = 256 * 1024;
constexpr size_t O_WGU = 1 * MiB, O_WD = 45 * MiB, O_WINA = 67 * MiB, O_WINB = 94 * MiB, O_WBN = 110 * MiB, O_WBM = 114 * MiB, O_WOUT = 118 * MiB, O_WC1K = 126 * MiB, O_WC1V = 127 * MiB;
constexpr size_t O_MQK = 1 * MiB, O_HM = 1 * MiB;
constexpr size_t O_VTS = 67 * MiB, O_VTW = 75 * MiB, O_KCB = 83 * MiB, O_VCT = 83 * MiB + 512 * 1024;
constexpr size_t O_XN = 128 * MiB, O_PA = 192 * MiB, O_H = 192 * MiB, O_MG = 192 * MiB;
constexpr size_t O_ONSA = 408 * MiB, O_WT = 408 * MiB, O_HC = 440 * MiB, O_CBK = 440 * MiB, O_CBV = 456 * MiB, O_CHK = 424 * MiB, O_CHV = 426 * MiB;
constexpr size_t O_SM = 504 * MiB, O_KC = 508 * MiB, O_VC = 509 * MiB, O_SEL = 510 * MiB, O_GA = 510 * MiB + 512 * 1024, O_GLA = 510 * MiB + 768 * 1024, O_GPM = 511 * MiB;
constexpr size_t WS_NEED = 512 * MiB;
constexpr int LDS_BYTES = 147456;

struct Params { const float* in[28]; float* out; unsigned char* ws; int ph_lo, ph_hi; };

__device__ __forceinline__ float bf2f(unsigned short b) { return __uint_as_float(((unsigned)b) << 16); }
__device__ __forceinline__ unsigned f2bf(float f) { unsigned u = __builtin_bit_cast(unsigned, f); return (u + 0x7fffu + ((u >> 16) & 1u)) >> 16; }
__device__ __forceinline__ unsigned pk2(float lo, float hi) { return f2bf(lo) | (f2bf(hi) << 16); }
__device__ __forceinline__ float lo16(unsigned w) { return __uint_as_float(w << 16); }
__device__ __forceinline__ float hi16(unsigned w) { return __uint_as_float(w & 0xffff0000u); }
__device__ __forceinline__ float wave_sum(float v) {
#pragma unroll
    for (int o = 1; o < 64; o <<= 1) v += __shfl_xor(v, o);
    return v;
}
__device__ __forceinline__ float wave_max(float v) {
#pragma unroll
    for (int o = 1; o < 64; o <<= 1) v = fmaxf(v, __shfl_xor(v, o));
    return v;
}
__device__ __forceinline__ float sigmf(float x) { return 1.f / (1.f + __expf(-x)); }

__device__ __forceinline__ void tr_item(const float* W, int ldw, int K, int srccol  , bf16* WT, int outrow0, const float* kscale, float* scr, int k0, int lane) {
#pragma unroll 8
    for (int i = 0; i < 32; ++i) { const int kk = 2 * i + (lane >> 5); float v = 0.f; if (srccol >= 0) v = W[(size_t)(k0 + kk) * ldw + srccol]; if (kscale) v *= kscale[k0 + kk]; scr[kk * 33 + (lane & 31)] = v; }
    WSYNC();
    const int c = lane & 7;
#pragma unroll
    for (int j = 0; j < 4; ++j) { const int n = (lane >> 3) + 8 * j; const float* s = scr + (8 * c) * 33 + n;
        v4u o; o.x = pk2(s[0 * 33], s[1 * 33]); o.y = pk2(s[2 * 33], s[3 * 33]); o.z = pk2(s[4 * 33], s[5 * 33]); o.w = pk2(s[6 * 33], s[7 * 33]);
        *(v4u*)(WT + (size_t)(outrow0 + n) * K + k0 + 8 * c) = o; }
    WSYNC();
}
__device__ __forceinline__ void tr_plain(const float* W, int K, int N, bf16* WT, const float* kscale, float* scr, int item, int lane) {
    const int nblk = N / 32, kb = item / nblk, nb = item % nblk;
    tr_item(W, N, K, nb * 32 + (lane & 31), WT, nb * 32, kscale, scr, kb * 64, lane);
}
__device__ __forceinline__ void tr_gu(const float* Wg, const float* Wu, bf16* WT, const float* kscale, float* scr, int item, int lane) {
    const int nblk = (2 * FF) / 32, kb = item / nblk, nb = item % nblk, n0 = nb * 32, pn = n0 >> 8, within = n0 & 255;
    const float* W = (within >= 128) ? Wu : Wg;
    tr_item(W, FF, DM, pn * 128 + (within & 127) + (lane & 31), WT, n0, kscale, scr, kb * 64, lane);
}
__device__ __forceinline__ int ina_src(int n) {
    if (n < 2560) return n;
    if (n < 5632) return n + 48;
    if (n < 6656) return 5688 + (n - 5632);
    if (n < 6704) return 2560 + (n - 6656);
    if (n < 6708) return 5680 + (n - 6704);
    if (n < 6712) return 5684 + (n - 6708);
    return -1;
}
__device__ __forceinline__ void norm_row(const float* xrow, bf16* orow, int lane) {
    const f32x4* xr = (const f32x4*)xrow + lane; f32x4 v[8]; float s = 0.f;
#pragma unroll
    for (int j = 0; j < 8; ++j) { v[j] = xr[64 * j]; s += (v[j].x * v[j].x + v[j].y * v[j].y) + (v[j].z * v[j].z + v[j].w * v[j].w); }
    const float rstd = rsqrtf(wave_sum(s) * (1.f / DM) + EPS);
    v2u* o8 = (v2u*)orow + lane;
#pragma unroll
    for (int j = 0; j < 8; ++j) { v2u w; w.x = pk2(v[j].x * rstd, v[j].y * rstd); w.y = pk2(v[j].z * rstd, v[j].w * rstd); o8[64 * j] = w; }
}

__device__ __forceinline__ void phase_prologue(const Params& P, unsigned char* lds, int gw, int ngw, int wave, int lane, int tid) {
    unsigned char* ws = P.ws; float* scr = (float*)(lds + wave * 16384);
    constexpr int I_GU = 32 * 352, I_D = 88 * 64, I_A = 32 * 216, I_B = 32 * 128, I_BN = 16 * 64, I_O = 32 * 64, I_C = 32 * 8;
    constexpr int NITEMS = I_GU + I_D + I_A + I_B + 2 * I_BN + I_O + 2 * I_C;
    for (int it = gw; it < NITEMS; it += ngw) {
        int r = it;
        if (r < I_GU) { tr_gu(P.in[2], P.in[3], (bf16*)(ws + O_WGU), P.in[1], scr, r, lane); continue; } r -= I_GU;
        if (r < I_D) { tr_plain(P.in[4], FF, DM, (bf16*)(ws + O_WD), nullptr, scr, r, lane); continue; } r -= I_D;
        if (r < I_A) { const int nblk = NA / 32, kb = r / nblk, nb = r % nblk; tr_item(P.in[6], INW, DM, ina_src(nb * 32 + (lane & 31)), (bf16*)(ws + O_WINA), nb * 32, P.in[5], scr, kb * 64, lane); continue; } r -= I_A;
        if (r < I_B) { const int nblk = NB / 32, kb = r / nblk, nb = r % nblk; tr_item(P.in[6], INW, DM, 6712 + nb * 32 + (lane & 31), (bf16*)(ws + O_WINB), nb * 32, P.in[5], scr, kb * 64, lane); continue; } r -= I_B;
        if (r < I_BN) { tr_plain(P.in[21], 1024, DM, (bf16*)(ws + O_WBN), nullptr, scr, r, lane); continue; } r -= I_BN;
        if (r < I_BN) { tr_plain(P.in[22], 1024, DM, (bf16*)(ws + O_WBM), P.in[20], scr, r, lane); continue; } r -= I_BN;
        if (r < I_O) { tr_plain(P.in[23], DM, DM, (bf16*)(ws + O_WOUT), nullptr, scr, r, lane); continue; } r -= I_O;
        if (r < I_C) { tr_plain(P.in[13], 2048, 256, (bf16*)(ws + O_WC1K), nullptr, scr, r, lane); continue; } r -= I_C;
        tr_plain(P.in[16], 2048, 256, (bf16*)(ws + O_WC1V), nullptr, scr, r, lane);
    }
    { const int gt = gw * 64 + lane, ngt = ngw * 64; float* ba = (float*)(ws + O_BIASA); float* bb = (float*)(ws + O_BIASB);
      for (int n = gt; n < NA; n += ngt) { const int s = ina_src(n); ba[n] = s >= 0 ? P.in[7][s] : 0.f; }
      for (int n = gt; n < NB; n += ngt) bb[n] = P.in[7][6712 + n]; }
    for (int m = gw; m < TOK; m += ngw) norm_row(P.in[0] + (size_t)m * DM, (bf16*)(ws + O_XN) + (size_t)m * DM, lane);
}
__device__ __forceinline__ void phase_norm(const float* src, bf16* dst, int gw, int ngw, int lane) {
    for (int m = gw; m < TOK; m += ngw) norm_row(src + (size_t)m * DM, dst + (size_t)m * DM, lane);
}
__device__ __forceinline__ void phase_conv_ffn2(const Params& P, unsigned char* lds, int gw, int ngw, int wave, int lane) {
    float* scr = (float*)(lds + wave * 16384);
    constexpr int I_GU = 32 * 352, I_D = 88 * 64;
    for (int it = gw; it < I_GU + I_D; it += ngw) {
        if (it < I_GU) tr_gu(P.in[25], P.in[26], (bf16*)(P.ws + O_WGU), P.in[24], scr, it, lane);
        else tr_plain(P.in[27], FF, DM, (bf16*)(P.ws + O_WD), nullptr, scr, it - I_GU, lane);
    }
}

__device__ __forceinline__ void phase_prep(const Params& P, int gw, int ngw, int lane) {
    unsigned char* ws = P.ws; bf16* PA = (bf16*)(ws + O_PA);
    { const float qg = P.in[8][lane] * (0.125f * 1.4426950408889634f), ksg = P.in[10][lane], kwg = P.in[11][lane];
      for (int m = gw; m < TOK; m += ngw) { bf16* pr = PA + (size_t)m * NA;
#pragma unroll 4
        for (int v = 0; v < 24; ++v) { const int col = (v < 16) ? (PA_Q + v * 64) : (v < 20 ? (PA_KV + 2 * 256 + (v - 16) * 64) : (PA_KV + 4 * 256 + (v - 20) * 64));
            const float gn = (v < 16) ? qg : (v < 20 ? ksg : kwg);
            const float x = bf2f(pr[col + lane]); const float ss = wave_sum(x * x); pr[col + lane] = (bf16)f2bf(x * rsqrtf(ss * (1.f / 64.f) + EPS) * gn); } } }
    { const size_t gt = (size_t)gw * 64 + lane, ngt = (size_t)ngw * 64; bf16* CBK = (bf16*)(ws + O_CBK); bf16* CBV = (bf16*)(ws + O_CBV);
      for (size_t idx = gt; idx < (size_t)4096 * 256; idx += ngt) { const int r = (int)(idx >> 8), k8 = (int)(idx & 255) * 8, l = k8 >> 6, d = k8 & 63;
        v4u ok = (v4u){0u, 0u, 0u, 0u}, ov = ok;
        if (r < 4080) { const int bg = r / 255, c = r % 255, b = bg >> 2, g = bg & 3; const bf16* src = PA + ((size_t)b * SEQ + 16 * c + l) * NA + PA_KV + g * 64 + d;
            const v4u kw = *(const v4u*)src, vw = *(const v4u*)(src + 256); const float* pk = P.in[12] + l * 64 + d; const float* pv = P.in[15] + l * 64 + d;
            ok.x = pk2(lo16(kw.x) + pk[0], hi16(kw.x) + pk[1]); ok.y = pk2(lo16(kw.y) + pk[2], hi16(kw.y) + pk[3]); ok.z = pk2(lo16(kw.z) + pk[4], hi16(kw.z) + pk[5]); ok.w = pk2(lo16(kw.w) + pk[6], hi16(kw.w) + pk[7]);
            ov.x = pk2(lo16(vw.x) + pv[0], hi16(vw.x) + pv[1]); ov.y = pk2(lo16(vw.y) + pv[2], hi16(vw.y) + pv[3]); ov.z = pk2(lo16(vw.z) + pv[4], hi16(vw.z) + pv[5]); ov.w = pk2(lo16(vw.w) + pv[6], hi16(vw.w) + pv[7]); }
        *(v4u*)(CBK + (size_t)r * 2048 + k8) = ok; *(v4u*)(CBV + (size_t)r * 2048 + k8) = ov; } }
    { const size_t gt = (size_t)gw * 64 + lane, ngt = (size_t)ngw * 64; bf16* MQK = (bf16*)(ws + O_MQK); const float* cw = P.in[18]; const float* cb = P.in[19];
      for (size_t idx = gt; idx < (size_t)TOK * 256; idx += ngt) { const int m = (int)(idx >> 8), c8 = (int)(idx & 255) * 8, t = m & (SEQ - 1);
        float a[8];
#pragma unroll
        for (int i = 0; i < 8; ++i) a[i] = cb[c8 + i];
#pragma unroll
        for (int j = 0; j < 4; ++j) { const int tt = t - 3 + j; if (tt >= 0) { const v4u w = *(const v4u*)(PA + (size_t)(m - 3 + j) * NA + PA_MQ + c8); const float* wj = cw + j * 2048 + c8;
            a[0] += wj[0] * lo16(w.x); a[1] += wj[1] * hi16(w.x); a[2] += wj[2] * lo16(w.y); a[3] += wj[3] * hi16(w.y); a[4] += wj[4] * lo16(w.z); a[5] += wj[5] * hi16(w.z); a[6] += wj[6] * lo16(w.w); a[7] += wj[7] * hi16(w.w); } }
#pragma unroll
        for (int i = 0; i < 8; ++i) a[i] = a[i] * sigmf(a[i]);
        v4u o; o.x = pk2(a[0], a[1]); o.y = pk2(a[2], a[3]); o.z = pk2(a[4], a[5]); o.w = pk2(a[6], a[7]);
        *(v4u*)(MQK + (size_t)m * 2048 + c8) = o; } }
    { const bf16* PAc = (const bf16*)(ws + O_PA);
      for (int it = gw; it < 2048; it += ngw) { const int j = it & 1, g = (it >> 1) & 3, tb = (it >> 3) & 63, b = it >> 9; const int bg = b * 4 + g;
        const bf16* src = PAc + ((size_t)b * SEQ + 64 * tb + lane) * NA + PA_KV + (j ? 5 : 3) * 256 + g * 64; bf16* dst = (bf16*)(ws + (j ? O_VTW : O_VTS)) + (size_t)bg * 64 * SEQ + 64 * tb + lane;
#pragma unroll
        for (int d8 = 0; d8 < 8; ++d8) { const v4u w = *(const v4u*)(src + 8 * d8);
            dst[(size_t)(8 * d8 + 0) * SEQ] = (bf16)(w.x & 0xffffu); dst[(size_t)(8 * d8 + 1) * SEQ] = (bf16)(w.x >> 16); dst[(size_t)(8 * d8 + 2) * SEQ] = (bf16)(w.y & 0xffffu); dst[(size_t)(8 * d8 + 3) * SEQ] = (bf16)(w.y >> 16);
            dst[(size_t)(8 * d8 + 4) * SEQ] = (bf16)(w.z & 0xffffu); dst[(size_t)(8 * d8 + 5) * SEQ] = (bf16)(w.z >> 16); dst[(size_t)(8 * d8 + 6) * SEQ] = (bf16)(w.w & 0xffffu); dst[(size_t)(8 * d8 + 7) * SEQ] = (bf16)(w.w >> 16); } } }
    { const float* SM = (const float*)(ws + O_SM); float* GA = (float*)(ws + O_GA); float* GLA = (float*)(ws + O_GLA); float* GPM = (float*)(ws + O_GPM); float* GG = (float*)(ws + O_GG); float* GMX = (float*)(ws + O_GMX);
      for (int it = gw; it < 1024; it += ngw) { const int bh = it >> 6, c = it & 63, b = bh >> 2, h = bh & 3; const size_t m = (size_t)b * SEQ + 64 * c + lane;
        const float ip = SM[m * 64 + 48 + h], fp = SM[m * 64 + 52 + h];
        const float lf = fminf(fp, 0.f) - log1pf(__expf(-fabsf(fp)));
        float a = lf;
#pragma unroll
        for (int o = 1; o < 64; o <<= 1) { const float y = __shfl_up(a, o); if (lane >= o) a += y; }
        const float g = __shfl(a, 63); const float la = ip - a; const float mx = wave_max(g + la);
        float pm = la;
#pragma unroll
        for (int o = 1; o < 64; o <<= 1) { const float y = __shfl_up(pm, o); if (lane >= o) pm = fmaxf(pm, y); }
        const size_t o1 = (size_t)bh * SEQ + 64 * c + lane; GA[o1] = a; GLA[o1] = la; GPM[o1] = a + pm;
        if (lane == 0) { GG[it] = g; GMX[it] = mx; } } }
}

__device__ __forceinline__ void phase_cmp2(const Params& P, int gw, int ngw, int lane) {
    unsigned char* ws = P.ws;
    for (int it = gw; it < 2 * 4080; it += ngw) { const int kv = it / 4080, r = it % 4080; const bf16* ch = (const bf16*)(ws + (kv ? O_CHV : O_CHK)) + (size_t)r * 256; const float* w2 = P.in[kv ? 17 : 14];
        float acc = 0.f;
        for (int hh = 0; hh < 256; hh += 8) { const v4u w = *(const v4u*)(ch + hh);
            acc += lo16(w.x) * w2[(hh + 0) * 64 + lane]; acc += hi16(w.x) * w2[(hh + 1) * 64 + lane]; acc += lo16(w.y) * w2[(hh + 2) * 64 + lane]; acc += hi16(w.y) * w2[(hh + 3) * 64 + lane];
            acc += lo16(w.z) * w2[(hh + 4) * 64 + lane]; acc += hi16(w.z) * w2[(hh + 5) * 64 + lane]; acc += lo16(w.w) * w2[(hh + 6) * 64 + lane]; acc += hi16(w.w) * w2[(hh + 7) * 64 + lane]; }
        const int bg = r / 255, c = r % 255;
        if (kv == 0) { const float ss = wave_sum(acc * acc); acc = acc * rsqrtf(ss * (1.f / 64.f) + EPS) * P.in[9][lane]; ((bf16*)(ws + O_KCB))[((size_t)bg * 256 + c) * 64 + lane] = (bf16)f2bf(acc); }
        else ((bf16*)(ws + O_VCT))[((size_t)bg * 64 + lane) * 256 + c] = (bf16)f2bf(acc); }
    for (int it = gw; it < 16; it += ngw) { ((bf16*)(ws + O_KCB))[((size_t)it * 256 + 255) * 64 + lane] = 0; ((bf16*)(ws + O_VCT))[((size_t)it * 64 + lane) * 256 + 255] = 0; }
}

__device__ __forceinline__ void mlstm_intra_item(const Params& P, unsigned char* lds, int it, int tid) {
    unsigned char* ws = P.ws; const int bh = it >> 6, c = it & 63, b = bh >> 2, h = bh & 3;
    bf16* QL = (bf16*)lds; bf16* KL = (bf16*)(lds + 33792); float* SCA = (float*)(lds + 67584);
    const bf16* MQK = (const bf16*)(ws + O_MQK); const size_t row0 = (size_t)b * SEQ + 64 * c;
    __syncthreads();
#pragma unroll
    for (int p = 0; p < 4; ++p) { const int idx = p * NT + tid, r = idx >> 5, c8 = (idx & 31) * 8; const bf16* src = MQK + (row0 + r) * 2048 + h * 256 + c8;
        *(v4u*)(QL + r * 264 + c8) = *(const v4u*)src; *(v4u*)(KL + r * 264 + c8) = *(const v4u*)(src + 1024); }
    float mprev = 0.f; { const float* GG = (const float*)(ws + O_GG) + bh * 64; const float* GMX = (const float*)(ws + O_GMX) + bh * 64; for (int cc = 0; cc < c; ++cc) mprev = fmaxf(GG[cc] + mprev, GMX[cc]); }
    if (tid < 64) { const size_t o1 = (size_t)bh * SEQ + 64 * c + tid; const float a = ((const float*)(ws + O_GA))[o1], la = ((const float*)(ws + O_GLA))[o1], mi = ((const float*)(ws + O_GPM))[o1];
        SCA[tid] = a; SCA[64 + tid] = la; SCA[128 + tid] = fmaxf(a + mprev, mi); }
    __syncthreads();
    const int j = tid >> 3, s0 = tid & 7; float d[8];
#pragma unroll
    for (int i = 0; i < 8; ++i) d[i] = 0.f;
    for (int d8 = 0; d8 < 256; d8 += 8) { const v4u qw = *(const v4u*)(QL + j * 264 + d8);
        const float q0 = lo16(qw.x), q1 = hi16(qw.x), q2 = lo16(qw.y), q3 = hi16(qw.y), q4 = lo16(qw.z), q5 = hi16(qw.z), q6 = lo16(qw.w), q7 = hi16(qw.w);
#pragma unroll
        for (int i = 0; i < 8; ++i) { const v4u kw = *(const v4u*)(KL + (s0 + 8 * i) * 264 + d8);
            d[i] += q0 * lo16(kw.x) + q1 * hi16(kw.x) + q2 * lo16(kw.y) + q3 * hi16(kw.y) + q4 * lo16(kw.z) + q5 * hi16(kw.z) + q6 * lo16(kw.w) + q7 * hi16(kw.w); } }
    const float aj = SCA[j], mc = SCA[128 + j]; float rs = 0.f; float* WT = (float*)(ws + O_WT) + (size_t)it * 4096 + j * 64;
#pragma unroll
    for (int i = 0; i < 8; ++i) { const int s = s0 + 8 * i; const float w = (s <= j) ? __expf(aj + SCA[64 + s] - mc) * d[i] * 0.0625f : 0.f; WT[s] = w; rs += w; }
    rs += __shfl_xor(rs, 1); rs += __shfl_xor(rs, 2); rs += __shfl_xor(rs, 4);
    if (s0 == 0) ((float*)(ws + O_DENI))[(size_t)bh * SEQ + 64 * c + j] = rs;
}

__device__ __forceinline__ void mlstm_scan_item(const Params& P, unsigned char* lds, int it, int tid) {
    unsigned char* ws = P.ws; const int bh = it >> 4, es = it & 15, b = bh >> 2, h = bh & 3;
    bf16* QL = (bf16*)lds; bf16* KL = (bf16*)(lds + 33792); float* VL = (float*)(lds + 67584); float* WL = (float*)(lds + 71680); float* CL = (float*)(lds + 88320); float* NL = (float*)(lds + 104704);
    float* SU = (float*)(lds + 105728); float* SSI = SU + 64; float* SMC = SU + 128; float* SDN = SU + 192;
    const bf16* MQK = (const bf16*)(ws + O_MQK); const bf16* PA = (const bf16*)(ws + O_PA); const float* WT = (const float*)(ws + O_WT); float* HC = (float*)(ws + O_HC);
    const float* GG = (const float*)(ws + O_GG) + bh * 64; const float* GMX = (const float*)(ws + O_GMX) + bh * 64;
    float C[8]; float nn = 0.f; float mst = 0.f;
#pragma unroll
    for (int i = 0; i < 8; ++i) C[i] = 0.f;
    const int ud = tid >> 1, ue = (tid & 1) * 8;
    const int oj = tid >> 3, oe = (tid & 7) * 2, oq = tid & 7;
    for (int c = 0; c < 64; ++c) {
        const size_t row0 = (size_t)b * SEQ + 64 * c;
        __syncthreads();
#pragma unroll
        for (int p = 0; p < 4; ++p) { const int idx = p * NT + tid, r = idx >> 5, c8 = (idx & 31) * 8; const bf16* src = MQK + (row0 + r) * 2048 + h * 256 + c8;
            *(v4u*)(QL + r * 264 + c8) = *(const v4u*)src; *(v4u*)(KL + r * 264 + c8) = *(const v4u*)(src + 1024); }
        { const v2u* vs = (const v2u*)(PA + (row0 + oj) * NA + PA_MV + h * 256 + es * 16 + oe); const unsigned w = *(const unsigned*)vs; VL[oj * 16 + oe] = lo16(w); VL[oj * 16 + oe + 1] = hi16(w); }
#pragma unroll
        for (int p = 0; p < 8; ++p) { const int idx = p * NT + tid; WL[(idx >> 6) * 65 + (idx & 63)] = WT[(size_t)(bh * 64 + c) * 4096 + idx]; }
        const float g = GG[c], mx = GMX[c]; const float mnew = fmaxf(g + mst, mx); const float dec = __expf(g + mst - mnew);
        if (tid < 64) { const size_t o1 = (size_t)bh * SEQ + 64 * c + tid; const float a = ((const float*)(ws + O_GA))[o1], la = ((const float*)(ws + O_GLA))[o1], mi = ((const float*)(ws + O_GPM))[o1];
            const float mc = fmaxf(a + mst, mi); SU[tid] = __expf(g + la - mnew) * 0.0625f; SSI[tid] = __expf(a + mst - mc); SMC[tid] = __expf(-mc); SDN[tid] = ((const float*)(ws + O_DENI))[o1]; }
#pragma unroll
        for (int i = 0; i < 8; ++i) CL[ud * 16 + ue + i] = C[i];
        if ((tid & 1) == 0) NL[ud] = nn;
        __syncthreads();
        { float n0 = 0.f, n1 = 0.f, dn = 0.f;
          for (int d8 = 0; d8 < 256; d8 += 8) { const v4u qw = *(const v4u*)(QL + oj * 264 + d8); float q[8] = {lo16(qw.x), hi16(qw.x), lo16(qw.y), hi16(qw.y), lo16(qw.z), hi16(qw.z), lo16(qw.w), hi16(qw.w)};
#pragma unroll
              for (int i = 0; i < 8; ++i) { const f32x2 cv = *(const f32x2*)(CL + (d8 + i) * 16 + oe); n0 += q[i] * cv.x; n1 += q[i] * cv.y; } }
          { const int db = oq * 32;
#pragma unroll
            for (int d8 = 0; d8 < 32; d8 += 8) { const v4u qw = *(const v4u*)(QL + oj * 264 + db + d8); const float* np = NL + db + d8;
                dn += lo16(qw.x) * np[0] + hi16(qw.x) * np[1] + lo16(qw.y) * np[2] + hi16(qw.y) * np[3] + lo16(qw.z) * np[4] + hi16(qw.z) * np[5] + lo16(qw.w) * np[6] + hi16(qw.w) * np[7]; } }
          dn += __shfl_xor(dn, 1); dn += __shfl_xor(dn, 2); dn += __shfl_xor(dn, 4);
          float i0 = 0.f, i1 = 0.f;
          for (int s = 0; s < 64; ++s) { const float w = WL[oj * 65 + s]; const f32x2 vv = *(const f32x2*)(VL + s * 16 + oe); i0 += w * vv.x; i1 += w * vv.y; }
          const float si = SSI[oj]; const float den = fmaxf(fabsf(si * dn + SDN[oj]), SMC[oj]); const float inv = 1.f / den;
          f32x2 o; o.x = (si * n0 + i0) * inv; o.y = (si * n1 + i1) * inv;
          *(f32x2*)(HC + (row0 + oj) * 1024 + h * 256 + es * 16 + oe) = o; }
        { float kacc = 0.f;
#pragma unroll
          for (int i = 0; i < 8; ++i) C[i] *= dec;
          for (int s = 0; s < 64; ++s) { const float kk = bf2f(KL[s * 264 + ud]) * SU[s]; kacc += kk; const f32x4 v0 = *(const f32x4*)(VL + s * 16 + ue), v1 = *(const f32x4*)(VL + s * 16 + ue + 4);
              C[0] += kk * v0.x; C[1] += kk * v0.y; C[2] += kk * v0.z; C[3] += kk * v0.w; C[4] += kk * v1.x; C[5] += kk * v1.y; C[6] += kk * v1.z; C[7] += kk * v1.w; }
          nn = dec * nn + kacc; }
        mst = mnew;
    }
}
typedef float f32x16 __attribute__((ext_vector_type(16)));
typedef short bf16x8 __attribute__((ext_vector_type(8)));
constexpr int NSA_KL = 0, NSA_VL = 9216, NSA_IMP = 27648, NSA_SEL = 93184, NSA_FAC = 94208, NSA_VALS = 96256;
__device__ __forceinline__ unsigned cvtpk(float lo, float hi) { unsigned r; asm volatile("v_cvt_pk_bf16_f32 %0, %1, %2" : "=v"(r) : "v"(lo), "v"(hi)); return r; }
__device__ __forceinline__ int crow(int r, int hi) { return (r & 3) + 8 * (r >> 2) + 4 * hi; }
template <int ND>
__device__ __forceinline__ void nsa_tile(const bf16* KL, const bf16* VL, const bf16x8 (&qr)[4], float negM, int klo, int khi, float& lsum, f32x16 (&o)[4], int r32, int hi) {
    f32x16 p0, p1; { float nm = negM; asm volatile("" : "+v"(nm));
#pragma unroll
    for (int r = 0; r < 16; ++r) { p0[r] = nm; p1[r] = nm; } }
#pragma unroll
    for (int d0 = 0; d0 < 4; ++d0) { const bf16x8 k0 = *(const bf16x8*)(KL + r32 * 72 + 16 * d0 + 8 * hi), k1 = *(const bf16x8*)(KL + (32 + r32) * 72 + 16 * d0 + 8 * hi);
        p0 = __builtin_amdgcn_mfma_f32_32x32x16_bf16(k0, qr[d0], p0, 0, 0, 0); p1 = __builtin_amdgcn_mfma_f32_32x32x16_bf16(k1, qr[d0], p1, 0, 0, 0); }
    __builtin_amdgcn_sched_barrier(0);
    const int lo2 = klo - 4 * hi, hi2 = khi - 4 * hi; float ls = 0.f;
#pragma unroll
    for (int r = 0; r < 16; ++r) { const int cr = (r & 3) + 8 * (r >> 2);
        p0[r] = (cr > lo2 && cr <= hi2) ? __builtin_amdgcn_exp2f(p0[r]) : 0.f; p1[r] = (cr + 32 > lo2 && cr + 32 <= hi2) ? __builtin_amdgcn_exp2f(p1[r]) : 0.f; ls += p0[r] + p1[r]; }
    lsum += ls;
    bf16x8 pf[4];
    { v4u w; w.x = cvtpk(p0[0], p0[1]); w.y = cvtpk(p0[2], p0[3]); w.z = cvtpk(p0[4], p0[5]); w.w = cvtpk(p0[6], p0[7]); pf[0] = __builtin_bit_cast(bf16x8, w);
      w.x = cvtpk(p0[8], p0[9]); w.y = cvtpk(p0[10], p0[11]); w.z = cvtpk(p0[12], p0[13]); w.w = cvtpk(p0[14], p0[15]); pf[1] = __builtin_bit_cast(bf16x8, w);
      w.x = cvtpk(p1[0], p1[1]); w.y = cvtpk(p1[2], p1[3]); w.z = cvtpk(p1[4], p1[5]); w.w = cvtpk(p1[6], p1[7]); pf[2] = __builtin_bit_cast(bf16x8, w);
      w.x = cvtpk(p1[8], p1[9]); w.y = cvtpk(p1[10], p1[11]); w.z = cvtpk(p1[12], p1[13]); w.w = cvtpk(p1[14], p1[15]); pf[3] = __builtin_bit_cast(bf16x8, w); }
    __builtin_amdgcn_sched_barrier(0);
#pragma unroll
    for (int d0 = 0; d0 < ND; ++d0) {
#pragma unroll
        for (int ks = 0; ks < 4; ++ks) { const bf16* vp = VL + (32 * d0 + r32) * 72 + 16 * ks + 4 * hi; const v2u a = *(const v2u*)vp, b2 = *(const v2u*)(vp + 8);
            const v4u w = (v4u){a.x, a.y, b2.x, b2.y}; o[d0] = __builtin_amdgcn_mfma_f32_32x32x16_bf16(pf[ks], __builtin_bit_cast(bf16x8, w), o[d0], 0, 0, 0); }
        __builtin_amdgcn_sched_barrier(0); }
}
__device__ __forceinline__ void nsa_unit(const Params& P, unsigned char* lds, int bg, int qi, int tid, int lane, int wave, float negMc, float negMs, float negMw) {
    asm volatile("" : "+v"(lane), "+v"(tid));
    unsigned char* ws = P.ws; const int b = bg >> 2, g = bg & 3, r32 = lane & 31, hi = lane >> 5, head = wave >> 1, half = wave & 1;
    const int tq = 64 * qi + 32 * half + r32;
    bf16* KL = (bf16*)(lds + NSA_KL); bf16* VL = (bf16*)(lds + NSA_VL); float* IMP = (float*)(lds + NSA_IMP); unsigned long long* SEL = (unsigned long long*)(lds + NSA_SEL);
    float* FAC = (float*)(lds + NSA_FAC) + wave * 64; float* VALS = (float*)(lds + NSA_VALS) + wave * 64;
    const bf16* PA = (const bf16*)(ws + O_PA); const size_t rowq = (size_t)b * SEQ + tq;
    bf16x8 qr[4]; { const bf16* qp = PA + rowq * NA + PA_Q + (g * 4 + head) * 64 + 8 * hi;
#pragma unroll
        for (int d0 = 0; d0 < 4; ++d0) qr[d0] = *(const bf16x8*)(qp + 16 * d0); }
    const int ldr = tid >> 3, ldc8 = (tid & 7) * 8;
    float* OSW = (float*)(lds + NSA_IMP) + wave * 2048 + r32;
    f32x16 o[4];
    __syncthreads();
    if (tid == 0) SEL[64] = 0ull;
    {
#pragma unroll
        for (int d0 = 0; d0 < 4; ++d0)
#pragma unroll
            for (int r = 0; r < 16; ++r) o[d0][r] = 0.f;
        const bf16* Kc = (const bf16*)(ws + O_KCB) + (size_t)bg * 256 * 64; const bf16* Vc = (const bf16*)(ws + O_VCT) + (size_t)bg * 64 * 256;
        const int ntile = ((4 * qi + 2) >> 6) + 1; const int cmaxq = (tq >= 31) ? ((tq - 31) >> 4) : -1; float lsum = 0.f;
        v4u kreg = *(const v4u*)(Kc + (size_t)ldr * 64 + ldc8), vreg = *(const v4u*)(Vc + (size_t)ldr * 256 + ldc8);
        for (int tl = 0; tl < ntile; ++tl) {
            __syncthreads();
            *(v4u*)(KL + ldr * 72 + ldc8) = kreg; *(v4u*)(VL + ldr * 72 + ldc8) = vreg;
            { const int cb = 64 * tl + ldc8, lo_ = 4 * ldr - 1, hi_ = (4 * ldr + 3 < 254) ? 4 * ldr + 3 : 254;
#define OVB(j) (((cb + (j)) >= lo_ && (cb + (j)) <= hi_) ? 0x3F80u : 0u)
              v4u w; w.x = OVB(0) | (OVB(1) << 16); w.y = OVB(2) | (OVB(3) << 16); w.z = OVB(4) | (OVB(5) << 16); w.w = OVB(6) | (OVB(7) << 16);
#undef OVB
              *(v4u*)(VL + (64 + ldr) * 72 + ldc8) = w; }
            __syncthreads();
            if (tl + 1 < ntile) { kreg = *(const v4u*)(Kc + (size_t)(64 * (tl + 1) + ldr) * 64 + ldc8); vreg = *(const v4u*)(Vc + (size_t)ldr * 256 + 64 * (tl + 1) + ldc8); }
            nsa_tile<4>(KL, VL, qr, negMc, -1, cmaxq - 64 * tl, lsum, o, r32, hi);
        }
        lsum += __shfl_xor(lsum, 32); const float inv = lsum > 0.f ? 1.f / lsum : 0.f;
        if (hi == 0) { FAC[r32] = inv * sigmf(((const float*)(ws + O_SM))[rowq * 64 + (g * 4 + head) * 3 + 0]); FAC[32 + r32] = inv; }
        WSYNC();
#pragma unroll
        for (int r = 0; r < 16; ++r) { const int q = crow(r, hi); const float f = FAC[q], f2 = FAC[32 + q];
            o[0][r] *= f; o[1][r] *= f;
            float* ip = IMP + ((size_t)head * 64 + 32 * half + q) * 64 + r32; ip[0] = o[2][r] * f2; ip[32] = o[3][r] * f2; }
        __syncthreads();
#pragma unroll 1
        for (int tk = 0; tk < 8; ++tk) { const int tok = 8 * wave + tk; const float* ip = IMP + (size_t)tok * 64 + lane;
            const float impv = ip[0] + ip[4096] + ip[8192] + ip[12288];
            const float val = (lane == 0 || lane == qi || lane == qi - 1) ? 1e4f : ((lane <= qi) ? impv : -1.f);
            VALS[lane] = val; WSYNC();
            int rank = 0;
#pragma unroll 8
            for (int m = 0; m < 64; ++m) { const float vm = VALS[m]; rank += (vm > val || (vm == val && m < lane)) ? 1 : 0; }
            const unsigned long long mask = __ballot(rank < 16 && lane <= qi);
            if (lane == 0) { SEL[tok] = mask; atomicOr(&SEL[64], mask); }
            WSYNC(); }
        __syncthreads();
#pragma unroll
        for (int r = 0; r < 16; ++r) { float* op = OSW + crow(r, hi) * 64; op[0] = o[0][r]; op[32] = o[1][r]; }
    }
    {
        const unsigned long long mysel = SEL[32 * half + r32]; unsigned long long om = SEL[64];
#pragma unroll
        for (int d0 = 0; d0 < 2; ++d0)
#pragma unroll
            for (int r = 0; r < 16; ++r) o[d0][r] = 0.f;
        const bf16* Ks = PA + (size_t)b * SEQ * NA + PA_KV + 2 * 256 + g * 64; const bf16* Vs = (const bf16*)(ws + O_VTS) + (size_t)bg * 64 * SEQ; float lsum = 0.f;
        int n = __builtin_ctzll(om); om &= om - 1;
        v4u kreg = *(const v4u*)(Ks + (size_t)(64 * n + ldr) * NA + ldc8), vreg = *(const v4u*)(Vs + (size_t)ldr * SEQ + 64 * n + ldc8);
        for (;;) {
            __syncthreads();
            *(v4u*)(KL + ldr * 72 + ldc8) = kreg; *(v4u*)(VL + ldr * 72 + ldc8) = vreg;
            __syncthreads();
            const int ncur = n; const bool more = om != 0ull;
            if (more) { n = __builtin_ctzll(om); om &= om - 1; kreg = *(const v4u*)(Ks + (size_t)(64 * n + ldr) * NA + ldc8); vreg = *(const v4u*)(Vs + (size_t)ldr * SEQ + 64 * n + ldc8); }
            const bool selb = (mysel >> ncur) & 1ull;
            if (__any(selb)) nsa_tile<2>(KL, VL, qr, negMs, -1, selb ? (tq - 64 * ncur) : -1000, lsum, o, r32, hi);
            if (!more) break;
        }
        lsum += __shfl_xor(lsum, 32); const float inv = lsum > 0.f ? 1.f / lsum : 0.f;
        WSYNC(); if (hi == 0) FAC[r32] = inv * sigmf(((const float*)(ws + O_SM))[rowq * 64 + (g * 4 + head) * 3 + 1]); WSYNC();
#pragma unroll
        for (int r = 0; r < 16; ++r) { const int q = crow(r, hi); const float f = FAC[q]; float* op = OSW + q * 64; op[0] += o[0][r] * f; op[32] += o[1][r] * f; }
    }
    {
#pragma unroll
        for (int d0 = 0; d0 < 2; ++d0)
#pragma unroll
            for (int r = 0; r < 16; ++r) o[d0][r] = 0.f;
        const bf16* Kw = PA + (size_t)b * SEQ * NA + PA_KV + 4 * 256 + g * 64; const bf16* Vw = (const bf16*)(ws + O_VTW) + (size_t)bg * 64 * SEQ; float lsum = 0.f;
        const int n0 = qi >= 8 ? qi - 8 : 0;
        v4u kreg = *(const v4u*)(Kw + (size_t)(64 * n0 + ldr) * NA + ldc8), vreg = *(const v4u*)(Vw + (size_t)ldr * SEQ + 64 * n0 + ldc8);
        for (int n = n0; n <= qi; ++n) {
            __syncthreads();
            *(v4u*)(KL + ldr * 72 + ldc8) = kreg; *(v4u*)(VL + ldr * 72 + ldc8) = vreg;
            __syncthreads();
            if (n < qi) { kreg = *(const v4u*)(Kw + (size_t)(64 * (n + 1) + ldr) * NA + ldc8); vreg = *(const v4u*)(Vw + (size_t)ldr * SEQ + 64 * (n + 1) + ldc8); }
            nsa_tile<2>(KL, VL, qr, negMw, tq - 512 - 64 * n, tq - 64 * n, lsum, o, r32, hi);
        }
        lsum += __shfl_xor(lsum, 32); const float inv = lsum > 0.f ? 1.f / lsum : 0.f;
        WSYNC(); if (hi == 0) FAC[r32] = inv * sigmf(((const float*)(ws + O_SM))[rowq * 64 + (g * 4 + head) * 3 + 2]); WSYNC();
#pragma unroll
        for (int r = 0; r < 16; ++r) { const int q = crow(r, hi); const float f = FAC[q]; float* op = OSW + q * 64; op[0] += o[0][r] * f; op[32] += o[1][r] * f; }
    }
    { bf16* ON = (bf16*)(ws + O_ONSA) + ((size_t)b * SEQ + 64 * qi + 32 * half) * 1024 + (g * 4 + head) * 64 + r32;
#pragma unroll
      for (int r = 0; r < 16; ++r) { const int q = crow(r, hi); bf16* op = ON + (size_t)q * 1024; op[0] = (bf16)f2bf(OSW[q * 64]); op[32] = (bf16)f2bf(OSW[q * 64 + 32]); } }
}
__device__ __forceinline__ void hm_item(const Params& P, int it, int lane) {
    unsigned char* ws = P.ws; const int row = it >> 2, h = it & 3;
    const f32x4 hc = *(const f32x4*)((const float*)(ws + O_HC) + (size_t)row * 1024 + h * 256 + 4 * lane);
    const float ss = wave_sum(hc.x * hc.x + hc.y * hc.y + hc.z * hc.z + hc.w * hc.w); const float rstd = rsqrtf(ss * (1.f / 256.f) + EPS);
    const v2u mo = *(const v2u*)((const bf16*)(ws + O_PA) + (size_t)row * NA + PA_MO + h * 256 + 4 * lane);
    v2u o; o.x = pk2(sigmf(lo16(mo.x)) * hc.x * rstd, sigmf(hi16(mo.x)) * hc.y * rstd); o.y = pk2(sigmf(lo16(mo.y)) * hc.z * rstd, sigmf(hi16(mo.y)) * hc.w * rstd);
    *(v2u*)((bf16*)(ws + O_HM) + (size_t)row * 1024 + h * 256 + 4 * lane) = o;
}

constexpr int N_PHASES = 16;
__global__ void __launch_bounds__(NT, 2) mk_fwd(Params P) {
    extern __shared__ __attribute__((aligned(16))) unsigned char lds[];
    cg::grid_group grid = cg::this_grid();
    const int G = gridDim.x, bx = blockIdx.x, ngw = G * NWV;
#define TIDS() int tid = threadIdx.x; asm volatile("" : "+v"(tid)); const int lane = tid & 63, wave = __builtin_amdgcn_readfirstlane(tid >> 6), gw = bx * NWV + wave; (void)gw; (void)lane
    unsigned char* ws = P.ws; const int lo = P.ph_lo, hi = P.ph_hi;
    PG8_LAS unsigned char* lds3 = (PG8_LAS unsigned char*)lds;
#define IN(k) (lo <= (k) && (k) < hi)
#define SEAM(k) do { if (IN(k) && IN((k) + 1)) grid.sync(); } while (0)
#define GEMM(EPI, Aoff, Boff, MM, NN, KK, E) do { pg8::Gemm g_{(const pg8::bf16_t*)(ws + (Aoff)), (const pg8::bf16_t*)(ws + (Boff)), (MM), (NN), (KK)}; pg8::StaticOrder S_; S_.init((MM), (NN), G, bx); \
        pg8::gemm_phase<EPI, pg8::StaticOrder, true, true>(lds3, g_, S_, (E)); } while (0)
    if (IN(0)) { TIDS(); phase_prologue(P, lds, gw, ngw, wave, lane, tid); } SEAM(0);
    if (IN(1)) { pg8::EpiP<0> E{(pg8::bf16_t*)(ws + O_H), FF, nullptr, nullptr, 0, nullptr}; GEMM(pg8::EpiP<0>, O_XN, O_WGU, TOK, 2 * FF, DM, E); } SEAM(1);
    if (IN(2)) { pg8::EpiResid E{P.in[0], P.out, DM, 0.5f}; GEMM(pg8::EpiResid, O_H, O_WD, TOK, DM, FF, E); } SEAM(2);
    if (IN(3)) { TIDS(); phase_norm(P.out, (bf16*)(ws + O_XN), gw, ngw, lane); } SEAM(3);
    if (IN(4)) { pg8::EpiP<1> E{(pg8::bf16_t*)(ws + O_PA), NA, (const float*)(ws + O_BIASA), nullptr, 0, (float*)(ws + O_SM)}; GEMM(pg8::EpiP<1>, O_XN, O_WINA, TOK, NA, DM, E); } SEAM(4);
    if (IN(5)) { TIDS(); phase_prep(P, gw, ngw, lane); } SEAM(5);
    if (IN(6)) {
        { pg8::EpiP<3> E{(pg8::bf16_t*)(ws + O_CHK), 256, nullptr, nullptr, 0, nullptr}; GEMM(pg8::EpiP<3>, O_CBK, O_WC1K, 4096, 256, 2048, E); }
        { pg8::EpiP<3> E{(pg8::bf16_t*)(ws + O_CHV), 256, nullptr, nullptr, 0, nullptr}; GEMM(pg8::EpiP<3>, O_CBV, O_WC1V, 4096, 256, 2048, E); }
        { TIDS(); for (int it = bx; it < 1024; it += G) mlstm_intra_item(P, lds, it, tid); }
    } SEAM(6);
    if (IN(7)) { TIDS(); phase_cmp2(P, gw, ngw, lane); for (int it = bx; it < 256; it += G) mlstm_scan_item(P, lds, it, tid); } SEAM(7);
    if (IN(8)) { TIDS();
#define UNI(x) __builtin_bit_cast(float, __builtin_amdgcn_readfirstlane(__builtin_bit_cast(int, (x))))
        const float mq = UNI(wave_max(fabsf(P.in[8][lane]))) * (8.f * 1.4426950408889634f);
        const float negMc = -mq * UNI(wave_max(fabsf(P.in[9][lane]))), negMs = -mq * UNI(wave_max(fabsf(P.in[10][lane]))), negMw = -mq * UNI(wave_max(fabsf(P.in[11][lane])));
#undef UNI
        for (int u = bx; u < 1024; u += G) { const int bg = u & 15, jj = (u >> 4) & 15, k = u >> 8; const int qi = (k == 0) ? jj : (k == 1) ? 31 - jj : (k == 2) ? 32 + jj : 63 - jj; nsa_unit(P, lds, bg, qi, tid, lane, wave, negMc, negMs, negMw); }
        for (int it = gw; it < 65536; it += ngw) hm_item(P, it, lane); } SEAM(8);
    if (IN(9)) { pg8::EpiP<2> E{(pg8::bf16_t*)(ws + O_MG), NB, (const float*)(ws + O_BIASB), nullptr, 0, nullptr}; GEMM(pg8::EpiP<2>, O_XN, O_WINB, TOK, NB, DM, E); } SEAM(9);
    if (IN(10)) { pg8::EpiP<4> E{(pg8::bf16_t*)(ws + O_XN), DM, nullptr, (const pg8::bf16_t*)(ws + O_MG), NB, nullptr}; GEMM(pg8::EpiP<4>, O_ONSA, O_WBN, TOK, DM, 1024, E); } SEAM(10);
    if (IN(11)) { pg8::EpiP<5> E{(pg8::bf16_t*)(ws + O_XN), DM, nullptr, (const pg8::bf16_t*)(ws + O_MG), NB, nullptr}; GEMM(pg8::EpiP<5>, O_HM, O_WBM, TOK, DM, 1024, E); } SEAM(11);
    if (IN(12)) { pg8::EpiResid E{P.out, P.out, DM, 1.0f}; GEMM(pg8::EpiResid, O_XN, O_WOUT, TOK, DM, DM, E); } SEAM(12);
    if (IN(13)) { TIDS(); phase_norm(P.out, (bf16*)(ws + O_XN), gw, ngw, lane); phase_conv_ffn2(P, lds, gw, ngw, wave, lane); } SEAM(13);
    if (IN(14)) { pg8::EpiP<0> E{(pg8::bf16_t*)(ws + O_H), FF, nullptr, nullptr, 0, nullptr}; GEMM(pg8::EpiP<0>, O_XN, O_WGU, TOK, 2 * FF, DM, E); } SEAM(14);
    if (IN(15)) { pg8::EpiResid E{P.out, P.out, DM, 0.5f}; GEMM(pg8::EpiResid, O_H, O_WD, TOK, DM, FF, E); }
#undef IN
#undef SEAM
#undef GEMM
}

#ifndef MK_COOP
#define MK_COOP 0
#endif
extern "C" void kernel_launch(void* const* d_in, const int* in_sizes, int n_in, void* d_out, int out_size, void* d_ws, size_t ws_size, hipStream_t stream) {
    static int grid = 0;
    if (grid == 0) {
        if (n_in != 28 || ws_size < WS_NEED) { fprintf(stderr, "kernel_launch: unexpected n_in %d / ws_size %zu\n", n_in, ws_size); grid = -1; return; }
        int dev = 0, cus = 0, per_cu = 0;
        hipGetDevice(&dev); hipDeviceGetAttribute(&cus, hipDeviceAttributeMultiprocessorCount, dev);
        hipFuncSetAttribute((const void*)mk_fwd, hipFuncAttributeMaxDynamicSharedMemorySize, LDS_BYTES);
        hipOccupancyMaxActiveBlocksPerMultiprocessor(&per_cu, (const void*)mk_fwd, NT, LDS_BYTES);
        (void)hipGetLastError();
        if (per_cu < 1) per_cu = 1;
        grid = cus * 1;
        if (grid < 8) grid = 256;
    }
    if (grid < 0) return;
    Params p{};
    for (int i = 0; i < 28; ++i) p.in[i] = (const float*)d_in[i];
    p.out = (float*)d_out; p.ws = (unsigned char*)d_ws;
#if MK_COOP
    p.ph_lo = 0; p.ph_hi = N_PHASES;
    void* args[] = {&p};
    hipError_t e = hipLaunchCooperativeKernel((const void*)mk_fwd, dim3(grid), dim3(NT), args, LDS_BYTES, stream);
    if (e != hipSuccess) fprintf(stderr, "cooperative launch failed: %s (grid %d)\n", hipGetErrorString(e), grid);
#else
    for (int k = 0; k < N_PHASES; ++k) { p.ph_lo = k; p.ph_hi = k + 1; hipLaunchKernelGGL(mk_fwd, dim3(grid), dim3(NT), LDS_BYTES, stream, p); }
#endif
}
```

```cpp
#include <hip/hip_runtime.h>
#include <hip/hip_cooperative_groups.h>
#include <cstdio>
#include <cstdint>
namespace cg = cooperative_groups;
#define MK_COOP 1
namespace pg8 {
#define PG8_LAS __attribute__((address_space(3)))
typedef unsigned short bf16_t;
typedef short bf16x8 __attribute__((ext_vector_type(8)));
typedef float f32x4 __attribute__((ext_vector_type(4)));
typedef unsigned u32x4 __attribute__((ext_vector_type(4)));
constexpr int BM = 256, BK = 64, HALF = 128, HTB = HALF * BK * 2  , STAGE_BYTES = 8 * HTB, NXCD = 8, WGM = 8;

__host__ __device__ __forceinline__ int lds_byte(int r, int c) { const int st = (r >> 4) * 2 + (c >> 5), rr = r & 15, cc = c & 31, ob = rr * 64 + cc * 2; return st * 1024 + (ob ^ (((ob >> 9) & 1) << 5)); }
__host__ __device__ __forceinline__ void stage_rc(int b, int& R, int& C) { const int st = b / 1024, sb = b % 1024, swz = sb ^ (((sb >> 9) & 1) << 5); R = (st >> 1) * 16 + swz / 64; C = (st & 1) * 32 + (swz % 64) / 2; }
__host__ __device__ __forceinline__ int perm32(int rho) { const int n = rho >> 4, i = rho & 15; return 8 * (i >> 2) + 4 * n + (i & 3); }

struct Unit { int pm, pn; };
struct Gemm { const bf16_t* A; const bf16_t* Bt; int M, N, K; };

struct StaticOrder {
    int nM, nN, nwg, G, c;
    __host__ __device__ void init(int M, int N, int G_, int c_) { nM = M / BM; nN = N / BM; nwg = nM * nN; G = G_; c = c_; }
    __host__ __device__ bool next(int i, Unit& u) const {
        const long L = (long)i * G + c; if (L >= nwg) return false;
        int wgid = (int)L; { const int q = nwg / NXCD, r = nwg % NXCD, xcd = wgid % NXCD, off = wgid / NXCD; wgid = (xcd < r ? xcd * (q + 1) : r * (q + 1) + (xcd - r) * q) + off; }
        const int nig = WGM * nN, gid = wgid / nig, fm = gid * WGM, gsz = (nM - fm) < WGM ? (nM - fm) : WGM;
        u.pm = fm + ((wgid % nig) % gsz); u.pn = (wgid % nig) / gsz; return true;
    }
    __device__ __forceinline__ void a_ready(const Unit&) const {}
    __device__ __forceinline__ void done(const Unit&) const {}
};

__device__ __forceinline__ unsigned cvt_pk_bf16(float lo, float hi) { typedef float f2_ __attribute__((ext_vector_type(2))); typedef __bf16 b2_ __attribute__((ext_vector_type(2))); const f2_ v = {lo, hi}; return __builtin_bit_cast(unsigned, __builtin_convertvector(v, b2_)); }
typedef float f32x2 __attribute__((ext_vector_type(2)));
__device__ __forceinline__ float sigm(float x) { return __builtin_amdgcn_rcpf(1.f + __builtin_amdgcn_exp2f(x * -1.4426950408889634f)); }
__device__ __forceinline__ float gelu_tanh(float x) { const float u = 1.5957691216f * (x + 0.044715f * x * x * x); return x - x * __builtin_amdgcn_rcpf(__builtin_amdgcn_exp2f(u * 1.4426950408889634f) + 1.f); }
template <int MODE> struct EpiP {
    static constexpr bool PERM = true, AFTER_DRAIN = false;
    bf16_t* O; int ldc; const float* bias; const bf16_t* G; int ldg; float* SMo;
    __device__ __forceinline__ void operator()(const f32x4 (&acc)[2][2][4][2], const Unit& u, int wr, int wc, int fr, int fq) const {
        const int row0 = u.pm * BM + wr * 64 + fr;
        if constexpr (MODE == 0) {
            const int col = u.pn * 128 + wc * 32 + 8 * fq;
#pragma unroll
            for (int ai = 0; ai < 2; ++ai)
#pragma unroll
                for (int m = 0; m < 4; ++m) {
                    const int row = row0 + ai * HALF + m * 16; float o[8];
#pragma unroll
                    for (int n = 0; n < 2; ++n)
#pragma unroll
                        for (int i = 0; i < 4; ++i) { const float g = acc[ai][0][m][n][i], uu = acc[ai][1][m][n][i]; o[4 * n + i] = g * sigm(g) * uu; }
                    u32x4 w; w.x = cvt_pk_bf16(o[0], o[1]); w.y = cvt_pk_bf16(o[2], o[3]); w.z = cvt_pk_bf16(o[4], o[5]); w.w = cvt_pk_bf16(o[6], o[7]);
                    *(u32x4*)(O + (size_t)row * ldc + col) = w;
                }
        } else if constexpr (MODE == 4 || MODE == 5) {
#pragma unroll
            for (int ai = 0; ai < 2; ++ai) { u32x4 gw[4][2], ow[4][2];
#pragma unroll
                for (int m = 0; m < 4; ++m)
#pragma unroll
                    for (int bj = 0; bj < 2; ++bj) { const int row = row0 + ai * HALF + m * 16, col = u.pn * BM + bj * HALF + wc * 32 + 8 * fq;
                        gw[m][bj] = *(const u32x4*)(G + (size_t)row * ldg + (MODE == 5 ? 2048 : 0) + col); if constexpr (MODE == 5) ow[m][bj] = *(const u32x4*)(O + (size_t)row * ldc + col); }
#pragma unroll
                for (int m = 0; m < 4; ++m)
#pragma unroll
                    for (int bj = 0; bj < 2; ++bj) { const int row = row0 + ai * HALF + m * 16, col = u.pn * BM + bj * HALF + wc * 32 + 8 * fq; const u32x4 g_ = gw[m][bj];
                        f32x4 v0 = acc[ai][bj][m][0] * (f32x4){__uint_as_float(g_.x << 16), __uint_as_float(g_.x & 0xffff0000u), __uint_as_float(g_.y << 16), __uint_as_float(g_.y & 0xffff0000u)};
                        f32x4 v1 = acc[ai][bj][m][1] * (f32x4){__uint_as_float(g_.z << 16), __uint_as_float(g_.z & 0xffff0000u), __uint_as_float(g_.w << 16), __uint_as_float(g_.w & 0xffff0000u)};
                        if constexpr (MODE == 5) { const u32x4 o_ = ow[m][bj];
                            v0 = v0 + (f32x4){__uint_as_float(o_.x << 16), __uint_as_float(o_.x & 0xffff0000u), __uint_as_float(o_.y << 16), __uint_as_float(o_.y & 0xffff0000u)};
                            v1 = v1 + (f32x4){__uint_as_float(o_.z << 16), __uint_as_float(o_.z & 0xffff0000u), __uint_as_float(o_.w << 16), __uint_as_float(o_.w & 0xffff0000u)}; }
                        u32x4 w; w.x = cvt_pk_bf16(v0[0], v0[1]); w.y = cvt_pk_bf16(v0[2], v0[3]); w.z = cvt_pk_bf16(v1[0], v1[1]); w.w = cvt_pk_bf16(v1[2], v1[3]);
                        *(u32x4*)(O + (size_t)row * ldc + col) = w; } }
        } else {
#pragma unroll
            for (int bj = 0; bj < 2; ++bj) {
                const int col = u.pn * BM + bj * HALF + wc * 32 + 8 * fq;
                f32x4 b0 = (f32x4){0.f, 0.f, 0.f, 0.f}, b1 = b0;
                if constexpr (MODE == 1 || MODE == 2) { b0 = *(const f32x4*)(bias + col); b1 = *(const f32x4*)(bias + col + 4); }
#pragma unroll
                for (int ai = 0; ai < 2; ++ai)
#pragma unroll
                    for (int m = 0; m < 4; ++m) {
                        const int row = row0 + ai * HALF + m * 16;
                        f32x4 v0 = acc[ai][bj][m][0] + b0, v1 = acc[ai][bj][m][1] + b1;
                        if constexpr (MODE == 1) {
                            if (SMo != nullptr && u.pn == 26 && bj == 0 && wc < 2) { float* sp = SMo + (size_t)row * 64 + wc * 32 + 8 * fq; *(f32x4*)sp = v0; *(f32x4*)(sp + 4) = v1; }
                        }
                        if constexpr (MODE == 2) {
#pragma unroll
                            for (int i = 0; i < 4; ++i) { v0[i] = sigm(v0[i]); v1[i] = sigm(v1[i]); }
                        }
                        if constexpr (MODE == 3) {
#pragma unroll
                            for (int i = 0; i < 4; ++i) { v0[i] = gelu_tanh(v0[i]); v1[i] = gelu_tanh(v1[i]); }
                        }
                        if constexpr (MODE == 4 || MODE == 5) {
                            const u32x4 gw = *(const u32x4*)(G + (size_t)row * ldg + (MODE == 5 ? 2048 : 0) + col);
                            const float g0 = __uint_as_float(gw.x << 16), g1 = __uint_as_float(gw.x & 0xffff0000u), g2 = __uint_as_float(gw.y << 16), g3 = __uint_as_float(gw.y & 0xffff0000u);
                            const float g4 = __uint_as_float(gw.z << 16), g5 = __uint_as_float(gw.z & 0xffff0000u), g6 = __uint_as_float(gw.w << 16), g7 = __uint_as_float(gw.w & 0xffff0000u);
                            v0 = v0 * (f32x4){g0, g1, g2, g3}; v1 = v1 * (f32x4){g4, g5, g6, g7};
                            if constexpr (MODE == 5) {
                                const u32x4 ow = *(const u32x4*)(O + (size_t)row * ldc + col);
                                v0 = v0 + (f32x4){__uint_as_float(ow.x << 16), __uint_as_float(ow.x & 0xffff0000u), __uint_as_float(ow.y << 16), __uint_as_float(ow.y & 0xffff0000u)};
                                v1 = v1 + (f32x4){__uint_as_float(ow.z << 16), __uint_as_float(ow.z & 0xffff0000u), __uint_as_float(ow.w << 16), __uint_as_float(ow.w & 0xffff0000u)};
                            }
                        }
                        u32x4 w; w.x = cvt_pk_bf16(v0[0], v0[1]); w.y = cvt_pk_bf16(v0[2], v0[3]); w.z = cvt_pk_bf16(v1[0], v1[1]); w.w = cvt_pk_bf16(v1[2], v1[3]);
                        *(u32x4*)(O + (size_t)row * ldc + col) = w;
                    }
            }
        }
    }
};
struct EpiResid {
    static constexpr bool PERM = false, AFTER_DRAIN = false;
    const float* res; float* out; int ldc; float scale;
    __device__ __forceinline__ void operator()(const f32x4 (&acc)[2][2][4][2], const Unit& u, int wr, int wc, int fr, int fq) const {
        const int row0 = u.pm * BM + wr * 64 + fr, col0 = u.pn * BM + wc * 32 + 4 * fq;
#pragma unroll
        for (int ai = 0; ai < 2; ++ai) { f32x4 r[4][2][2];
#pragma unroll
            for (int m = 0; m < 4; ++m) { const size_t off = (size_t)(row0 + ai * HALF + m * 16) * ldc + col0;
#pragma unroll
                for (int bj = 0; bj < 2; ++bj)
#pragma unroll
                    for (int n = 0; n < 2; ++n) r[m][bj][n] = *(const f32x4*)(res + off + bj * HALF + n * 16); }
#pragma unroll
            for (int m = 0; m < 4; ++m) { const size_t off = (size_t)(row0 + ai * HALF + m * 16) * ldc + col0;
#pragma unroll
                for (int bj = 0; bj < 2; ++bj)
#pragma unroll
                    for (int n = 0; n < 2; ++n) *(f32x4*)(out + off + bj * HALF + n * 16) = r[m][bj][n] + acc[ai][bj][m][n] * scale; } }
    }
};
template <class Epi, class Sched, bool ALIGN_EPI = false, bool SP2 = false>
__device__ __forceinline__ void gemm_phase(PG8_LAS unsigned char* lds, const Gemm g, const Sched& S, const Epi& E) {
    int tid_o = threadIdx.x; asm volatile("" : "+v"(tid_o));
    const int tid = tid_o, wid = __builtin_amdgcn_readfirstlane(tid >> 6), lane = tid & 63, wr = wid >> 2, wc = wid & 3, fr = lane & 15, fq = lane >> 4;
    const int K = g.K, nt = K / BK;
    unsigned voffA[2], voffB[2];
#pragma unroll
    for (int i = 0; i < 2; ++i) { int R, C; stage_rc(tid * 16 + i * 8192, R, C); const int Rb = Epi::PERM ? ((R & ~31) + perm32(R & 31)) : R;
        voffA[i] = (unsigned)(R * K + C) * 2u; voffB[i] = (unsigned)(Rb * K + C) * 2u; }
    const size_t kstep = (size_t)(BK * 2);
    const size_t hstep = (size_t)HALF * K * 2;
    const size_t tstep = 2 * hstep;
    const unsigned ldsw = (unsigned)wid * 1024u;
    const int aoff = lds_byte(wr * 64 + fr, fq * 8), boff = lds_byte(wc * 32 + fr, fq * 8);
#define PG8_SA(b, h) (((b) * 2 + (h)) * HTB)
#define PG8_SB(b, h) ((4 + (b) * 2 + (h)) * HTB)
#define PG8_STAGE(bufoff, gbase, voff) do { _Pragma("unroll") for (int _i = 0; _i < 2; ++_i) \
        __builtin_amdgcn_global_load_lds((const unsigned*)((const char*)(gbase) + (voff)[_i]), (PG8_LAS unsigned*)(lds + (bufoff) + ldsw + _i * 8192), 16, 0, 0); } while (0)
#define PG8_LDA(dst, b, h) do { _Pragma("unroll") for (int m = 0; m < 4; ++m) _Pragma("unroll") for (int k = 0; k < 2; ++k) dst[m][k] = *(const PG8_LAS bf16x8*)(lds + PG8_SA(b, h) + aoff + m * 2048 + k * 1024); } while (0)
#define PG8_LDB(dst, b, h) do { _Pragma("unroll") for (int n = 0; n < 2; ++n) _Pragma("unroll") for (int k = 0; k < 2; ++k) dst[n][k] = *(const PG8_LAS bf16x8*)(lds + PG8_SB(b, h) + boff + n * 2048 + k * 1024); } while (0)
#define PG8_MMA(ai, bj, At, Bt) do { __builtin_amdgcn_s_setprio(1); _Pragma("unroll") for (int m = 0; m < 4; ++m) _Pragma("unroll") for (int n = 0; n < 2; ++n) _Pragma("unroll") for (int k = 0; k < 2; ++k) \
        acc[ai][bj][m][n] = __builtin_amdgcn_mfma_f32_16x16x32_bf16(Bt[n][k], At[m][k], acc[ai][bj][m][n], 0, 0, 0); __builtin_amdgcn_s_setprio(0); } while (0)
#define PG8_WAIT_V(n) asm volatile("s_waitcnt vmcnt(" #n ")" ::: "memory")
#define PG8_WAIT_L(n) asm volatile("s_waitcnt lgkmcnt(" #n ")" ::: "memory")
#define PG8_BAR __builtin_amdgcn_s_barrier()
#define PG8_SCHED __builtin_amdgcn_sched_barrier(0)
    Unit cur, nxt; int ui = 0;
    if (!S.next(0, cur)) return;
    f32x4 acc[2][2][4][2];
#pragma unroll
    for (int a = 0; a < 2; ++a)
#pragma unroll
        for (int b = 0; b < 2; ++b)
#pragma unroll
            for (int m = 0; m < 4; ++m)
#pragma unroll
                for (int n = 0; n < 2; ++n) acc[a][b][m][n] = (f32x4){0.f, 0.f, 0.f, 0.f};
    bf16x8 At[4][2], B0[2][2], B1[2][2];
    const char* cA = (const char*)g.A + (size_t)cur.pm * tstep; const char* cB = (const char*)g.Bt + (size_t)cur.pn * tstep;
    S.a_ready(cur);
    if constexpr (SP2) {
        PG8_STAGE(PG8_SB(0, 0), cB, voffB); PG8_STAGE(PG8_SB(0, 1), cB + hstep, voffB); PG8_STAGE(PG8_SA(0, 0), cA, voffA); PG8_STAGE(PG8_SA(0, 1), cA + hstep, voffA);
        if (wr == 1) PG8_BAR;
        PG8_WAIT_V(2); PG8_BAR;
        PG8_STAGE(PG8_SB(1, 0), cB + kstep, voffB); PG8_STAGE(PG8_SA(1, 0), cA + kstep, voffA); PG8_STAGE(PG8_SB(1, 1), cB + hstep + kstep, voffB);
        PG8_WAIT_V(6); PG8_BAR;
    } else {
        PG8_STAGE(PG8_SB(0, 0), cB, voffB); PG8_STAGE(PG8_SA(0, 0), cA, voffA); PG8_STAGE(PG8_SB(0, 1), cB + hstep, voffB); PG8_STAGE(PG8_SA(0, 1), cA + hstep, voffA);
        if (wr == 1) PG8_BAR;
        PG8_WAIT_V(4); PG8_BAR;
        PG8_STAGE(PG8_SB(1, 0), cB + kstep, voffB); PG8_STAGE(PG8_SA(1, 0), cA + kstep, voffA); PG8_STAGE(PG8_SB(1, 1), cB + hstep + kstep, voffB);
        PG8_WAIT_V(6); PG8_BAR;
    }
    for (;;) {
        const bool has_next = S.next(ui + 1, nxt);
        const char* nA = has_next ? (const char*)g.A + (size_t)nxt.pm * tstep : cA; const char* nB = has_next ? (const char*)g.Bt + (size_t)nxt.pn * tstep : cB;
        for (int t = 0; t < nt; t += 2) {
            const bool last = (t == nt - 2);
            const char* a1 = cA + (size_t)(t + 1) * kstep;
            const char* a2 = last ? nA : cA + (size_t)(t + 2) * kstep; const char* b2 = last ? nB : cB + (size_t)(t + 2) * kstep;
            const char* a3 = a2 + kstep; const char* b3 = b2 + kstep;
            if (last && has_next) S.a_ready(nxt);
            if constexpr (SP2) {
            PG8_LDB(B0, 0, 0); PG8_LDB(B1, 0, 1); PG8_SCHED; PG8_LDA(At, 0, 0); PG8_STAGE(PG8_SA(1, 1), a1 + hstep, voffA);
            PG8_WAIT_V(8); PG8_WAIT_L(0); PG8_BAR; PG8_MMA(0, 0, At, B0); PG8_MMA(0, 1, At, B1); PG8_BAR; PG8_SCHED;
            PG8_LDA(At, 0, 1); PG8_STAGE(PG8_SB(0, 0), b2, voffB); PG8_STAGE(PG8_SB(0, 1), b2 + hstep, voffB); PG8_STAGE(PG8_SA(0, 0), a2, voffA);
            PG8_WAIT_V(8); PG8_WAIT_L(0); PG8_BAR; PG8_MMA(1, 0, At, B0); PG8_MMA(1, 1, At, B1); PG8_BAR; PG8_SCHED;
            PG8_LDB(B0, 1, 0); PG8_LDB(B1, 1, 1); PG8_SCHED; PG8_LDA(At, 1, 0); PG8_STAGE(PG8_SA(0, 1), a2 + hstep, voffA);
            PG8_WAIT_V(8); PG8_WAIT_L(0); PG8_BAR; PG8_MMA(0, 0, At, B0); PG8_MMA(0, 1, At, B1); PG8_BAR; PG8_SCHED;
            PG8_LDA(At, 1, 1); PG8_STAGE(PG8_SB(1, 0), b3, voffB); PG8_STAGE(PG8_SB(1, 1), b3 + hstep, voffB); PG8_STAGE(PG8_SA(1, 0), a3, voffA);
            PG8_WAIT_V(8); PG8_WAIT_L(0); PG8_BAR; PG8_MMA(1, 0, At, B0); PG8_MMA(1, 1, At, B1); PG8_BAR; PG8_SCHED;
            } else {
            PG8_LDB(B0, 0, 0); PG8_SCHED; PG8_LDA(At, 0, 0); PG8_STAGE(PG8_SA(1, 1), a1 + hstep, voffA);
            PG8_WAIT_L(8); PG8_BAR; PG8_WAIT_L(0); PG8_MMA(0, 0, At, B0); PG8_BAR; PG8_SCHED;
            PG8_LDB(B1, 0, 1); PG8_STAGE(PG8_SB(0, 0), b2, voffB);
            PG8_BAR; PG8_WAIT_L(0); PG8_MMA(0, 1, At, B1); PG8_BAR;
            PG8_LDA(At, 0, 1); PG8_STAGE(PG8_SA(0, 0), a2, voffA);
            PG8_BAR; PG8_WAIT_L(0); PG8_MMA(1, 0, At, B0); PG8_BAR; PG8_SCHED;
            PG8_STAGE(PG8_SB(0, 1), b2 + hstep, voffB);
            PG8_WAIT_V(6); PG8_BAR; PG8_MMA(1, 1, At, B1); PG8_BAR;
            PG8_LDB(B0, 1, 0); PG8_SCHED; PG8_LDA(At, 1, 0); PG8_STAGE(PG8_SA(0, 1), a2 + hstep, voffA);
            PG8_WAIT_L(8); PG8_BAR; PG8_WAIT_L(0); PG8_MMA(0, 0, At, B0); PG8_BAR; PG8_SCHED;
            PG8_LDB(B1, 1, 1); PG8_STAGE(PG8_SB(1, 0), b3, voffB);
            PG8_BAR; PG8_WAIT_L(0); PG8_MMA(0, 1, At, B1); PG8_BAR;
            PG8_LDA(At, 1, 1); PG8_STAGE(PG8_SA(1, 0), a3, voffA);
            PG8_BAR; PG8_WAIT_L(0); PG8_MMA(1, 0, At, B0); PG8_BAR; PG8_SCHED;
            PG8_STAGE(PG8_SB(1, 1), b3 + hstep, voffB);
            PG8_WAIT_V(6); PG8_BAR; PG8_MMA(1, 1, At, B1); PG8_BAR;
            }
        }
        if constexpr (ALIGN_EPI) { if (wr == 0) PG8_BAR; }
        if constexpr (!Epi::AFTER_DRAIN) { E(acc, cur, wr, wc, fr, fq); S.done(cur); }
        if (!has_next) break;
#pragma unroll
        for (int a = 0; a < 2; ++a)
#pragma unroll
            for (int b = 0; b < 2; ++b)
#pragma unroll
                for (int m = 0; m < 4; ++m)
#pragma unroll
                    for (int n = 0; n < 2; ++n) acc[a][b][m][n] = (f32x4){0.f, 0.f, 0.f, 0.f};
        cur = nxt; cA = nA; cB = nB; ++ui;
        if constexpr (ALIGN_EPI) { if (wr == 1) PG8_BAR; }
    }
    PG8_WAIT_V(0);
    if constexpr (!ALIGN_EPI) { if (wr == 0) PG8_BAR; }
    PG8_BAR;
    if constexpr (Epi::AFTER_DRAIN) { E.fused(acc, cur, wr, wc, fr, fq, lds, wid, lane); S.done(cur); }
#undef PG8_SA
#undef PG8_SB
#undef PG8_STAGE
#undef PG8_LDA
#undef PG8_LDB
#undef PG8_MMA
#undef PG8_WAIT_V
#undef PG8_WAIT_L
#undef PG8_BAR
#undef PG8_SCHED
}
}
#define LAS __attribute__((address_space(3)))
typedef unsigned short bf16;
typedef unsigned v4u __attribute__((ext_vector_type(4)));
typedef unsigned v2u __attribute__((ext_vector_type(2)));
typedef float f32x4 __attribute__((ext_vector_type(4)));
typedef float f32x2 __attribute__((ext_vector_type(2)));
#define WSYNC() asm volatile("s_waitcnt lgkmcnt(0)" ::: "memory")

constexpr int NT = 512, NWV = 8;
constexpr int TOK = 16384, SEQ = 4096, DM = 2048, FF = 5632, NA = 6912, NB = 4096, INW = 10808;
constexpr int PA_Q = 0, PA_KV = 1024, PA_MQ = 2560, PA_MK = 3584, PA_MV = 4608, PA_MO = 5632, PA_SM = 6656;
constexpr float EPS = 1e-6f;
constexpr size_t MiB = 1u << 20;
constexpr size_t O_BIASA = 64 * 1024, O_BIASB = 128 * 1024, O_GG = 192 * 1024, O_GMX = 200 * 1024, O_DENI = 256 * 1024;
constexpr size_t O_WGU = 1 * MiB, O_WD = 45 * MiB, O_WINA = 67 * MiB, O_WINB = 94 * MiB, O_WBN = 110 * MiB, O_WBM = 114 * MiB, O_WOUT = 118 * MiB, O_WC1K = 126 * MiB, O_WC1V = 127 * MiB;
constexpr size_t O_MQK = 1 * MiB, O_HM = 1 * MiB;
constexpr size_t O_KTU = 472 * MiB;
constexpr size_t O_VTS = 67 * MiB, O_VTW = 75 * MiB, O_KCB = 83 * MiB, O_VCT = 83 * MiB + 512 * 1024;
constexpr size_t O_XN = 128 * MiB, O_PA = 192 * MiB, O_H = 192 * MiB, O_MG = 192 * MiB;
constexpr size_t O_ONSA = 408 * MiB, O_WT = 84 * MiB, O_HC = 440 * MiB, O_CBK = 408 * MiB, O_CBV = 424 * MiB, O_CHK = 65 * MiB, O_CHV = 92 * MiB;
constexpr size_t O_SM = 504 * MiB, O_KC = 508 * MiB, O_VC = 509 * MiB, O_SEL = 510 * MiB, O_GA = 510 * MiB + 512 * 1024, O_GLA = 510 * MiB + 768 * 1024, O_GPM = 511 * MiB;
constexpr size_t WS_NEED = 512 * MiB;
constexpr int LDS_BYTES = 147456;

struct Params { const float* in[28]; float* out; unsigned char* ws; int ph_lo, ph_hi; };

__device__ __forceinline__ float bf2f(unsigned short b) { return __uint_as_float(((unsigned)b) << 16); }
__device__ __forceinline__ unsigned pk2(float lo, float hi) { typedef float f2_ __attribute__((ext_vector_type(2))); typedef __bf16 b2_ __attribute__((ext_vector_type(2))); const f2_ v = {lo, hi}; return __builtin_bit_cast(unsigned, __builtin_convertvector(v, b2_)); }
__device__ __forceinline__ unsigned f2bf(float f) { return pk2(f, 0.f) & 0xffffu; }
__device__ __forceinline__ float lo16(unsigned w) { return __uint_as_float(w << 16); }
__device__ __forceinline__ float hi16(unsigned w) { return __uint_as_float(w & 0xffff0000u); }
__device__ __forceinline__ float wave_sum(float v) {
#pragma unroll
    for (int o = 1; o < 64; o <<= 1) v += __shfl_xor(v, o);
    return v;
}
__device__ __forceinline__ float wave_max(float v) {
#pragma unroll
    for (int o = 1; o < 64; o <<= 1) v = fmaxf(v, __shfl_xor(v, o));
    return v;
}
__device__ __forceinline__ float sigmf(float x) { return __builtin_amdgcn_rcpf(1.f + __builtin_amdgcn_exp2f(x * -1.4426950408889634f)); }

__device__ __forceinline__ void tr_item(const float* W, int ldw, int K, int srccol  , bf16* WT, int outrow0, const float* kscale, float* scr, int k0, int lane) {
#pragma unroll 8
    for (int i = 0; i < 32; ++i) { const int kk = 2 * i + (lane >> 5); float v = 0.f; if (srccol >= 0) v = W[(size_t)(k0 + kk) * ldw + srccol]; if (kscale) v *= kscale[k0 + kk]; scr[kk * 33 + (lane & 31)] = v; }
    WSYNC();
    const int c = lane & 7;
#pragma unroll
    for (int j = 0; j < 4; ++j) { const int n = (lane >> 3) + 8 * j; const float* s = scr + (8 * c) * 33 + n;
        v4u o; o.x = pk2(s[0 * 33], s[1 * 33]); o.y = pk2(s[2 * 33], s[3 * 33]); o.z = pk2(s[4 * 33], s[5 * 33]); o.w = pk2(s[6 * 33], s[7 * 33]);
        *(v4u*)(WT + (size_t)(outrow0 + n) * K + k0 + 8 * c) = o; }
    WSYNC();
}
__device__ __forceinline__ void tr_item64(const float* W, int ldw, int K, int srccol0, bf16* WT, int outrow0, const float* kscale, float* scr, int k0, int lane) {
    const int kr = lane >> 4, c4 = (lane & 15) * 4; f32x4 v[16];
#pragma unroll
    for (int i = 0; i < 16; ++i) v[i] = *(const f32x4*)(W + (size_t)(k0 + 4 * i + kr) * ldw + srccol0 + c4);
#pragma unroll
    for (int i = 0; i < 16; ++i) { const int k = 4 * i + kr; const float sc = kscale ? kscale[k0 + k] : 1.f; float* s = scr + k * 65 + c4; s[0] = v[i].x * sc; s[1] = v[i].y * sc; s[2] = v[i].z * sc; s[3] = v[i].w * sc; }
    WSYNC();
    const int c = lane & 7;
#pragma unroll
    for (int j = 0; j < 8; ++j) { const int n = (lane >> 3) + 8 * j; const float* s = scr + (8 * c) * 65 + n;
        v4u o; o.x = pk2(s[0 * 65], s[1 * 65]); o.y = pk2(s[2 * 65], s[3 * 65]); o.z = pk2(s[4 * 65], s[5 * 65]); o.w = pk2(s[6 * 65], s[7 * 65]);
        *(v4u*)(WT + (size_t)(outrow0 + n) * K + k0 + 8 * c) = o; }
    WSYNC();
}
__device__ __forceinline__ void tr_plain(const float* W, int K, int N, bf16* WT, const float* kscale, float* scr, int item, int lane) {
    const int nblk = N / 64, kb = item / nblk, nb = item % nblk;
    tr_item64(W, N, K, nb * 64, WT, nb * 64, kscale, scr, kb * 64, lane);
}
__device__ __forceinline__ void tr_gu(const float* Wg, const float* Wu, bf16* WT, const float* kscale, float* scr, int item, int lane) {
    const int nblk = (2 * FF) / 64, kb = item / nblk, nb = item % nblk, n0 = nb * 64, pn = n0 >> 8, within = n0 & 255;
    const float* W = (within >= 128) ? Wu : Wg;
    tr_item64(W, FF, DM, pn * 128 + (within & 127), WT, n0, kscale, scr, kb * 64, lane);
}
__device__ __forceinline__ int ina_src(int n) {
    if (n < 2560) return n;
    if (n < 5632) return n + 48;
    if (n < 6656) return 5688 + (n - 5632);
    if (n < 6704) return 2560 + (n - 6656);
    if (n < 6708) return 5680 + (n - 6704);
    if (n < 6712) return 5684 + (n - 6708);
    return -1;
}
__device__ __forceinline__ void norm_row(const float* xrow, bf16* orow, int lane) {
    const f32x4* xr = (const f32x4*)xrow + lane; f32x4 v[8]; float s = 0.f;
#pragma unroll
    for (int j = 0; j < 8; ++j) { v[j] = xr[64 * j]; s += (v[j].x * v[j].x + v[j].y * v[j].y) + (v[j].z * v[j].z + v[j].w * v[j].w); }
    const float rstd = rsqrtf(wave_sum(s) * (1.f / DM) + EPS);
    v2u* o8 = (v2u*)orow + lane;
#pragma unroll
    for (int j = 0; j < 8; ++j) { v2u w; w.x = pk2(v[j].x * rstd, v[j].y * rstd); w.y = pk2(v[j].z * rstd, v[j].w * rstd); o8[64 * j] = w; }
}

__device__ __forceinline__ void phase_prologue(const Params& P, unsigned char* lds, int gw, int ngw, int wave, int lane, int tid) {
    unsigned char* ws = P.ws; float* scr = (float*)(lds + wave * 16640);
    constexpr int I_GU = 32 * 176, I_D = 88 * 32, I_A = 32 * 108, I_B = 32 * 64, I_BN = 16 * 32, I_O = 32 * 32, I_C = 32 * 4;
    constexpr int NITEMS = I_GU + I_D + I_A + I_B + 2 * I_BN + I_O + 2 * I_C;
    for (int it = gw; it < NITEMS; it += ngw) {
        int r = it;
        if (r < I_GU) { tr_gu(P.in[2], P.in[3], (bf16*)(ws + O_WGU), P.in[1], scr, r, lane); continue; } r -= I_GU;
        if (r < I_D) { tr_plain(P.in[4], FF, DM, (bf16*)(ws + O_WD), nullptr, scr, r, lane); continue; } r -= I_D;
        if (r < I_A) { const int nblk = NA / 64, kb = r / nblk, nb = r % nblk;
            if (nb == 104) { tr_item(P.in[6], INW, DM, ina_src(6656 + (lane & 31)), (bf16*)(ws + O_WINA), 6656, P.in[5], scr, kb * 64, lane); tr_item(P.in[6], INW, DM, ina_src(6688 + (lane & 31)), (bf16*)(ws + O_WINA), 6688, P.in[5], scr, kb * 64, lane); }
            else if (nb > 104) { tr_item(P.in[6], INW, DM, -1, (bf16*)(ws + O_WINA), nb * 64, P.in[5], scr, kb * 64, lane); tr_item(P.in[6], INW, DM, -1, (bf16*)(ws + O_WINA), nb * 64 + 32, P.in[5], scr, kb * 64, lane); }
            else tr_item64(P.in[6], INW, DM, ina_src(nb * 64), (bf16*)(ws + O_WINA), nb * 64, P.in[5], scr, kb * 64, lane);
            continue; } r -= I_A;
        if (r < I_B) { const int nblk = NB / 64, kb = r / nblk, nb = r % nblk; tr_item64(P.in[6], INW, DM, 6712 + nb * 64, (bf16*)(ws + O_WINB), nb * 64, P.in[5], scr, kb * 64, lane); continue; } r -= I_B;
        if (r < I_BN) { tr_plain(P.in[21], 1024, DM, (bf16*)(ws + O_WBN), nullptr, scr, r, lane); continue; } r -= I_BN;
        if (r < I_BN) { tr_plain(P.in[22], 1024, DM, (bf16*)(ws + O_WBM), P.in[20], scr, r, lane); continue; } r -= I_BN;
        if (r < I_O) { tr_plain(P.in[23], DM, DM, (bf16*)(ws + O_WOUT), nullptr, scr, r, lane); continue; } r -= I_O;
        if (r < I_C) { tr_plain(P.in[13], 2048, 256, (bf16*)(ws + O_WC1K), nullptr, scr, r, lane); continue; } r -= I_C;
        tr_plain(P.in[16], 2048, 256, (bf16*)(ws + O_WC1V), nullptr, scr, r, lane);
    }
    { const int gt = gw * 64 + lane, ngt = ngw * 64; float* ba = (float*)(ws + O_BIASA); float* bb = (float*)(ws + O_BIASB);
      for (int n = gt; n < NA; n += ngt) { const int s = ina_src(n); ba[n] = s >= 0 ? P.in[7][s] : 0.f; }
      for (int n = gt; n < NB; n += ngt) bb[n] = P.in[7][6712 + n]; }
    for (int m = gw; m < TOK; m += ngw) norm_row(P.in[0] + (size_t)m * DM, (bf16*)(ws + O_XN) + (size_t)m * DM, lane);
}
__device__ __forceinline__ void phase_norm(const float* src, bf16* dst, int gw, int ngw, int lane) {
    for (int m = gw; m < TOK; m += ngw) norm_row(src + (size_t)m * DM, dst + (size_t)m * DM, lane);
}
__device__ __forceinline__ void phase_conv_ffn2(const Params& P, unsigned char* lds, int gw, int ngw, int wave, int lane) {
    float* scr = (float*)(lds + wave * 16640);
    constexpr int I_GU = 32 * 176, I_D = 88 * 32;
    for (int it = gw; it < I_GU + I_D; it += ngw) {
        if (it < I_GU) tr_gu(P.in[25], P.in[26], (bf16*)(P.ws + O_WGU), P.in[24], scr, it, lane);
        else tr_plain(P.in[27], FF, DM, (bf16*)(P.ws + O_WD), nullptr, scr, it - I_GU, lane);
    }
}

__device__ __forceinline__ void phase_prep(const Params& P, int gw, int ngw, int lane) {
    unsigned char* ws = P.ws; bf16* PA = (bf16*)(ws + O_PA);
    { const float qg = P.in[8][lane] * (0.125f * 1.4426950408889634f), ksg = P.in[10][lane], kwg = P.in[11][lane];
      for (int m = gw; m < TOK; m += ngw) { bf16* pr = PA + (size_t)m * NA; float x[24];
#pragma unroll
        for (int v = 0; v < 24; ++v) { const int col = (v < 16) ? (PA_Q + v * 64) : (v < 20 ? (PA_KV + 2 * 256 + (v - 16) * 64) : (PA_KV + 4 * 256 + (v - 20) * 64)); x[v] = bf2f(pr[col + lane]); }
#pragma unroll
        for (int v = 0; v < 24; ++v) { const int col = (v < 16) ? (PA_Q + v * 64) : (v < 20 ? (PA_KV + 2 * 256 + (v - 16) * 64) : (PA_KV + 4 * 256 + (v - 20) * 64));
            const float gn = (v < 16) ? qg : (v < 20 ? ksg : kwg); const float ss = wave_sum(x[v] * x[v]); pr[col + lane] = (bf16)f2bf(x[v] * rsqrtf(ss * (1.f / 64.f) + EPS) * gn); } } }
    { const size_t gt = (size_t)gw * 64 + lane, ngt = (size_t)ngw * 64; bf16* CBK = (bf16*)(ws + O_CBK); bf16* CBV = (bf16*)(ws + O_CBV);
      const int k8 = (int)(gt & 255) * 8, l = k8 >> 6, d = k8 & 63; float pk[8], pv[8];
#pragma unroll
      for (int i = 0; i < 8; ++i) { pk[i] = P.in[12][l * 64 + d + i]; pv[i] = P.in[15][l * 64 + d + i]; }
      for (size_t idx = gt; idx < (size_t)4096 * 256; idx += ngt) { const int r = (int)(idx >> 8);
        v4u ok = (v4u){0u, 0u, 0u, 0u}, ov = ok;
        if (r < 4080) { const int bg = r / 255, c = r % 255, b = bg >> 2, g = bg & 3; const bf16* src = PA + ((size_t)b * SEQ + 16 * c + l) * NA + PA_KV + g * 64 + d;
            const v4u kw = *(const v4u*)src, vw = *(const v4u*)(src + 256);
            ok.x = pk2(lo16(kw.x) + pk[0], hi16(kw.x) + pk[1]); ok.y = pk2(lo16(kw.y) + pk[2], hi16(kw.y) + pk[3]); ok.z = pk2(lo16(kw.z) + pk[4], hi16(kw.z) + pk[5]); ok.w = pk2(lo16(kw.w) + pk[6], hi16(kw.w) + pk[7]);
            ov.x = pk2(lo16(vw.x) + pv[0], hi16(vw.x) + pv[1]); ov.y = pk2(lo16(vw.y) + pv[2], hi16(vw.y) + pv[3]); ov.z = pk2(lo16(vw.z) + pv[4], hi16(vw.z) + pv[5]); ov.w = pk2(lo16(vw.w) + pv[6], hi16(vw.w) + pv[7]); }
        *(v4u*)(CBK + (size_t)r * 2048 + k8) = ok; *(v4u*)(CBV + (size_t)r * 2048 + k8) = ov; } }
    { const size_t gt = (size_t)gw * 64 + lane, ngt = (size_t)ngw * 64; bf16* MQK = (bf16*)(ws + O_MQK); const float* cw = P.in[18]; const float* cb = P.in[19];
      const int c8 = (int)(gt & 255) * 8; float wt[4][8], bs[8];
#pragma unroll
      for (int i = 0; i < 8; ++i) { bs[i] = cb[c8 + i];
#pragma unroll
          for (int j = 0; j < 4; ++j) wt[j][i] = cw[j * 2048 + c8 + i]; }
#pragma unroll 2
      for (size_t idx = gt; idx < (size_t)TOK * 256; idx += ngt) { const int m = (int)(idx >> 8), t = m & (SEQ - 1);
        float a[8]; v4u w[4];
#pragma unroll
        for (int j = 0; j < 4; ++j) { const int mm = (t - 3 + j >= 0) ? (m - 3 + j) : m; w[j] = *(const v4u*)(PA + (size_t)mm * NA + PA_MQ + c8); }
#pragma unroll
        for (int i = 0; i < 8; ++i) a[i] = bs[i];
#pragma unroll
        for (int j = 0; j < 4; ++j) { const float z = (t - 3 + j >= 0) ? 1.f : 0.f;
            a[0] += wt[j][0] * z * lo16(w[j].x); a[1] += wt[j][1] * z * hi16(w[j].x); a[2] += wt[j][2] * z * lo16(w[j].y); a[3] += wt[j][3] * z * hi16(w[j].y);
            a[4] += wt[j][4] * z * lo16(w[j].z); a[5] += wt[j][5] * z * hi16(w[j].z); a[6] += wt[j][6] * z * lo16(w[j].w); a[7] += wt[j][7] * z * hi16(w[j].w); }
#pragma unroll
        for (int i = 0; i < 8; ++i) a[i] = a[i] * sigmf(a[i]);
        v4u o; o.x = pk2(a[0], a[1]); o.y = pk2(a[2], a[3]); o.z = pk2(a[4], a[5]); o.w = pk2(a[6], a[7]);
        *(v4u*)(MQK + (size_t)m * 2048 + c8) = o; } }
    { const bf16* PAc = (const bf16*)(ws + O_PA);
      for (int it = gw; it < 2048; it += ngw) { const int j = it & 1, g = (it >> 1) & 3, tb = (it >> 3) & 63, b = it >> 9; const int bg = b * 4 + g;
        const bf16* src = PAc + ((size_t)b * SEQ + 64 * tb + lane) * NA + PA_KV + (j ? 5 : 3) * 256 + g * 64; bf16* dst = (bf16*)(ws + (j ? O_VTW : O_VTS)) + (size_t)bg * 64 * SEQ + (size_t)tb * 4096 + lane;
#pragma unroll
        for (int d8 = 0; d8 < 8; ++d8) { const v4u w = *(const v4u*)(src + 8 * d8);
            dst[(size_t)(8 * d8 + 0) * 64] = (bf16)(w.x & 0xffffu); dst[(size_t)(8 * d8 + 1) * 64] = (bf16)(w.x >> 16); dst[(size_t)(8 * d8 + 2) * 64] = (bf16)(w.y & 0xffffu); dst[(size_t)(8 * d8 + 3) * 64] = (bf16)(w.y >> 16);
            dst[(size_t)(8 * d8 + 4) * 64] = (bf16)(w.z & 0xffffu); dst[(size_t)(8 * d8 + 5) * 64] = (bf16)(w.z >> 16); dst[(size_t)(8 * d8 + 6) * 64] = (bf16)(w.w & 0xffffu); dst[(size_t)(8 * d8 + 7) * 64] = (bf16)(w.w >> 16); } } }
    { const float* SM = (const float*)(ws + O_SM); float* GA = (float*)(ws + O_GA); float* GLA = (float*)(ws + O_GLA); float* GPM = (float*)(ws + O_GPM); float* GG = (float*)(ws + O_GG); float* GMX = (float*)(ws + O_GMX);
      for (int it = gw; it < 1024; it += ngw) { const int bh = it >> 6, c = it & 63, b = bh >> 2, h = bh & 3; const size_t m = (size_t)b * SEQ + 64 * c + lane;
        const float ip = SM[m * 64 + 48 + h], fp = SM[m * 64 + 52 + h];
        const float lf = fminf(fp, 0.f) - log1pf(__expf(-fabsf(fp)));
        float a = lf;
#pragma unroll
        for (int o = 1; o < 64; o <<= 1) { const float y = __shfl_up(a, o); if (lane >= o) a += y; }
        const float g = __shfl(a, 63); const float la = ip - a; const float mx = wave_max(g + la);
        float pm = la;
#pragma unroll
        for (int o = 1; o < 64; o <<= 1) { const float y = __shfl_up(pm, o); if (lane >= o) pm = fmaxf(pm, y); }
        const size_t o1 = (size_t)bh * SEQ + 64 * c + lane; GA[o1] = a; GLA[o1] = la; GPM[o1] = a + pm;
        if (lane == 0) { GG[it] = g; GMX[it] = mx; } } }
    for (int it = gw; it < 16; it += ngw) { ((bf16*)(ws + O_KCB))[((size_t)it * 256 + 255) * 64 + lane] = 0; ((bf16*)(ws + O_VCT))[((size_t)it * 64 + lane) * 256 + 255] = 0; }
}

typedef short cbf16x8 __attribute__((ext_vector_type(8)));
__device__ __forceinline__ void cmp2_block(const Params& P, unsigned char* lds, int pm, int kv, int tid) {
    unsigned char* ws = P.ws; const int lane = tid & 63, wave = __builtin_amdgcn_readfirstlane(tid >> 6), m16 = lane & 15, quad = lane >> 4;
    bf16* W2T = (bf16*)lds;
    {
        const float* w2 = P.in[kv ? 17 : 14]; const bf16* CH = (const bf16*)(ws + (kv ? O_CHV : O_CHK));
        __syncthreads();
#pragma unroll 8
        for (int i = 0; i < 32; ++i) { const int idx = i * NT + tid, hh = idx >> 6, j = idx & 63; W2T[j * 264 + hh] = (bf16)f2bf(w2[idx]); }
        __syncthreads();
#pragma unroll 1
        for (int mi = 0; mi < 2; ++mi) { const int mt = 2 * wave + mi; const int rbase = 256 * pm + 16 * mt;
            cbf16x8 af[8];
#pragma unroll
            for (int kk = 0; kk < 8; ++kk) af[kk] = *(const cbf16x8*)(CH + (size_t)(rbase + m16) * 256 + 32 * kk + 8 * quad);
            f32x4 acc[4];
#pragma unroll
            for (int nt = 0; nt < 4; ++nt) acc[nt] = (f32x4){0.f, 0.f, 0.f, 0.f};
#pragma unroll
            for (int kk = 0; kk < 8; ++kk)
#pragma unroll
                for (int nt = 0; nt < 4; ++nt) { const cbf16x8 bfr = *(const cbf16x8*)(W2T + (16 * nt + m16) * 264 + 32 * kk + 8 * quad); acc[nt] = __builtin_amdgcn_mfma_f32_16x16x32_bf16(af[kk], bfr, acc[nt], 0, 0, 0); }
#pragma unroll
            for (int i = 0; i < 4; ++i) { const int r = rbase + 4 * quad + i; float ss = acc[0][i] * acc[0][i] + acc[1][i] * acc[1][i] + acc[2][i] * acc[2][i] + acc[3][i] * acc[3][i];
                ss += __shfl_xor(ss, 1); ss += __shfl_xor(ss, 2); ss += __shfl_xor(ss, 4); ss += __shfl_xor(ss, 8);
                if (r < 4080) { const int bg = r / 255, c = r % 255;
                    if (kv == 0) { const float rstd = rsqrtf(ss * (1.f / 64.f) + EPS);
#pragma unroll
                        for (int nt = 0; nt < 4; ++nt) { const int j = 16 * nt + m16; ((bf16*)(ws + O_KCB))[((size_t)bg * 256 + c) * 64 + j] = (bf16)f2bf(acc[nt][i] * rstd * P.in[9][j]); } }
                    else {
#pragma unroll
                        for (int nt = 0; nt < 4; ++nt) { const int j = 16 * nt + m16; ((bf16*)(ws + O_VCT))[((size_t)bg * 64 + j) * 256 + c] = (bf16)f2bf(acc[nt][i]); } } } }
        }
    }
    __syncthreads();
}

constexpr int SCAN_N1 = 9, SCAN_NFLAG = SCAN_N1 + 1;
__device__ __forceinline__ void mlstm_intra_item(const Params& P, unsigned char* lds, int it, int tid) {
    unsigned char* ws = P.ws; const int bh = it >> 6, c = it & 63, b = bh >> 2, h = bh & 3;
    const int lane = tid & 63, wave = __builtin_amdgcn_readfirstlane(tid >> 6), m16 = lane & 15, quad = lane >> 4, jt = wave >> 1, sh = wave & 1;
    float* PART = (float*)lds;
    const bf16* MQK = (const bf16*)(ws + O_MQK); const size_t row0 = (size_t)b * SEQ + 64 * c;
    cbf16x8 qf[8], kf[2][8];
    { const bf16* qp = MQK + (row0 + 16 * jt + m16) * 2048 + h * 256 + 8 * quad;
#pragma unroll
      for (int kk = 0; kk < 8; ++kk) qf[kk] = *(const cbf16x8*)(qp + 32 * kk);
#pragma unroll
      for (int t2 = 0; t2 < 2; ++t2) { const bf16* kp = MQK + (row0 + 16 * (2 * sh + t2) + m16) * 2048 + 1024 + h * 256 + 8 * quad;
#pragma unroll
          for (int kk = 0; kk < 8; ++kk) kf[t2][kk] = *(const cbf16x8*)(kp + 32 * kk); } }
    const size_t o1 = (size_t)bh * SEQ + 64 * c;
    const float* GA = (const float*)(ws + O_GA) + o1; const float* GLA = (const float*)(ws + O_GLA) + o1; const float* GPM = (const float*)(ws + O_GPM) + o1;
    float aj[4], mij[4], las[2];
#pragma unroll
    for (int i = 0; i < 4; ++i) { aj[i] = GA[16 * jt + 4 * quad + i]; mij[i] = GPM[16 * jt + 4 * quad + i]; }
#pragma unroll
    for (int t2 = 0; t2 < 2; ++t2) las[t2] = GLA[16 * (2 * sh + t2) + m16];
    float mprev = 0.f; { const float* GG = (const float*)(ws + O_GG) + bh * 64; const float* GMX = (const float*)(ws + O_GMX) + bh * 64; for (int cc = 0; cc < c; ++cc) mprev = fmaxf(GG[cc] + mprev, GMX[cc]); }
    f32x4 acc[2];
#pragma unroll
    for (int t2 = 0; t2 < 2; ++t2) { acc[t2] = (f32x4){0.f, 0.f, 0.f, 0.f};
#pragma unroll
        for (int kk = 0; kk < 8; ++kk) acc[t2] = __builtin_amdgcn_mfma_f32_16x16x32_bf16(qf[kk], kf[t2][kk], acc[t2], 0, 0, 0); }
    if (jt == 0) {
        const float g = ((const float*)(ws + O_GG))[bh * 64 + c], mnew = fmaxf(g + mprev, ((const float*)(ws + O_GMX))[bh * 64 + c]);
        bf16* KU = (bf16*)(ws + O_KTU) + (size_t)it * 16384;
#pragma unroll
        for (int t2 = 0; t2 < 2; ++t2) { const int s = 16 * (2 * sh + t2) + m16; const float us = __expf(g + las[t2] - mnew) * 0.0625f;
#pragma unroll
            for (int kk = 0; kk < 8; ++kk) { const cbf16x8 kv = kf[t2][kk];
#pragma unroll
                for (int i = 0; i < 8; ++i) KU[(size_t)(32 * kk + 8 * quad + i) * 64 + s] = (bf16)f2bf(bf2f((unsigned short)kv[i]) * us); } } }
    bf16* WT = (bf16*)(ws + O_WT) + (size_t)it * 4096;
    __syncthreads();
#pragma unroll
    for (int i = 0; i < 4; ++i) { const int j = 16 * jt + 4 * quad + i; const float mc = fmaxf(aj[i] + mprev, mij[i]); float rs = 0.f;
#pragma unroll
        for (int t2 = 0; t2 < 2; ++t2) { const int s = 16 * (2 * sh + t2) + m16; const float w = (s <= j) ? __expf(aj[i] + las[t2] - mc) * acc[t2][i] * 0.0625f : 0.f; WT[j * 64 + s] = (bf16)f2bf(w); rs += w; }
        rs += __shfl_xor(rs, 1); rs += __shfl_xor(rs, 2); rs += __shfl_xor(rs, 4); rs += __shfl_xor(rs, 8);
        if (m16 == 0) PART[sh * 64 + j] = rs; }
    __syncthreads();
    if (tid < 64) ((float*)(ws + O_DENI))[o1 + tid] = PART[tid] + PART[64 + tid];
    if (c < SCAN_NFLAG) {
        asm volatile("s_waitcnt vmcnt(0)" ::: "memory"); __syncthreads();
        if (tid == 0) { __builtin_amdgcn_fence(__ATOMIC_RELEASE, "agent"); asm volatile("s_waitcnt vmcnt(0)" ::: "memory");
            __hip_atomic_store((unsigned*)ws + 3700 + bh * 16 + c, 1u, __ATOMIC_RELAXED, __HIP_MEMORY_SCOPE_AGENT); } }
}

typedef short sbf16x8 __attribute__((ext_vector_type(8)));
#define LBAR() asm volatile("s_waitcnt lgkmcnt(0)\n\ts_barrier" ::: "memory")
__device__ __forceinline__ unsigned cvtpk2(float lo, float hi) { typedef float f2_ __attribute__((ext_vector_type(2))); typedef __bf16 b2_ __attribute__((ext_vector_type(2))); const f2_ v = {lo, hi}; return __builtin_bit_cast(unsigned, __builtin_convertvector(v, b2_)); }
constexpr int SC_QL = 0, SC_KT = 33792, SC_VT = 70656, SC_WB = 89088, SC_NL = 98304, SC_RS = 100352, SC_OUT = 101376;
struct ScanState { f32x4 acc[16]; float mst, gnx, mxnx, pla, pa, pmi, pdn; v4u pq[4], pk[4], pv[2], pw; };
__device__ __forceinline__ void scan_wait_flag(const Params& P, int bh, int c, int tid) {
    if (tid == 0) { unsigned* f = (unsigned*)P.ws + 3700 + bh * 16 + c; unsigned sp = 0;
        while (__hip_atomic_load(f, __ATOMIC_RELAXED, __HIP_MEMORY_SCOPE_AGENT) == 0u && ++sp < (1u << 22)) __builtin_amdgcn_s_sleep(2);
        __builtin_amdgcn_fence(__ATOMIC_ACQUIRE, "agent"); asm volatile("s_waitcnt vmcnt(0)" ::: "memory"); }
    __syncthreads();
}
__device__ __forceinline__ void mlstm_scan_item(const Params& P, unsigned char* lds, int it, int tid, ScanState& S, int c0, int c1) {
    unsigned char* ws = P.ws; const int bh = it >> 1, eh = it & 1, b = bh >> 2, h = bh & 3;
    const int lane = tid & 63, wave = __builtin_amdgcn_readfirstlane(tid >> 6);
    bf16* QL = (bf16*)(lds + SC_QL); bf16* KT = (bf16*)(lds + SC_KT); bf16* VT = (bf16*)(lds + SC_VT); bf16* WB = (bf16*)(lds + SC_WB); float* NL = (float*)(lds + SC_NL); float* RS = (float*)(lds + SC_RS); float* RD = RS + 64; bf16* OUTL = (bf16*)(lds + SC_OUT);
    const bf16* MQK = (const bf16*)(ws + O_MQK); const bf16* PA = (const bf16*)(ws + O_PA); const bf16* WT = (const bf16*)(ws + O_WT); bf16* HC = (bf16*)(ws + O_HC); const bf16* KTU = (const bf16*)(ws + O_KTU) + (size_t)(bh * 64) * 16384;
    const float* GG = (const float*)(ws + O_GG) + bh * 64; const float* GMX = (const float*)(ws + O_GMX) + bh * 64;
    const float* GA = (const float*)(ws + O_GA) + (size_t)bh * SEQ; const float* GLA = (const float*)(ws + O_GLA) + (size_t)bh * SEQ; const float* GPM = (const float*)(ws + O_GPM) + (size_t)bh * SEQ; const float* DENI = (const float*)(ws + O_DENI) + (size_t)bh * SEQ;
    f32x4 (&acc)[16] = S.acc; float& mst = S.mst;
    if (c0 == 0) {
#pragma unroll
        for (int i = 0; i < 16; ++i) acc[i] = (f32x4){0.f, 0.f, 0.f, 0.f};
        mst = 0.f; }
    v4u (&pq)[4] = S.pq; v4u (&pk)[4] = S.pk; v4u (&pv)[2] = S.pv; v4u& pw = S.pw; float& pla = S.pla; float& pa = S.pa; float& pmi = S.pmi; float& pdn = S.pdn; float& gnx = S.gnx; float& mxnx = S.mxnx;
    if (c0 == 0) {
    __syncthreads();
    if (tid < 256) { NL[tid] = 0.f; NL[256 + tid] = 0.f; }
    scan_wait_flag(P, bh, 0, tid);
    { const size_t row0 = (size_t)b * SEQ; const int ts = tid & 63, tc = tid >> 6, qr_ = tid >> 5, qc8 = (tid & 31) * 8, wr_ = tid >> 3, wc8 = (tid & 7) * 8, dj = tid >> 3;
#pragma unroll
      for (int p = 0; p < 4; ++p) { pq[p] = *(const v4u*)(MQK + (row0 + 16 * p + qr_) * 2048 + h * 256 + qc8); pk[p] = *(const v4u*)(KTU + (size_t)(p * NT + tid) * 8); }
#pragma unroll
      for (int p = 0; p < 2; ++p) pv[p] = *(const v4u*)(PA + (row0 + ts) * NA + PA_MV + h * 256 + eh * 128 + (tc + 8 * p) * 8);
      pw = *(const v4u*)(WT + (size_t)(bh * 64) * 4096 + wr_ * 64 + wc8);
      pla = GLA[ts]; pa = GA[dj]; pmi = GPM[dj]; pdn = DENI[dj]; }
    gnx = GG[0]; mxnx = GMX[0]; }
    for (int c = c0; c < c1; ++c) {
        const size_t row0 = (size_t)b * SEQ + 64 * c;
        const float g = gnx, mx = mxnx; const float mnew = fmaxf(g + mst, mx); const float dec = __expf(g + mst - mnew);
        const float mc = fmaxf(pa + mst, pmi); const float si = __expf(pa + mst - mc), emc = __expf(-mc), dni = pdn;
        const int cur = c & 1;
        int lane_o = lane, tid_o = tid; asm volatile("" : "+v"(lane_o), "+v"(tid_o)); const int m16 = lane_o & 15, quad = lane_o >> 4;
        const int ts = tid_o & 63, tc = tid_o >> 6, qr_ = tid_o >> 5, qc8 = (tid_o & 31) * 8, wr_ = tid_o >> 3, wc8 = (tid_o & 7) * 8, dj = tid_o >> 3, dpart = tid_o & 7; const int tid = tid_o;
        LBAR();
        if (c > 0) {
#pragma unroll
            for (int p = 0; p < 2; ++p) { const int idx = p * NT + tid, j = idx >> 4, c8 = (idx & 15) * 8; *(v4u*)(HC + (row0 - 64 + j) * 1024 + h * 256 + eh * 128 + c8) = *(const v4u*)(OUTL + j * 136 + c8); } }
#pragma unroll
        for (int p = 0; p < 4; ++p) { *(v4u*)(QL + (16 * p + qr_) * 264 + qc8) = pq[p];
            { const int idx = p * NT + tid; *(v4u*)(KT + (idx >> 3) * 72 + (idx & 7) * 8) = pk[p]; } }
#pragma unroll
        for (int p = 0; p < 2; ++p) { bf16* vd = VT + (size_t)((tc + 8 * p) * 8) * 72 + ts; const v4u w = pv[p];
            vd[0 * 72] = (bf16)(w.x & 0xffffu); vd[1 * 72] = (bf16)(w.x >> 16); vd[2 * 72] = (bf16)(w.y & 0xffffu); vd[3 * 72] = (bf16)(w.y >> 16);
            vd[4 * 72] = (bf16)(w.z & 0xffffu); vd[5 * 72] = (bf16)(w.z >> 16); vd[6 * 72] = (bf16)(w.w & 0xffffu); vd[7 * 72] = (bf16)(w.w >> 16); }
        *(v4u*)(WB + wr_ * 72 + wc8) = pw;
        LBAR();
        if (c + 1 < SCAN_NFLAG && c1 < 64) scan_wait_flag(P, bh, c + 1, tid);
        if (c + 1 < 64) { const size_t r1 = row0 + 64;
#pragma unroll
            for (int p = 0; p < 4; ++p) { pq[p] = *(const v4u*)(MQK + (r1 + 16 * p + qr_) * 2048 + h * 256 + qc8); pk[p] = *(const v4u*)(KTU + (size_t)(c + 1) * 16384 + (size_t)(p * NT + tid) * 8); }
#pragma unroll
            for (int p = 0; p < 2; ++p) pv[p] = *(const v4u*)(PA + (r1 + ts) * NA + PA_MV + h * 256 + eh * 128 + (tc + 8 * p) * 8);
            pw = *(const v4u*)(WT + (size_t)(bh * 64 + c + 1) * 4096 + wr_ * 64 + wc8);
            gnx = GG[c + 1]; mxnx = GMX[c + 1]; pla = GLA[64 * (c + 1) + ts]; pa = GA[64 * (c + 1) + dj]; pmi = GPM[64 * (c + 1) + dj]; pdn = DENI[64 * (c + 1) + dj]; }
        { const float* ncur = NL + cur * 256; float dn = 0.f;
#pragma unroll
          for (int d8 = 0; d8 < 32; d8 += 8) { const v4u qw = *(const v4u*)(QL + dj * 264 + dpart * 32 + d8); const float* np = ncur + dpart * 32 + d8;
              dn += lo16(qw.x) * np[0] + hi16(qw.x) * np[1] + lo16(qw.y) * np[2] + hi16(qw.y) * np[3] + lo16(qw.z) * np[4] + hi16(qw.z) * np[5] + lo16(qw.w) * np[6] + hi16(qw.w) * np[7]; }
          dn += __shfl_xor(dn, 1); dn += __shfl_xor(dn, 2); dn += __shfl_xor(dn, 4);
          if (dpart == 0) { RS[dj] = si; RD[dj] = 1.f / fmaxf(fabsf(si * dn + dni), emc); }
          if (tid < 256) { float ks = 0.f;
#pragma unroll
              for (int s8 = 0; s8 < 64; s8 += 8) { const v4u kw = *(const v4u*)(KT + tid * 72 + s8); ks += (lo16(kw.x) + hi16(kw.x)) + (lo16(kw.y) + hi16(kw.y)) + (lo16(kw.z) + hi16(kw.z)) + (lo16(kw.w) + hi16(kw.w)); }
              NL[(cur ^ 1) * 256 + tid] = dec * ncur[tid] + ks; } }
        f32x4 oi[4], oa[4];
#pragma unroll
        for (int jt = 0; jt < 4; ++jt) { oi[jt] = (f32x4){0.f, 0.f, 0.f, 0.f}; oa[jt] = (f32x4){0.f, 0.f, 0.f, 0.f}; }
        sbf16x8 vfr[2]; sbf16x8 wfr[4][2];
#pragma unroll
        for (int ks = 0; ks < 2; ++ks) vfr[ks] = *(const sbf16x8*)(VT + (16 * wave + m16) * 72 + 32 * ks + 8 * quad);
#pragma unroll
        for (int jt = 0; jt < 4; ++jt)
#pragma unroll
            for (int ks = 0; ks < 2; ++ks) wfr[jt][ks] = *(const sbf16x8*)(WB + (16 * jt + m16) * 72 + 32 * ks + 8 * quad);
        asm volatile("" ::: "memory");
#pragma unroll
        for (int jt = 0; jt < 4; ++jt)
#pragma unroll
            for (int ks = 0; ks < 2; ++ks) oa[jt] = __builtin_amdgcn_mfma_f32_16x16x32_bf16(wfr[jt][ks], vfr[ks], oa[jt], 0, 0, 0);
        v2u qa[2][4][2];
#pragma unroll
        for (int jt = 0; jt < 4; ++jt) { const bf16* qp = QL + (16 * jt + m16) * 264 + 4 * quad; qa[0][jt][0] = *(const v2u*)qp; qa[0][jt][1] = *(const v2u*)(qp + 16); }
        asm volatile("" ::: "memory");
#pragma unroll
        for (int kk = 0; kk < 8; ++kk) {
            if (kk + 1 < 8) {
#pragma unroll
                for (int jt = 0; jt < 4; ++jt) { const bf16* qp = QL + (16 * jt + m16) * 264 + 32 * (kk + 1) + 4 * quad; qa[(kk + 1) & 1][jt][0] = *(const v2u*)qp; qa[(kk + 1) & 1][jt][1] = *(const v2u*)(qp + 16); }
                asm volatile("" ::: "memory");
            }
            v4u cw; cw.x = cvtpk2(acc[2 * kk][0], acc[2 * kk][1]); cw.y = cvtpk2(acc[2 * kk][2], acc[2 * kk][3]); cw.z = cvtpk2(acc[2 * kk + 1][0], acc[2 * kk + 1][1]); cw.w = cvtpk2(acc[2 * kk + 1][2], acc[2 * kk + 1][3]);
            const sbf16x8 bfr = __builtin_bit_cast(sbf16x8, cw);
#pragma unroll
            for (int jt = 0; jt < 4; ++jt) { const v4u aw = (v4u){qa[kk & 1][jt][0].x, qa[kk & 1][jt][0].y, qa[kk & 1][jt][1].x, qa[kk & 1][jt][1].y};
                oi[jt] = __builtin_amdgcn_mfma_f32_16x16x32_bf16(__builtin_bit_cast(sbf16x8, aw), bfr, oi[jt], 0, 0, 0); } }
        LBAR();
        { bf16* hp = OUTL + (4 * quad) * 136 + 16 * wave + m16; f32x4 rs4[4], rd4[4];
#pragma unroll
          for (int jt = 0; jt < 4; ++jt) { rs4[jt] = *(const f32x4*)(RS + 16 * jt + 4 * quad); rd4[jt] = *(const f32x4*)(RD + 16 * jt + 4 * quad); }
#pragma unroll
          for (int jt = 0; jt < 4; ++jt)
#pragma unroll
              for (int i = 0; i < 4; ++i) hp[(16 * jt + i) * 136] = (bf16)f2bf((rs4[jt][i] * oi[jt][i] + oa[jt][i]) * rd4[jt][i]); }
        { sbf16x8 kfa[4], kfb[4];
#pragma unroll
          for (int i = 0; i < 4; ++i) kfa[i] = *(const sbf16x8*)(KT + (16 * (i >> 1) + m16) * 72 + 32 * (i & 1) + 8 * quad);
          asm volatile("" ::: "memory");
#pragma unroll
          for (int db = 0; db < 8; ++db) {
            if (db + 1 < 8) {
#pragma unroll
                for (int i = 0; i < 4; ++i) kfb[i] = *(const sbf16x8*)(KT + (16 * (2 * (db + 1) + (i >> 1)) + m16) * 72 + 32 * (i & 1) + 8 * quad);
                asm volatile("" ::: "memory");
            }
#pragma unroll
            for (int i = 0; i < 2; ++i) { const int dt = 2 * db + i; acc[dt] = acc[dt] * dec;
                acc[dt] = __builtin_amdgcn_mfma_f32_16x16x32_bf16(kfa[2 * i], vfr[0], acc[dt], 0, 0, 0); acc[dt] = __builtin_amdgcn_mfma_f32_16x16x32_bf16(kfa[2 * i + 1], vfr[1], acc[dt], 0, 0, 0); }
            if (db + 1 < 8) {
#pragma unroll
                for (int i = 0; i < 4; ++i) kfa[i] = kfb[i];
            }
          } }
        mst = mnew;
    }
    if (c1 == 64) { LBAR();
    { const size_t rowl = (size_t)b * SEQ + 64 * 63;
#pragma unroll
      for (int p = 0; p < 2; ++p) { const int idx = p * NT + tid, j = idx >> 4, c8 = (idx & 15) * 8; *(v4u*)(HC + (rowl + j) * 1024 + h * 256 + eh * 128 + c8) = *(const v4u*)(OUTL + j * 136 + c8); } }
}
}
#define GAS __attribute__((address_space(1)))
typedef GAS unsigned gu32;
typedef GAS unsigned long long gu64;
#define RLX_AGENT __ATOMIC_RELAXED, __HIP_MEMORY_SCOPE_AGENT
#define LDS_WAIT() asm volatile("s_waitcnt lgkmcnt(0)" ::: "memory")
#define VM_WAIT() asm volatile("s_waitcnt vmcnt(0)" ::: "memory")
__device__ __forceinline__ unsigned long long rt() { return __builtin_amdgcn_s_memrealtime(); }
#define XB_TMO      128
#define XB_XCNT(j)  (256  + 64 * (j))
#define XB_XSUB(j)  (1280 + 64 * (j))
#define XB_XGEN(j)  (2304 + 64 * (j))
#define XB_TOP      3328
#define XB_TOPGEN   3392
#define XCD_BAR_WORDS 3456
#define XB_SPIN_CAP (1u << 18)

__device__ __forceinline__ unsigned xb_ld(unsigned* p)              { return __hip_atomic_load(p, __ATOMIC_RELAXED, __HIP_MEMORY_SCOPE_AGENT); }
__device__ __forceinline__ unsigned xb_add(unsigned* p, unsigned v) { return __hip_atomic_fetch_add(p, v, __ATOMIC_RELAXED, __HIP_MEMORY_SCOPE_AGENT); }
__device__ __forceinline__ unsigned xb_xcc_id() { return (unsigned)__builtin_amdgcn_s_getreg((3 << 11) | 20) & 0xFu; }
#define XB_SPIN(cond, bar) do { unsigned _sp = 0; while (cond) { __builtin_amdgcn_s_sleep(1); \
    if ((++_sp & 255u) == 0u) { if (xb_ld(&(bar)[XB_TMO])) break; if (_sp > XB_SPIN_CAP) { atomicAdd(&(bar)[XB_TMO], 1u); break; } } } } while (0)

struct XcdBarrier {
    unsigned* bar; unsigned x;
    volatile LAS unsigned* st;
};

__device__ __forceinline__ XcdBarrier xcd_barrier_post(unsigned* bar, volatile LAS unsigned* st) {
    XcdBarrier b; b.bar = bar; b.x = xb_xcc_id(); b.st = st;
    if (threadIdx.x == 0) (void)xb_add(&bar[XB_XCNT(b.x)], 1u);
    return b;
}
__device__ __forceinline__ void xcd_barrier_complete(unsigned* bar, unsigned x, unsigned& nloc, unsigned& nx) {
    const unsigned G = gridDim.x * gridDim.y * gridDim.z;
    unsigned sum, cnt, mine, sp = 0u;
    for (;;) {
        sum = 0u; cnt = 0u; mine = 0u;
#pragma unroll
        for (unsigned j = 0; j < 16; ++j) { const unsigned c = xb_ld(&bar[XB_XCNT(j)]); sum += c; cnt += (c > 0u) ? 1u : 0u; mine = (j == x) ? c : mine; }
        if (sum == G) break;
        __builtin_amdgcn_s_sleep(1);
        if ((++sp & 255u) == 0u) { if (xb_ld(&bar[XB_TMO])) break; if (sp > XB_SPIN_CAP) { atomicAdd(&bar[XB_TMO], 1u); break; } }
    }
    nloc = mine > 0u ? mine : 1u; nx = cnt > 0u ? cnt : 1u;
}

__device__ __forceinline__ void xcd_barrier(const XcdBarrier& b) {
    asm volatile("s_waitcnt vmcnt(0)" ::: "memory");
    __syncthreads();
    if (threadIdx.x == 0) {
        unsigned* bar = b.bar;
        __builtin_amdgcn_s_waitcnt(0);
        unsigned nloc = b.st[0], nx = b.st[1];
        if (nloc == 0u) { xcd_barrier_complete(bar, b.x, nloc, nx); b.st[0] = nloc; b.st[1] = nx; }
        const unsigned old = xb_add(&bar[XB_XSUB(b.x)], 1u);
        const unsigned gen = old / nloc;
        if (old + 1u == (gen + 1u) * nloc) {
            __builtin_amdgcn_fence(__ATOMIC_RELEASE, "agent");
            asm volatile("s_waitcnt vmcnt(0)" ::: "memory");
            const unsigned og = xb_add(&bar[XB_TOP], 1u);
            const unsigned tg = og / nx;
            if (og + 1u == (tg + 1u) * nx) xb_add(&bar[XB_TOPGEN], 1u);
            else XB_SPIN(xb_ld(&bar[XB_TOPGEN]) == tg, bar);
            __builtin_amdgcn_fence(__ATOMIC_ACQUIRE, "agent");
            xb_add(&bar[XB_XGEN(b.x)], 1u);
            asm volatile("s_waitcnt vmcnt(0)" ::: "memory");
        } else {
            XB_SPIN(xb_ld(&bar[XB_XGEN(b.x)]) == gen, bar);
            __builtin_amdgcn_fence(__ATOMIC_ACQUIRE, "agent");
            asm volatile("s_waitcnt vmcnt(0)" ::: "memory");
        }
    }
    __syncthreads();
}

typedef float f32x16 __attribute__((ext_vector_type(16)));
typedef short bf16x8 __attribute__((ext_vector_type(8)));
constexpr int NSA_KL = 0, NSA_VL = 9216, NSA_SET = 27648  , NSA_IMP = 55296, NSA_SEL = 120832, NSA_FAC = 121856, NSA_VALS = 123904;
__device__ __forceinline__ unsigned cvtpk(float lo, float hi) { typedef float f2_ __attribute__((ext_vector_type(2))); typedef __bf16 b2_ __attribute__((ext_vector_type(2))); const f2_ v = {lo, hi}; return __builtin_bit_cast(unsigned, __builtin_convertvector(v, b2_)); }
__device__ __forceinline__ int crow(int r, int hi) { return (r & 3) + 8 * (r >> 2) + 4 * hi; }
#define CBAR() asm volatile("" ::: "memory")
template <int ND, bool MASK = true>
__device__ __forceinline__ void nsa_tile(const bf16* KL, const bf16* VL, const bf16x8 (&qr)[4], float negM, int klo, int khi, float& lsum, f32x16 (&o)[4], int r32, int hi) {
    f32x16 p0, p1; { float nm = negM; asm volatile("" : "+v"(nm));
#pragma unroll
    for (int r = 0; r < 16; ++r) { p0[r] = nm; p1[r] = nm; } }
    bf16x8 kf[8];
#pragma unroll
    for (int d0 = 0; d0 < 4; ++d0) { kf[2 * d0] = *(const bf16x8*)(KL + r32 * 72 + 16 * d0 + 8 * hi); kf[2 * d0 + 1] = *(const bf16x8*)(KL + (32 + r32) * 72 + 16 * d0 + 8 * hi); }
    CBAR();
#pragma unroll
    for (int d0 = 0; d0 < 4; ++d0) { p0 = __builtin_amdgcn_mfma_f32_32x32x16_bf16(kf[2 * d0], qr[d0], p0, 0, 0, 0); p1 = __builtin_amdgcn_mfma_f32_32x32x16_bf16(kf[2 * d0 + 1], qr[d0], p1, 0, 0, 0); }
    v2u va[4][2];
#pragma unroll
    for (int ks = 0; ks < 4; ++ks) { const bf16* vp = VL + r32 * 72 + 16 * ks + 4 * hi; va[ks][0] = *(const v2u*)vp; va[ks][1] = *(const v2u*)(vp + 8); }
    CBAR();
    const int lo2 = klo - 4 * hi, hi2 = khi - 4 * hi; float ls = 0.f;
#pragma unroll
    for (int r = 0; r < 16; ++r) { const int cr = (r & 3) + 8 * (r >> 2);
        if constexpr (MASK) { p0[r] = (cr > lo2 && cr <= hi2) ? __builtin_amdgcn_exp2f(p0[r]) : 0.f; p1[r] = (cr + 32 > lo2 && cr + 32 <= hi2) ? __builtin_amdgcn_exp2f(p1[r]) : 0.f; }
        else { p0[r] = __builtin_amdgcn_exp2f(p0[r]); p1[r] = __builtin_amdgcn_exp2f(p1[r]); }
        ls += p0[r] + p1[r]; }
    lsum += ls;
    bf16x8 pf[4];
    { v4u w; w.x = cvtpk(p0[0], p0[1]); w.y = cvtpk(p0[2], p0[3]); w.z = cvtpk(p0[4], p0[5]); w.w = cvtpk(p0[6], p0[7]); pf[0] = __builtin_bit_cast(bf16x8, w);
      w.x = cvtpk(p0[8], p0[9]); w.y = cvtpk(p0[10], p0[11]); w.z = cvtpk(p0[12], p0[13]); w.w = cvtpk(p0[14], p0[15]); pf[1] = __builtin_bit_cast(bf16x8, w);
      w.x = cvtpk(p1[0], p1[1]); w.y = cvtpk(p1[2], p1[3]); w.z = cvtpk(p1[4], p1[5]); w.w = cvtpk(p1[6], p1[7]); pf[2] = __builtin_bit_cast(bf16x8, w);
      w.x = cvtpk(p1[8], p1[9]); w.y = cvtpk(p1[10], p1[11]); w.z = cvtpk(p1[12], p1[13]); w.w = cvtpk(p1[14], p1[15]); pf[3] = __builtin_bit_cast(bf16x8, w); }
#pragma unroll
    for (int d0 = 0; d0 < ND; ++d0) {
        v2u vb[4][2];
        if (d0 + 1 < ND) {
#pragma unroll
            for (int ks = 0; ks < 4; ++ks) { const bf16* vp = VL + (32 * (d0 + 1) + r32) * 72 + 16 * ks + 4 * hi; vb[ks][0] = *(const v2u*)vp; vb[ks][1] = *(const v2u*)(vp + 8); }
            CBAR();
        }
#pragma unroll
        for (int ks = 0; ks < 4; ++ks) { const v4u w = (v4u){va[ks][0].x, va[ks][0].y, va[ks][1].x, va[ks][1].y}; o[d0] = __builtin_amdgcn_mfma_f32_32x32x16_bf16(pf[ks], __builtin_bit_cast(bf16x8, w), o[d0], 0, 0, 0); }
        if (d0 + 1 < ND) {
#pragma unroll
            for (int ks = 0; ks < 4; ++ks) { va[ks][0] = vb[ks][0]; va[ks][1] = vb[ks][1]; }
        }
    }
}
__device__ __forceinline__ void nsa_unit(const Params& P, unsigned char* lds, int bg, int qi, int tid, int lane, int wave, float negMc, float negMs, float negMw) {
    asm volatile("" : "+v"(lane), "+v"(tid));
    unsigned char* ws = P.ws; const int b = bg >> 2, g = bg & 3, r32 = lane & 31, hi = lane >> 5, head = wave >> 1, half = wave & 1;
    const int tq = 64 * qi + 32 * half + r32;
    bf16* KL = (bf16*)(lds + NSA_KL); bf16* VL = (bf16*)(lds + NSA_VL); float* IMP = (float*)(lds + NSA_IMP); unsigned long long* SEL = (unsigned long long*)(lds + NSA_SEL);
    float* FAC = (float*)(lds + NSA_FAC) + wave * 64; float* VALS = (float*)(lds + NSA_VALS) + wave * 64;
    const bf16* PA = (const bf16*)(ws + O_PA); const size_t rowq = (size_t)b * SEQ + tq;
    bf16x8 qr[4]; { const bf16* qp = PA + rowq * NA + PA_Q + (g * 4 + head) * 64 + 8 * hi;
#pragma unroll
        for (int d0 = 0; d0 < 4; ++d0) qr[d0] = *(const bf16x8*)(qp + 16 * d0); }
    float gpre0, gpre1, gpre2; { const float* sm = (const float*)(ws + O_SM) + rowq * 64 + (g * 4 + head) * 3; gpre0 = sm[0]; gpre1 = sm[1]; gpre2 = sm[2]; }
    const int ldr = tid >> 3, ldc8 = (tid & 7) * 8;
    float* OSW = (float*)(lds + NSA_IMP) + wave * 2048;
#define OSWI(q_, blk_) (((blk_) * 32 + r32) * 32 + ((q_) ^ r32))
    f32x16 o[4];
    __syncthreads();
    if (tid == 0) SEL[64] = 0ull;
    bf16* KL1 = (bf16*)(lds + NSA_SET + NSA_KL); bf16* VL1 = (bf16*)(lds + NSA_SET + NSA_VL);
    const int so = ldr * 72 + ldc8;
#define NSA_LBAR() asm volatile("s_waitcnt lgkmcnt(0)\n\ts_barrier" ::: "memory")
#define NSA_LOAD(n, kr, vr) do { if ((n) >= 0) { kr = *(const v4u*)(KSRC(n)); vr = *(const v4u*)(VSRC(n)); } } while (0)
#define NSA_STAGE(na, nb, ka, va, kb, vb) do { NSA_LBAR(); *(v4u*)(KL + so) = ka; *(v4u*)(VL + so) = va; if ((nb) >= 0) { *(v4u*)(KL1 + so) = kb; *(v4u*)(VL1 + so) = vb; } EXTRA(na, nb); NSA_LBAR(); } while (0)
#define NSA_PIPE() do { int a0, b0, a1, b1; v4u k0a, v0a, k0b, v0b, k1a, v1a, k1b, v1b; k0a = v0a = k0b = v0b = k1a = v1a = k1b = v1b = (v4u){0u, 0u, 0u, 0u}; \
        POPN(a0); POPN(b0); POPN(a1); POPN(b1); NSA_LOAD(a0, k0a, v0a); NSA_LOAD(b0, k0b, v0b); NSA_LOAD(a1, k1a, v1a); NSA_LOAD(b1, k1b, v1b); \
        while (a0 >= 0) { \
            NSA_STAGE(a0, b0, k0a, v0a, k0b, v0b); \
            { const int ca = a0, cb = b0; POPN(a0); POPN(b0); NSA_LOAD(a0, k0a, v0a); NSA_LOAD(b0, k0b, v0b); TILE(KL, VL, ca); if (cb >= 0) TILE(KL1, VL1, cb); } \
            if (a1 < 0) break; \
            NSA_STAGE(a1, b1, k1a, v1a, k1b, v1b); \
            { const int ca = a1, cb = b1; POPN(a1); POPN(b1); NSA_LOAD(a1, k1a, v1a); NSA_LOAD(b1, k1b, v1b); TILE(KL, VL, ca); if (cb >= 0) TILE(KL1, VL1, cb); } \
        } } while (0)
    {
#pragma unroll
        for (int d0 = 0; d0 < 4; ++d0)
#pragma unroll
            for (int r = 0; r < 16; ++r) o[d0][r] = 0.f;
        const bf16* Kc = (const bf16*)(ws + O_KCB) + (size_t)bg * 256 * 64 + (size_t)ldr * 64 + ldc8; const bf16* Vc = (const bf16*)(ws + O_VCT) + (size_t)bg * 64 * 256 + (size_t)ldr * 256 + ldc8;
        const int ntile = ((4 * qi + 2) >> 6) + 1; const int cmaxq = (tq >= 31) ? ((tq - 31) >> 4) : -1; float lsum = 0.f; int tl = 0;
#define POPN(n) do { n = (tl < ntile) ? tl : -1; ++tl; } while (0)
#define KSRC(n) (Kc + (size_t)64 * (n) * 64)
#define VSRC(n) (Vc + 64 * (n))
#define OVROW(dst, n) do { const int cb_ = 64 * (n) + ldc8, lo_ = 4 * ldr - 1, hi_ = (4 * ldr + 3 < 254) ? 4 * ldr + 3 : 254; v4u w_; \
            w_.x = (((cb_ + 0) >= lo_ && (cb_ + 0) <= hi_) ? 0x3F80u : 0u) | (((cb_ + 1) >= lo_ && (cb_ + 1) <= hi_) ? 0x3F800000u : 0u); w_.y = (((cb_ + 2) >= lo_ && (cb_ + 2) <= hi_) ? 0x3F80u : 0u) | (((cb_ + 3) >= lo_ && (cb_ + 3) <= hi_) ? 0x3F800000u : 0u); \
            w_.z = (((cb_ + 4) >= lo_ && (cb_ + 4) <= hi_) ? 0x3F80u : 0u) | (((cb_ + 5) >= lo_ && (cb_ + 5) <= hi_) ? 0x3F800000u : 0u); w_.w = (((cb_ + 6) >= lo_ && (cb_ + 6) <= hi_) ? 0x3F80u : 0u) | (((cb_ + 7) >= lo_ && (cb_ + 7) <= hi_) ? 0x3F800000u : 0u); \
            *(v4u*)((dst) + (64 + ldr) * 72 + ldc8) = w_; } while (0)
#define EXTRA(na, nb) do { OVROW(VL, na); if ((nb) >= 0) OVROW(VL1, nb); } while (0)
#define TILE(K_, V_, n) nsa_tile<4, true>(K_, V_, qr, negMc, -1, cmaxq - 64 * (n), lsum, o, r32, hi)
        NSA_PIPE();
#undef POPN
#undef KSRC
#undef VSRC
#undef EXTRA
#undef TILE
        lsum += __shfl_xor(lsum, 32); const float inv = lsum > 0.f ? 1.f / lsum : 0.f;
        if (hi == 0) { FAC[r32] = inv * sigmf(gpre0); FAC[32 + r32] = inv; }
        WSYNC();
#pragma unroll
        for (int r = 0; r < 16; ++r) { const int q = crow(r, hi); const float f = FAC[q], f2 = FAC[32 + q];
            o[0][r] *= f; o[1][r] *= f;
            float* ip = IMP + ((size_t)head * 64 + 32 * half + q) * 64 + r32; ip[0] = o[2][r] * f2; ip[32] = o[3][r] * f2; }
        __syncthreads();
#pragma unroll 1
        for (int tk = 0; tk < 8; ++tk) { const int tok = 8 * wave + tk; const float* ip = IMP + (size_t)tok * 64 + lane;
            const float impv = ip[0] + ip[4096] + ip[8192] + ip[12288];
            const float val = (lane == 0 || lane == qi || lane == qi - 1) ? 1e4f : ((lane <= qi) ? impv : -1.f);
            const unsigned ub = __float_as_uint(val); const unsigned key = (ub & 0x80000000u) ? ~ub : (ub | 0x80000000u);
            unsigned thr = 0u;
#pragma unroll
            for (int bit = 31; bit >= 0; --bit) { const unsigned cand = thr | (1u << bit); if (__popcll(__ballot(key >= cand)) >= 16) thr = cand; }
            const unsigned long long gtm = __ballot(key > thr), eqm = __ballot(key == thr); const int need = 16 - __popcll(gtm);
            const int below = __popcll(eqm & ((1ull << lane) - 1ull));
            const bool sel = (key > thr) || (key == thr && below < need);
            const unsigned long long mask = __ballot(sel && lane <= qi);
            if (lane == 0) { SEL[tok] = mask; atomicOr(&SEL[64], mask); } }
        __syncthreads();
#pragma unroll
        for (int r = 0; r < 16; ++r) { const int q = crow(r, hi); OSW[OSWI(q, 0)] = o[0][r]; OSW[OSWI(q, 1)] = o[1][r]; }
    }
#define EXTRA(na, nb) do { } while (0)
    {
        const unsigned long long mysel = SEL[32 * half + r32]; unsigned long long om = SEL[64];
#pragma unroll
        for (int d0 = 0; d0 < 2; ++d0)
#pragma unroll
            for (int r = 0; r < 16; ++r) o[d0][r] = 0.f;
        const bf16* Ks = PA + (size_t)b * SEQ * NA + PA_KV + 2 * 256 + g * 64 + (size_t)ldr * NA + ldc8; const bf16* Vs = (const bf16*)(ws + O_VTS) + (size_t)bg * 64 * SEQ + (size_t)ldr * 64 + ldc8; float lsum = 0.f;
#define POPN(n) do { if (om) { n = __builtin_ctzll(om); om &= om - 1; } else n = -1; } while (0)
#define KSRC(n) (Ks + (size_t)64 * (n) * NA)
#define VSRC(n) (Vs + (size_t)4096 * (n))
#define TILE(K_, V_, n) do { const bool selb = (mysel >> (n)) & 1ull; \
            if ((n) == qi) nsa_tile<2, true>(K_, V_, qr, negMs, -1, tq - 64 * (n), lsum, o, r32, hi);        \
            else if (__any(selb)) nsa_tile<2, false>(K_, V_, qr, selb ? negMs : -1e30f, 0, 0, lsum, o, r32, hi); } while (0)
        NSA_PIPE();
#undef POPN
#undef KSRC
#undef VSRC
#undef TILE
        lsum += __shfl_xor(lsum, 32); const float inv = lsum > 0.f ? 1.f / lsum : 0.f;
        WSYNC(); if (hi == 0) FAC[r32] = inv * sigmf(gpre1); WSYNC();
#pragma unroll
        for (int r = 0; r < 16; ++r) { const int q = crow(r, hi); const float f = FAC[q]; OSW[OSWI(q, 0)] += o[0][r] * f; OSW[OSWI(q, 1)] += o[1][r] * f; }
    }
    {
#pragma unroll
        for (int d0 = 0; d0 < 2; ++d0)
#pragma unroll
            for (int r = 0; r < 16; ++r) o[d0][r] = 0.f;
        const bf16* Kw = PA + (size_t)b * SEQ * NA + PA_KV + 4 * 256 + g * 64 + (size_t)ldr * NA + ldc8; const bf16* Vw = (const bf16*)(ws + O_VTW) + (size_t)bg * 64 * SEQ + (size_t)ldr * 64 + ldc8; float lsum = 0.f;
        int wn = qi >= 8 ? qi - 8 : 0;
#define POPN(n) do { n = (wn <= qi) ? wn : -1; ++wn; } while (0)
#define KSRC(n) (Kw + (size_t)64 * (n) * NA)
#define VSRC(n) (Vw + (size_t)4096 * (n))
#define TILE(K_, V_, n) do { if ((n) == qi || (n) == qi - 8) nsa_tile<2, true>(K_, V_, qr, negMw, tq - 512 - 64 * (n), tq - 64 * (n), lsum, o, r32, hi); \
            else nsa_tile<2, false>(K_, V_, qr, negMw, 0, 0, lsum, o, r32, hi); } while (0)
        NSA_PIPE();
#undef POPN
#undef KSRC
#undef VSRC
#undef TILE
        lsum += __shfl_xor(lsum, 32); const float inv = lsum > 0.f ? 1.f / lsum : 0.f;
        WSYNC(); if (hi == 0) FAC[r32] = inv * sigmf(gpre2); WSYNC();
#pragma unroll
        for (int r = 0; r < 16; ++r) { const int q = crow(r, hi); const float f = FAC[q]; OSW[OSWI(q, 0)] += o[0][r] * f; OSW[OSWI(q, 1)] += o[1][r] * f; }
    }
#undef EXTRA
    { WSYNC(); const int q = lane >> 1, dh = lane & 1; float v[32];
#pragma unroll
      for (int j = 0; j < 32; ++j) v[j] = OSW[(32 * dh + j) * 32 + (q ^ j)];
      bf16* op = (bf16*)(ws + O_ONSA) + ((size_t)b * SEQ + 64 * qi + 32 * half + q) * 1024 + (g * 4 + head) * 64 + 32 * dh;
#pragma unroll
      for (int k = 0; k < 4; ++k) { v4u w; w.x = cvtpk(v[8 * k], v[8 * k + 1]); w.y = cvtpk(v[8 * k + 2], v[8 * k + 3]); w.z = cvtpk(v[8 * k + 4], v[8 * k + 5]); w.w = cvtpk(v[8 * k + 6], v[8 * k + 7]); *(v4u*)(op + 8 * k) = w; }
      WSYNC(); }
#undef OSWI
}
__device__ __forceinline__ void hm_item8(const Params& P, int it0, int lane) {
    unsigned char* ws = P.ws; v2u hw[8], mo[8];
#pragma unroll
    for (int k = 0; k < 8; ++k) { const int it = it0 + k, row = it >> 2, h = it & 3;
        hw[k] = *(const v2u*)((const bf16*)(ws + O_HC) + (size_t)row * 1024 + h * 256 + 4 * lane);
        mo[k] = *(const v2u*)((const bf16*)(ws + O_PA) + (size_t)row * NA + PA_MO + h * 256 + 4 * lane); }
#pragma unroll
    for (int k = 0; k < 8; ++k) { const int it = it0 + k, row = it >> 2, h = it & 3;
        const float x0 = lo16(hw[k].x), x1 = hi16(hw[k].x), x2 = lo16(hw[k].y), x3 = hi16(hw[k].y);
        const float ss = wave_sum(x0 * x0 + x1 * x1 + x2 * x2 + x3 * x3); const float rstd = rsqrtf(ss * (1.f / 256.f) + EPS);
        v2u o; o.x = pk2(sigmf(lo16(mo[k].x)) * x0 * rstd, sigmf(hi16(mo[k].x)) * x1 * rstd); o.y = pk2(sigmf(lo16(mo[k].y)) * x2 * rstd, sigmf(hi16(mo[k].y)) * x3 * rstd);
        *(v2u*)((bf16*)(ws + O_HM) + (size_t)row * 1024 + h * 256 + 4 * lane) = o; }
}

constexpr int N_PHASES = 16;
__global__ void __launch_bounds__(NT, 2) mk_fwd(Params P) {
    extern __shared__ __attribute__((aligned(16))) unsigned char lds[];
    cg::grid_group grid = cg::this_grid();
    const int G = gridDim.x, bx = blockIdx.x, ngw = G * NWV;
#define TIDS() int tid = threadIdx.x; asm volatile("" : "+v"(tid)); const int lane = tid & 63, wave = __builtin_amdgcn_readfirstlane(tid >> 6), gw = bx * NWV + wave; (void)gw; (void)lane
    unsigned char* ws = P.ws; const int lo = P.ph_lo, hi = P.ph_hi;
    PG8_LAS unsigned char* lds3 = (PG8_LAS unsigned char*)lds;
#define IN(k) (lo <= (k) && (k) < hi)
    const bool multi = (hi - lo) > 1;
    volatile LAS unsigned* bst = (volatile LAS unsigned*)((LAS unsigned char*)lds + (LDS_BYTES - 64));
    XcdBarrier xbar; xbar.bar = (unsigned*)ws; xbar.x = 0; xbar.st = bst;
    if (multi) { if (threadIdx.x < 2) bst[threadIdx.x] = 0u; __syncthreads(); xbar = xcd_barrier_post((unsigned*)ws, bst); }
#define SEAM(k) do { if (IN(k) && IN((k) + 1)) { if ((k) == 0) grid.sync(); else xcd_barrier(xbar); } } while (0)
#define GEMMC(EPI, Aoff, Boff, MM, NN, KK, E, CID) do { pg8::Gemm g_{(const pg8::bf16_t*)(ws + (Aoff)), (const pg8::bf16_t*)(ws + (Boff)), (MM), (NN), (KK)}; pg8::StaticOrder S_; S_.init((MM), (NN), G, (CID)); \
        pg8::gemm_phase<EPI, pg8::StaticOrder, true, true>(lds3, g_, S_, (E)); } while (0)
#define GEMMNA(EPI, Aoff, Boff, MM, NN, KK, E) do { pg8::Gemm g_{(const pg8::bf16_t*)(ws + (Aoff)), (const pg8::bf16_t*)(ws + (Boff)), (MM), (NN), (KK)}; pg8::StaticOrder S_; S_.init((MM), (NN), G, bx); \
        pg8::gemm_phase<EPI, pg8::StaticOrder, false, true>(lds3, g_, S_, (E)); } while (0)
#define GEMM(EPI, Aoff, Boff, MM, NN, KK, E) do { pg8::Gemm g_{(const pg8::bf16_t*)(ws + (Aoff)), (const pg8::bf16_t*)(ws + (Boff)), (MM), (NN), (KK)}; pg8::StaticOrder S_; S_.init((MM), (NN), G, bx); \
        pg8::gemm_phase<EPI, pg8::StaticOrder, true, true>(lds3, g_, S_, (E)); } while (0)
    ScanState sst;
    const bool scanwg = (bx >= 32 && bx < 64 && G >= 64);
    if (IN(0)) { TIDS(); phase_prologue(P, lds, gw, ngw, wave, lane, tid); } SEAM(0);
    if (IN(1)) { pg8::EpiP<0> E{(pg8::bf16_t*)(ws + O_H), FF, nullptr, nullptr, 0, nullptr}; GEMM(pg8::EpiP<0>, O_XN, O_WGU, TOK, 2 * FF, DM, E); } SEAM(1);
    if (IN(2)) { pg8::EpiResid E{P.in[0], P.out, DM, 0.5f}; GEMMNA(pg8::EpiResid, O_H, O_WD, TOK, DM, FF, E); } SEAM(2);
    if (IN(3)) { TIDS(); phase_norm(P.out, (bf16*)(ws + O_XN), gw, ngw, lane); } SEAM(3);
    if (IN(4)) { pg8::EpiP<1> E{(pg8::bf16_t*)(ws + O_PA), NA, (const float*)(ws + O_BIASA), nullptr, 0, (float*)(ws + O_SM)}; GEMM(pg8::EpiP<1>, O_XN, O_WINA, TOK, NA, DM, E); } SEAM(4);
    if (IN(5)) { TIDS(); phase_prep(P, gw, ngw, lane); } SEAM(5);
    if (IN(6)) {
        { pg8::EpiP<3> E{(pg8::bf16_t*)(ws + O_CHK), 256, nullptr, nullptr, 0, nullptr}; GEMM(pg8::EpiP<3>, O_CBK, O_WC1K, 4096, 256, 2048, E); }
        { pg8::EpiP<3> E{(pg8::bf16_t*)(ws + O_CHV), 256, nullptr, nullptr, 0, nullptr}; GEMMC(pg8::EpiP<3>, O_CBV, O_WC1V, 4096, 256, 2048, E, (bx + G - 16) % G); }
        { TIDS(); if (bx < 32 && G >= 32) { const int cid = bx & 15; cmp2_block(P, lds, (cid % 8) * 2 + cid / 8, bx >> 4, tid); }
          unsigned* ictr = (unsigned*)ws + 3502;
          if (scanwg && multi) mlstm_scan_item(P, lds, bx - 32, tid, sst, 0, SCAN_N1);
          else for (;;) { __syncthreads(); if (tid == 0) bst[4] = __hip_atomic_fetch_add(ictr, 1u, __ATOMIC_RELAXED, __HIP_MEMORY_SCOPE_AGENT); __syncthreads();
              const int v = (int)bst[4]; if (v >= 1024) break; mlstm_intra_item(P, lds, (v & 15) * 64 + (v >> 4), tid); } }
    } SEAM(6);
    if (IN(8)) { TIDS();
#define UNI(x) __builtin_bit_cast(float, __builtin_amdgcn_readfirstlane(__builtin_bit_cast(int, (x))))
        const float mq = UNI(wave_max(fabsf(P.in[8][lane]))) * (8.f * 1.4426950408889634f);
        const float negMc = -mq * UNI(wave_max(fabsf(P.in[9][lane]))), negMs = -mq * UNI(wave_max(fabsf(P.in[10][lane]))), negMw = -mq * UNI(wave_max(fabsf(P.in[11][lane])));
#undef UNI
        if (scanwg) mlstm_scan_item(P, lds, bx - 32, tid, sst, multi ? SCAN_N1 : 0, 64);
        unsigned* qctr = (unsigned*)ws + 3500;
        __syncthreads(); if (tid == 0) bst[4] = __hip_atomic_fetch_add(qctr, 1u, __ATOMIC_RELAXED, __HIP_MEMORY_SCOPE_AGENT); __syncthreads();
        int u = (int)bst[4];
        for (int sl = 0; u < 1024; sl ^= 1) {
            if (tid == 0) bst[5 - sl] = __hip_atomic_fetch_add(qctr, 1u, __ATOMIC_RELAXED, __HIP_MEMORY_SCOPE_AGENT);
            nsa_unit(P, lds, u & 15, 63 - (u >> 4), tid, lane, wave, negMc, negMs, negMw);
            __syncthreads(); u = (int)bst[5 - sl]; }
    } SEAM(8);
    if (IN(9)) { { TIDS(); for (int it = gw * 8; it < 65536; it += ngw * 8) { hm_item8(P, it, lane); } }
        if (multi) xcd_barrier(xbar);
        pg8::EpiP<2> E{(pg8::bf16_t*)(ws + O_MG), NB, (const float*)(ws + O_BIASB), nullptr, 0, nullptr}; GEMM(pg8::EpiP<2>, O_XN, O_WINB, TOK, NB, DM, E); } SEAM(9);
    if (IN(10)) { pg8::EpiP<4> E{(pg8::bf16_t*)(ws + O_XN), DM, nullptr, (const pg8::bf16_t*)(ws + O_MG), NB, nullptr}; GEMM(pg8::EpiP<4>, O_ONSA, O_WBN, TOK, DM, 1024, E); }
    if (IN(11)) { pg8::EpiP<5> E{(pg8::bf16_t*)(ws + O_XN), DM, nullptr, (const pg8::bf16_t*)(ws + O_MG), NB, nullptr}; GEMM(pg8::EpiP<5>, O_HM, O_WBM, TOK, DM, 1024, E); } SEAM(11);
    if (IN(12)) { pg8::EpiResid E{P.out, P.out, DM, 1.0f}; GEMMNA(pg8::EpiResid, O_XN, O_WOUT, TOK, DM, DM, E); } SEAM(12);
    if (IN(13)) { TIDS(); phase_norm(P.out, (bf16*)(ws + O_XN), gw, ngw, lane); phase_conv_ffn2(P, lds, gw, ngw, wave, lane); } SEAM(13);
    if (IN(14)) { pg8::EpiP<0> E{(pg8::bf16_t*)(ws + O_H), FF, nullptr, nullptr, 0, nullptr}; GEMM(pg8::EpiP<0>, O_XN, O_WGU, TOK, 2 * FF, DM, E); } SEAM(14);
    if (IN(15)) { pg8::EpiResid E{P.out, P.out, DM, 0.5f}; GEMMNA(pg8::EpiResid, O_H, O_WD, TOK, DM, FF, E); }
#undef IN
#undef SEAM
#undef GEMM
#undef GEMMNA
}

#ifndef MK_COOP
#define MK_COOP 0
#endif
extern "C" void kernel_launch(void* const* d_in, const int* in_sizes, int n_in, void* d_out, int out_size, void* d_ws, size_t ws_size, hipStream_t stream) {
    static int grid = 0;
    if (grid == 0) {
        if (n_in != 28 || ws_size < WS_NEED) { fprintf(stderr, "kernel_launch: unexpected n_in %d / ws_size %zu\n", n_in, ws_size); grid = -1; return; }
        int dev = 0, cus = 0, per_cu = 0;
        hipGetDevice(&dev); hipDeviceGetAttribute(&cus, hipDeviceAttributeMultiprocessorCount, dev);
        hipFuncSetAttribute((const void*)mk_fwd, hipFuncAttributeMaxDynamicSharedMemorySize, LDS_BYTES);
        hipOccupancyMaxActiveBlocksPerMultiprocessor(&per_cu, (const void*)mk_fwd, NT, LDS_BYTES);
        (void)hipGetLastError();
        if (per_cu < 1) per_cu = 1;
        grid = cus * 1;
        if (grid < 8) grid = 256;
    }
    if (grid < 0) return;
    Params p{};
    for (int i = 0; i < 28; ++i) p.in[i] = (const float*)d_in[i];
    p.out = (float*)d_out; p.ws = (unsigned char*)d_ws;
    if (hipMemsetAsync(d_ws, 0, 16384, stream) != hipSuccess) fprintf(stderr, "memset failed\n");
#if MK_COOP
    p.ph_lo = 0; p.ph_hi = N_PHASES;
    void* args[] = {&p};
    hipError_t e = hipLaunchCooperativeKernel((const void*)mk_fwd, dim3(grid), dim3(NT), args, LDS_BYTES, stream);
    if (e != hipSuccess) fprintf(stderr, "cooperative launch failed: %s (grid %d)\n", hipGetErrorString(e), grid);
#else
    for (int k = 0; k < N_PHASES; ++k) { p.ph_lo = k; p.ph_hi = k + 1; hipLaunchKernelGGL(mk_fwd, dim3(grid), dim3(NT), LDS_BYTES, stream, p); }
#endif
}
```

```cpp
#include <hip/hip_runtime.h>
#include <hip/hip_cooperative_groups.h>
#include <cstdio>
#include <cstdint>
namespace cg = cooperative_groups;
#define MK_COOP 1
namespace pg8 {
#define PG8_LAS __attribute__((address_space(3)))
typedef unsigned short bf16_t;
typedef short bf16x8 __attribute__((ext_vector_type(8)));
typedef float f32x4 __attribute__((ext_vector_type(4)));
typedef unsigned u32x4 __attribute__((ext_vector_type(4)));
constexpr int BM = 256, BK = 64, HALF = 128, HTB = HALF * BK * 2  , STAGE_BYTES = 8 * HTB, NXCD = 8, WGM = 8;

__host__ __device__ __forceinline__ int lds_byte(int r, int c) { const int st = (r >> 4) * 2 + (c >> 5), rr = r & 15, cc = c & 31, ob = rr * 64 + cc * 2; return st * 1024 + (ob ^ (((ob >> 9) & 1) << 5)); }
__host__ __device__ __forceinline__ void stage_rc(int b, int& R, int& C) { const int st = b / 1024, sb = b % 1024, swz = sb ^ (((sb >> 9) & 1) << 5); R = (st >> 1) * 16 + swz / 64; C = (st & 1) * 32 + (swz % 64) / 2; }
__host__ __device__ __forceinline__ int perm32(int rho) { const int n = rho >> 4, i = rho & 15; return 8 * (i >> 2) + 4 * n + (i & 3); }

struct Unit { int pm, pn; };
struct Gemm { const bf16_t* A; const bf16_t* Bt; int M, N, K; };

struct StaticOrder {
    int nM, nN, nwg, G, c;
    __host__ __device__ void init(int M, int N, int G_, int c_) { nM = M / BM; nN = N / BM; nwg = nM * nN; G = G_; c = c_; }
    __host__ __device__ bool next(int i, Unit& u) const {
        const long L = (long)i * G + c; if (L >= nwg) return false;
        int wgid = (int)L; { const int q = nwg / NXCD, r = nwg % NXCD, xcd = wgid % NXCD, off = wgid / NXCD; wgid = (xcd < r ? xcd * (q + 1) : r * (q + 1) + (xcd - r) * q) + off; }
        const int nig = WGM * nN, gid = wgid / nig, fm = gid * WGM, gsz = (nM - fm) < WGM ? (nM - fm) : WGM;
        u.pm = fm + ((wgid % nig) % gsz); u.pn = (wgid % nig) / gsz; return true;
    }
    __device__ __forceinline__ void a_ready(const Unit&) const {}
    __device__ __forceinline__ void done(const Unit&) const {}
};

__device__ __forceinline__ unsigned cvt_pk_bf16(float lo, float hi) { typedef float f2_ __attribute__((ext_vector_type(2))); typedef __bf16 b2_ __attribute__((ext_vector_type(2))); const f2_ v = {lo, hi}; return __builtin_bit_cast(unsigned, __builtin_convertvector(v, b2_)); }
typedef float f32x2 __attribute__((ext_vector_type(2)));
__device__ __forceinline__ float sigm(float x) { return __builtin_amdgcn_rcpf(1.f + __builtin_amdgcn_exp2f(x * -1.4426950408889634f)); }
__device__ __forceinline__ float gelu_tanh(float x) { const float u = 1.5957691216f * (x + 0.044715f * x * x * x); return x - x * __builtin_amdgcn_rcpf(__builtin_amdgcn_exp2f(u * 1.4426950408889634f) + 1.f); }
template <int MODE> struct EpiP {
    static constexpr bool PERM = true, AFTER_DRAIN = false;
    bf16_t* O; int ldc; const float* bias; const bf16_t* G; int ldg; float* SMo;
    __device__ __forceinline__ void operator()(const f32x4 (&acc)[2][2][4][2], const Unit& u, int wr, int wc, int fr, int fq) const {
        const int row0 = u.pm * BM + wr * 64 + fr;
        if constexpr (MODE == 0) {
            const int col = u.pn * 128 + wc * 32 + 8 * fq;
#pragma unroll
            for (int ai = 0; ai < 2; ++ai)
#pragma unroll
                for (int m = 0; m < 4; ++m) {
                    const int row = row0 + ai * HALF + m * 16; float o[8];
#pragma unroll
                    for (int n = 0; n < 2; ++n)
#pragma unroll
                        for (int i = 0; i < 4; ++i) { const float g = acc[ai][0][m][n][i], uu = acc[ai][1][m][n][i]; o[4 * n + i] = g * sigm(g) * uu; }
                    u32x4 w; w.x = cvt_pk_bf16(o[0], o[1]); w.y = cvt_pk_bf16(o[2], o[3]); w.z = cvt_pk_bf16(o[4], o[5]); w.w = cvt_pk_bf16(o[6], o[7]);
                    *(u32x4*)(O + (size_t)row * ldc + col) = w;
                }
        } else if constexpr (MODE == 4 || MODE == 5) {
#pragma unroll
            for (int ai = 0; ai < 2; ++ai) { u32x4 gw[4][2], ow[4][2];
#pragma unroll
                for (int m = 0; m < 4; ++m)
#pragma unroll
                    for (int bj = 0; bj < 2; ++bj) { const int row = row0 + ai * HALF + m * 16, col = u.pn * BM + bj * HALF + wc * 32 + 8 * fq;
                        gw[m][bj] = *(const u32x4*)(G + (size_t)row * ldg + (MODE == 5 ? 2048 : 0) + col); if constexpr (MODE == 5) ow[m][bj] = *(const u32x4*)(O + (size_t)row * ldc + col); }
#pragma unroll
                for (int m = 0; m < 4; ++m)
#pragma unroll
                    for (int bj = 0; bj < 2; ++bj) { const int row = row0 + ai * HALF + m * 16, col = u.pn * BM + bj * HALF + wc * 32 + 8 * fq; const u32x4 g_ = gw[m][bj];
                        f32x4 v0 = acc[ai][bj][m][0] * (f32x4){__uint_as_float(g_.x << 16), __uint_as_float(g_.x & 0xffff0000u), __uint_as_float(g_.y << 16), __uint_as_float(g_.y & 0xffff0000u)};
                        f32x4 v1 = acc[ai][bj][m][1] * (f32x4){__uint_as_float(g_.z << 16), __uint_as_float(g_.z & 0xffff0000u), __uint_as_float(g_.w << 16), __uint_as_float(g_.w & 0xffff0000u)};
                        if constexpr (MODE == 5) { const u32x4 o_ = ow[m][bj];
                            v0 = v0 + (f32x4){__uint_as_float(o_.x << 16), __uint_as_float(o_.x & 0xffff0000u), __uint_as_float(o_.y << 16), __uint_as_float(o_.y & 0xffff0000u)};
                            v1 = v1 + (f32x4){__uint_as_float(o_.z << 16), __uint_as_float(o_.z & 0xffff0000u), __uint_as_float(o_.w << 16), __uint_as_float(o_.w & 0xffff0000u)}; }
                        u32x4 w; w.x = cvt_pk_bf16(v0[0], v0[1]); w.y = cvt_pk_bf16(v0[2], v0[3]); w.z = cvt_pk_bf16(v1[0], v1[1]); w.w = cvt_pk_bf16(v1[2], v1[3]);
                        *(u32x4*)(O + (size_t)row * ldc + col) = w; } }
        } else {
#pragma unroll
            for (int bj = 0; bj < 2; ++bj) {
                const int col = u.pn * BM + bj * HALF + wc * 32 + 8 * fq;
                f32x4 b0 = (f32x4){0.f, 0.f, 0.f, 0.f}, b1 = b0;
                if constexpr (MODE == 1 || MODE == 2) { b0 = *(const f32x4*)(bias + col); b1 = *(const f32x4*)(bias + col + 4); }
#pragma unroll
                for (int ai = 0; ai < 2; ++ai)
#pragma unroll
                    for (int m = 0; m < 4; ++m) {
                        const int row = row0 + ai * HALF + m * 16;
                        f32x4 v0 = acc[ai][bj][m][0] + b0, v1 = acc[ai][bj][m][1] + b1;
                        if constexpr (MODE == 1) {
                            if (SMo != nullptr && u.pn == 26 && bj == 0 && wc < 2) { float* sp = SMo + (size_t)row * 64 + wc * 32 + 8 * fq; *(f32x4*)sp = v0; *(f32x4*)(sp + 4) = v1; }
                        }
                        if constexpr (MODE == 2) {
#pragma unroll
                            for (int i = 0; i < 4; ++i) { v0[i] = sigm(v0[i]); v1[i] = sigm(v1[i]); }
                        }
                        if constexpr (MODE == 3) {
#pragma unroll
                            for (int i = 0; i < 4; ++i) { v0[i] = gelu_tanh(v0[i]); v1[i] = gelu_tanh(v1[i]); }
                        }
                        if constexpr (MODE == 4 || MODE == 5) {
                            const u32x4 gw = *(const u32x4*)(G + (size_t)row * ldg + (MODE == 5 ? 2048 : 0) + col);
                            const float g0 = __uint_as_float(gw.x << 16), g1 = __uint_as_float(gw.x & 0xffff0000u), g2 = __uint_as_float(gw.y << 16), g3 = __uint_as_float(gw.y & 0xffff0000u);
                            const float g4 = __uint_as_float(gw.z << 16), g5 = __uint_as_float(gw.z & 0xffff0000u), g6 = __uint_as_float(gw.w << 16), g7 = __uint_as_float(gw.w & 0xffff0000u);
                            v0 = v0 * (f32x4){g0, g1, g2, g3}; v1 = v1 * (f32x4){g4, g5, g6, g7};
                            if constexpr (MODE == 5) {
                                const u32x4 ow = *(const u32x4*)(O + (size_t)row * ldc + col);
                                v0 = v0 + (f32x4){__uint_as_float(ow.x << 16), __uint_as_float(ow.x & 0xffff0000u), __uint_as_float(ow.y << 16), __uint_as_float(ow.y & 0xffff0000u)};
                                v1 = v1 + (f32x4){__uint_as_float(ow.z << 16), __uint_as_float(ow.z & 0xffff0000u), __uint_as_float(ow.w << 16), __uint_as_float(ow.w & 0xffff0000u)};
                            }
                        }
                        u32x4 w; w.x = cvt_pk_bf16(v0[0], v0[1]); w.y = cvt_pk_bf16(v0[2], v0[3]); w.z = cvt_pk_bf16(v1[0], v1[1]); w.w = cvt_pk_bf16(v1[2], v1[3]);
                        *(u32x4*)(O + (size_t)row * ldc + col) = w;
                    }
            }
        }
    }
};
struct EpiResid {
    static constexpr bool PERM = false, AFTER_DRAIN = false;
    const float* res; float* out; int ldc; float scale;
    __device__ __forceinline__ void operator()(const f32x4 (&acc)[2][2][4][2], const Unit& u, int wr, int wc, int fr, int fq) const {
        const int row0 = u.pm * BM + wr * 64 + fr, col0 = u.pn * BM + wc * 32 + 4 * fq;
#pragma unroll
        for (int ai = 0; ai < 2; ++ai) { f32x4 r[4][2][2];
#pragma unroll
            for (int m = 0; m < 4; ++m) { const size_t off = (size_t)(row0 + ai * HALF + m * 16) * ldc + col0;
#pragma unroll
                for (int bj = 0; bj < 2; ++bj)
#pragma unroll
                    for (int n = 0; n < 2; ++n) r[m][bj][n] = *(const f32x4*)(res + off + bj * HALF + n * 16); }
#pragma unroll
            for (int m = 0; m < 4; ++m) { const size_t off = (size_t)(row0 + ai * HALF + m * 16) * ldc + col0;
#pragma unroll
                for (int bj = 0; bj < 2; ++bj)
#pragma unroll
                    for (int n = 0; n < 2; ++n) *(f32x4*)(out + off + bj * HALF + n * 16) = r[m][bj][n] + acc[ai][bj][m][n] * scale; } }
    }
};
template <class Epi, class Sched, bool ALIGN_EPI = false, bool SP2 = false>
__device__ __forceinline__ void gemm_phase(PG8_LAS unsigned char* lds, const Gemm g, const Sched& S, const Epi& E) {
    int tid_o = threadIdx.x; asm volatile("" : "+v"(tid_o));
    const int tid = tid_o, wid = __builtin_amdgcn_readfirstlane(tid >> 6), lane = tid & 63, wr = wid >> 2, wc = wid & 3, fr = lane & 15, fq = lane >> 4;
    const int K = g.K, nt = K / BK;
    unsigned voffA[2], voffB[2];
#pragma unroll
    for (int i = 0; i < 2; ++i) { int R, C; stage_rc(tid * 16 + i * 8192, R, C); const int Rb = Epi::PERM ? ((R & ~31) + perm32(R & 31)) : R;
        voffA[i] = (unsigned)(R * K + C) * 2u; voffB[i] = (unsigned)(Rb * K + C) * 2u; }
    const size_t kstep = (size_t)(BK * 2);
    const size_t hstep = (size_t)HALF * K * 2;
    const size_t tstep = 2 * hstep;
    const unsigned ldsw = (unsigned)wid * 1024u;
    const int aoff = lds_byte(wr * 64 + fr, fq * 8), boff = lds_byte(wc * 32 + fr, fq * 8);
#define PG8_SA(b, h) (((b) * 2 + (h)) * HTB)
#define PG8_SB(b, h) ((4 + (b) * 2 + (h)) * HTB)
#define PG8_STAGE(bufoff, gbase, voff) do { _Pragma("unroll") for (int _i = 0; _i < 2; ++_i) \
        __builtin_amdgcn_global_load_lds((const unsigned*)((const char*)(gbase) + (voff)[_i]), (PG8_LAS unsigned*)(lds + (bufoff) + ldsw + _i * 8192), 16, 0, 0); } while (0)
#define PG8_LDA(dst, b, h) do { _Pragma("unroll") for (int m = 0; m < 4; ++m) _Pragma("unroll") for (int k = 0; k < 2; ++k) dst[m][k] = *(const PG8_LAS bf16x8*)(lds + PG8_SA(b, h) + aoff + m * 2048 + k * 1024); } while (0)
#define PG8_LDB(dst, b, h) do { _Pragma("unroll") for (int n = 0; n < 2; ++n) _Pragma("unroll") for (int k = 0; k < 2; ++k) dst[n][k] = *(const PG8_LAS bf16x8*)(lds + PG8_SB(b, h) + boff + n * 2048 + k * 1024); } while (0)
#define PG8_MMA(ai, bj, At, Bt) do { __builtin_amdgcn_s_setprio(1); _Pragma("unroll") for (int m = 0; m < 4; ++m) _Pragma("unroll") for (int n = 0; n < 2; ++n) _Pragma("unroll") for (int k = 0; k < 2; ++k) \
        acc[ai][bj][m][n] = __builtin_amdgcn_mfma_f32_16x16x32_bf16(Bt[n][k], At[m][k], acc[ai][bj][m][n], 0, 0, 0); __builtin_amdgcn_s_setprio(0); } while (0)
#define PG8_WAIT_V(n) asm volatile("s_waitcnt vmcnt(" #n ")" ::: "memory")
#define PG8_WAIT_L(n) asm volatile("s_waitcnt lgkmcnt(" #n ")" ::: "memory")
#define PG8_BAR __builtin_amdgcn_s_barrier()
#define PG8_SCHED __builtin_amdgcn_sched_barrier(0)
    Unit cur, nxt; int ui = 0;
    if (!S.next(0, cur)) return;
    f32x4 acc[2][2][4][2];
#pragma unroll
    for (int a = 0; a < 2; ++a)
#pragma unroll
        for (int b = 0; b < 2; ++b)
#pragma unroll
            for (int m = 0; m < 4; ++m)
#pragma unroll
                for (int n = 0; n < 2; ++n) acc[a][b][m][n] = (f32x4){0.f, 0.f, 0.f, 0.f};
    bf16x8 At[4][2], B0[2][2], B1[2][2];
    const char* cA = (const char*)g.A + (size_t)cur.pm * tstep; const char* cB = (const char*)g.Bt + (size_t)cur.pn * tstep;
    S.a_ready(cur);
    if constexpr (SP2) {
        PG8_STAGE(PG8_SB(0, 0), cB, voffB); PG8_STAGE(PG8_SB(0, 1), cB + hstep, voffB); PG8_STAGE(PG8_SA(0, 0), cA, voffA); PG8_STAGE(PG8_SA(0, 1), cA + hstep, voffA);
        if (wr == 1) PG8_BAR;
        PG8_WAIT_V(2); PG8_BAR;
        PG8_STAGE(PG8_SB(1, 0), cB + kstep, voffB); PG8_STAGE(PG8_SA(1, 0), cA + kstep, voffA); PG8_STAGE(PG8_SB(1, 1), cB + hstep + kstep, voffB);
        PG8_WAIT_V(6); PG8_BAR;
    } else {
        PG8_STAGE(PG8_SB(0, 0), cB, voffB); PG8_STAGE(PG8_SA(0, 0), cA, voffA); PG8_STAGE(PG8_SB(0, 1), cB + hstep, voffB); PG8_STAGE(PG8_SA(0, 1), cA + hstep, voffA);
        if (wr == 1) PG8_BAR;
        PG8_WAIT_V(4); PG8_BAR;
        PG8_STAGE(PG8_SB(1, 0), cB + kstep, voffB); PG8_STAGE(PG8_SA(1, 0), cA + kstep, voffA); PG8_STAGE(PG8_SB(1, 1), cB + hstep + kstep, voffB);
        PG8_WAIT_V(6); PG8_BAR;
    }
    for (;;) {
        const bool has_next = S.next(ui + 1, nxt);
        const char* nA = has_next ? (const char*)g.A + (size_t)nxt.pm * tstep : cA; const char* nB = has_next ? (const char*)g.Bt + (size_t)nxt.pn * tstep : cB;
        for (int t = 0; t < nt; t += 2) {
            const bool last = (t == nt - 2);
            const char* a1 = cA + (size_t)(t + 1) * kstep;
            const char* a2 = last ? nA : cA + (size_t)(t + 2) * kstep; const char* b2 = last ? nB : cB + (size_t)(t + 2) * kstep;
            const char* a3 = a2 + kstep; const char* b3 = b2 + kstep;
            if (last && has_next) S.a_ready(nxt);
            if constexpr (SP2) {
            PG8_LDB(B0, 0, 0); PG8_LDB(B1, 0, 1); PG8_SCHED; PG8_LDA(At, 0, 0); PG8_STAGE(PG8_SA(1, 1), a1 + hstep, voffA);
            PG8_WAIT_V(8); PG8_WAIT_L(0); PG8_BAR; PG8_MMA(0, 0, At, B0); PG8_MMA(0, 1, At, B1); PG8_BAR; PG8_SCHED;
            PG8_LDA(At, 0, 1); PG8_STAGE(PG8_SB(0, 0), b2, voffB); PG8_STAGE(PG8_SB(0, 1), b2 + hstep, voffB); PG8_STAGE(PG8_SA(0, 0), a2, voffA);
            PG8_WAIT_V(8); PG8_WAIT_L(0); PG8_BAR; PG8_MMA(1, 0, At, B0); PG8_MMA(1, 1, At, B1); PG8_BAR; PG8_SCHED;
            PG8_LDB(B0, 1, 0); PG8_LDB(B1, 1, 1); PG8_SCHED; PG8_LDA(At, 1, 0); PG8_STAGE(PG8_SA(0, 1), a2 + hstep, voffA);
            PG8_WAIT_V(8); PG8_WAIT_L(0); PG8_BAR; PG8_MMA(0, 0, At, B0); PG8_MMA(0, 1, At, B1); PG8_BAR; PG8_SCHED;
            PG8_LDA(At, 1, 1); PG8_STAGE(PG8_SB(1, 0), b3, voffB); PG8_STAGE(PG8_SB(1, 1), b3 + hstep, voffB); PG8_STAGE(PG8_SA(1, 0), a3, voffA);
            PG8_WAIT_V(8); PG8_WAIT_L(0); PG8_BAR; PG8_MMA(1, 0, At, B0); PG8_MMA(1, 1, At, B1); PG8_BAR; PG8_SCHED;
            } else {
            PG8_LDB(B0, 0, 0); PG8_SCHED; PG8_LDA(At, 0, 0); PG8_STAGE(PG8_SA(1, 1), a1 + hstep, voffA);
            PG8_WAIT_L(8); PG8_BAR; PG8_WAIT_L(0); PG8_MMA(0, 0, At, B0); PG8_BAR; PG8_SCHED;
            PG8_LDB(B1, 0, 1); PG8_STAGE(PG8_SB(0, 0), b2, voffB);
            PG8_BAR; PG8_WAIT_L(0); PG8_MMA(0, 1, At, B1); PG8_BAR;
            PG8_LDA(At, 0, 1); PG8_STAGE(PG8_SA(0, 0), a2, voffA);
            PG8_BAR; PG8_WAIT_L(0); PG8_MMA(1, 0, At, B0); PG8_BAR; PG8_SCHED;
            PG8_STAGE(PG8_SB(0, 1), b2 + hstep, voffB);
            PG8_WAIT_V(6); PG8_BAR; PG8_MMA(1, 1, At, B1); PG8_BAR;
            PG8_LDB(B0, 1, 0); PG8_SCHED; PG8_LDA(At, 1, 0); PG8_STAGE(PG8_SA(0, 1), a2 + hstep, voffA);
            PG8_WAIT_L(8); PG8_BAR; PG8_WAIT_L(0); PG8_MMA(0, 0, At, B0); PG8_BAR; PG8_SCHED;
            PG8_LDB(B1, 1, 1); PG8_STAGE(PG8_SB(1, 0), b3, voffB);
            PG8_BAR; PG8_WAIT_L(0); PG8_MMA(0, 1, At, B1); PG8_BAR;
            PG8_LDA(At, 1, 1); PG8_STAGE(PG8_SA(1, 0), a3, voffA);
            PG8_BAR; PG8_WAIT_L(0); PG8_MMA(1, 0, At, B0); PG8_BAR; PG8_SCHED;
            PG8_STAGE(PG8_SB(1, 1), b3 + hstep, voffB);
            PG8_WAIT_V(6); PG8_BAR; PG8_MMA(1, 1, At, B1); PG8_BAR;
            }
        }
        if constexpr (ALIGN_EPI) { if (wr == 0) PG8_BAR; }
        if constexpr (!Epi::AFTER_DRAIN) { E(acc, cur, wr, wc, fr, fq); S.done(cur); }
        if (!has_next) break;
#pragma unroll
        for (int a = 0; a < 2; ++a)
#pragma unroll
            for (int b = 0; b < 2; ++b)
#pragma unroll
                for (int m = 0; m < 4; ++m)
#pragma unroll
                    for (int n = 0; n < 2; ++n) acc[a][b][m][n] = (f32x4){0.f, 0.f, 0.f, 0.f};
        cur = nxt; cA = nA; cB = nB; ++ui;
        if constexpr (ALIGN_EPI) { if (wr == 1) PG8_BAR; }
    }
    PG8_WAIT_V(0);
    if constexpr (!ALIGN_EPI) { if (wr == 0) PG8_BAR; }
    PG8_BAR;
    if constexpr (Epi::AFTER_DRAIN) { E.fused(acc, cur, wr, wc, fr, fq, lds, wid, lane); S.done(cur); }
#undef PG8_SA
#undef PG8_SB
#undef PG8_STAGE
#undef PG8_LDA
#undef PG8_LDB
#undef PG8_MMA
#undef PG8_WAIT_V
#undef PG8_WAIT_L
#undef PG8_BAR
#undef PG8_SCHED
}
}
#define LAS __attribute__((address_space(3)))
typedef unsigned short bf16;
typedef unsigned v4u __attribute__((ext_vector_type(4)));
typedef unsigned v2u __attribute__((ext_vector_type(2)));
typedef float f32x4 __attribute__((ext_vector_type(4)));
typedef float f32x2 __attribute__((ext_vector_type(2)));
#define WSYNC() asm volatile("s_waitcnt lgkmcnt(0)" ::: "memory")

constexpr int NT = 512, NWV = 8;
constexpr int TOK = 16384, SEQ = 4096, DM = 2048, FF = 5632, NA = 6912, NB = 4096, INW = 10808;
constexpr int PA_Q = 0, PA_KV = 1024, PA_MQ = 2560, PA_MK = 3584, PA_MV = 4608, PA_MO = 5632, PA_SM = 6656;
constexpr float EPS = 1e-6f;
constexpr size_t MiB = 1u << 20;
constexpr size_t O_BIASA = 64 * 1024, O_BIASB = 128 * 1024, O_GG = 192 * 1024, O_GMX = 200 * 1024, O_DENI = 256 * 1024;
constexpr size_t O_WGU = 1 * MiB, O_WD = 45 * MiB, O_WINA = 67 * MiB, O_WINB = 94 * MiB, O_WBN = 110 * MiB, O_WBM = 114 * MiB, O_WOUT = 118 * MiB, O_WC1K = 126 * MiB, O_WC1V = 127 * MiB;
constexpr size_t O_MQK = 1 * MiB, O_HM = 1 * MiB;
constexpr size_t O_KTU = 472 * MiB;
constexpr size_t O_VTS = 67 * MiB, O_VTW = 75 * MiB, O_KCB = 83 * MiB, O_VCT = 83 * MiB + 512 * 1024;
constexpr size_t O_XN = 128 * MiB, O_PA = 192 * MiB, O_H = 192 * MiB, O_MG = 192 * MiB;
constexpr size_t O_ONSA = 408 * MiB, O_WT = 84 * MiB, O_HC = 440 * MiB, O_CBK = 408 * MiB, O_CBV = 424 * MiB, O_CHK = 65 * MiB, O_CHV = 92 * MiB;
constexpr size_t O_SM = 504 * MiB, O_KC = 508 * MiB, O_VC = 509 * MiB, O_SEL = 510 * MiB, O_GA = 510 * MiB + 512 * 1024, O_GLA = 510 * MiB + 768 * 1024, O_GPM = 511 * MiB;
constexpr size_t WS_NEED = 512 * MiB;
constexpr int LDS_BYTES = 147456;

struct Params { const float* in[28]; float* out; unsigned char* ws; int ph_lo, ph_hi; };

__device__ __forceinline__ float bf2f(unsigned short b) { return __uint_as_float(((unsigned)b) << 16); }
__device__ __forceinline__ unsigned pk2(float lo, float hi) { typedef float f2_ __attribute__((ext_vector_type(2))); typedef __bf16 b2_ __attribute__((ext_vector_type(2))); const f2_ v = {lo, hi}; return __builtin_bit_cast(unsigned, __builtin_convertvector(v, b2_)); }
__device__ __forceinline__ unsigned f2bf(float f) { return pk2(f, 0.f) & 0xffffu; }
__device__ __forceinline__ float lo16(unsigned w) { return __uint_as_float(w << 16); }
__device__ __forceinline__ float hi16(unsigned w) { return __uint_as_float(w & 0xffff0000u); }
__device__ __forceinline__ float wave_sum(float v) {
#pragma unroll
    for (int o = 1; o < 64; o <<= 1) v += __shfl_xor(v, o);
    return v;
}
__device__ __forceinline__ float wave_max(float v) {
#pragma unroll
    for (int o = 1; o < 64; o <<= 1) v = fmaxf(v, __shfl_xor(v, o));
    return v;
}
__device__ __forceinline__ float sigmf(float x) { return __builtin_amdgcn_rcpf(1.f + __builtin_amdgcn_exp2f(x * -1.4426950408889634f)); }

__device__ __forceinline__ void tr_item(const float* W, int ldw, int K, int srccol  , bf16* WT, int outrow0, const float* kscale, float* scr, int k0, int lane) {
#pragma unroll 8
    for (int i = 0; i < 32; ++i) { const int kk = 2 * i + (lane >> 5); float v = 0.f; if (srccol >= 0) v = W[(size_t)(k0 + kk) * ldw + srccol]; if (kscale) v *= kscale[k0 + kk]; scr[kk * 33 + (lane & 31)] = v; }
    WSYNC();
    const int c = lane & 7;
#pragma unroll
    for (int j = 0; j < 4; ++j) { const int n = (lane >> 3) + 8 * j; const float* s = scr + (8 * c) * 33 + n;
        v4u o; o.x = pk2(s[0 * 33], s[1 * 33]); o.y = pk2(s[2 * 33], s[3 * 33]); o.z = pk2(s[4 * 33], s[5 * 33]); o.w = pk2(s[6 * 33], s[7 * 33]);
        *(v4u*)(WT + (size_t)(outrow0 + n) * K + k0 + 8 * c) = o; }
    WSYNC();
}
__device__ __forceinline__ void tr_item64(const float* W, int ldw, int K, int srccol0, bf16* WT, int outrow0, const float* kscale, float* scr, int k0, int lane) {
    const int kr = lane >> 4, c4 = (lane & 15) * 4; f32x4 v[16];
#pragma unroll
    for (int i = 0; i < 16; ++i) v[i] = *(const f32x4*)(W + (size_t)(k0 + 4 * i + kr) * ldw + srccol0 + c4);
#pragma unroll
    for (int i = 0; i < 16; ++i) { const int k = 4 * i + kr; const float sc = kscale ? kscale[k0 + k] : 1.f; float* s = scr + k * 65 + c4; s[0] = v[i].x * sc; s[1] = v[i].y * sc; s[2] = v[i].z * sc; s[3] = v[i].w * sc; }
    WSYNC();
    const int c = lane & 7;
#pragma unroll
    for (int j = 0; j < 8; ++j) { const int n = (lane >> 3) + 8 * j; const float* s = scr + (8 * c) * 65 + n;
        v4u o; o.x = pk2(s[0 * 65], s[1 * 65]); o.y = pk2(s[2 * 65], s[3 * 65]); o.z = pk2(s[4 * 65], s[5 * 65]); o.w = pk2(s[6 * 65], s[7 * 65]);
        *(v4u*)(WT + (size_t)(outrow0 + n) * K + k0 + 8 * c) = o; }
    WSYNC();
}
__device__ __forceinline__ void tr_plain(const float* W, int K, int N, bf16* WT, const float* kscale, float* scr, int item, int lane) {
    const int nblk = N / 64, kb = item / nblk, nb = item % nblk;
    tr_item64(W, N, K, nb * 64, WT, nb * 64, kscale, scr, kb * 64, lane);
}
__device__ __forceinline__ void tr_gu(const float* Wg, const float* Wu, bf16* WT, const float* kscale, float* scr, int item, int lane) {
    const int nblk = (2 * FF) / 64, kb = item / nblk, nb = item % nblk, n0 = nb * 64, pn = n0 >> 8, within = n0 & 255;
    const float* W = (within >= 128) ? Wu : Wg;
    tr_item64(W, FF, DM, pn * 128 + (within & 127), WT, n0, kscale, scr, kb * 64, lane);
}
__device__ __forceinline__ int ina_src(int n) {
    if (n < 2560) return n;
    if (n < 5632) return n + 48;
    if (n < 6656) return 5688 + (n - 5632);
    if (n < 6704) return 2560 + (n - 6656);
    if (n < 6708) return 5680 + (n - 6704);
    if (n < 6712) return 5684 + (n - 6708);
    return -1;
}
__device__ __forceinline__ void norm_row(const float* xrow, bf16* orow, int lane) {
    const f32x4* xr = (const f32x4*)xrow + lane; f32x4 v[8]; float s = 0.f;
#pragma unroll
    for (int j = 0; j < 8; ++j) { v[j] = xr[64 * j]; s += (v[j].x * v[j].x + v[j].y * v[j].y) + (v[j].z * v[j].z + v[j].w * v[j].w); }
    const float rstd = rsqrtf(wave_sum(s) * (1.f / DM) + EPS);
    v2u* o8 = (v2u*)orow + lane;
#pragma unroll
    for (int j = 0; j < 8; ++j) { v2u w; w.x = pk2(v[j].x * rstd, v[j].y * rstd); w.y = pk2(v[j].z * rstd, v[j].w * rstd); o8[64 * j] = w; }
}

__device__ __forceinline__ void phase_prologue(const Params& P, unsigned char* lds, int gw, int ngw, int wave, int lane, int tid) {
    unsigned char* ws = P.ws; float* scr = (float*)(lds + wave * 16640);
    constexpr int I_GU = 32 * 176, I_D = 88 * 32, I_A = 32 * 108, I_B = 32 * 64, I_BN = 16 * 32, I_O = 32 * 32, I_C = 32 * 4;
    constexpr int NITEMS = I_GU + I_D + I_A + I_B + 2 * I_BN + I_O + 2 * I_C;
    for (int it = gw; it < NITEMS; it += ngw) {
        int r = it;
        if (r < I_GU) { tr_gu(P.in[2], P.in[3], (bf16*)(ws + O_WGU), P.in[1], scr, r, lane); continue; } r -= I_GU;
        if (r < I_D) { tr_plain(P.in[4], FF, DM, (bf16*)(ws + O_WD), nullptr, scr, r, lane); continue; } r -= I_D;
        if (r < I_A) { const int nblk = NA / 64, kb = r / nblk, nb = r % nblk;
            if (nb == 104) { tr_item(P.in[6], INW, DM, ina_src(6656 + (lane & 31)), (bf16*)(ws + O_WINA), 6656, P.in[5], scr, kb * 64, lane); tr_item(P.in[6], INW, DM, ina_src(6688 + (lane & 31)), (bf16*)(ws + O_WINA), 6688, P.in[5], scr, kb * 64, lane); }
            else if (nb > 104) { tr_item(P.in[6], INW, DM, -1, (bf16*)(ws + O_WINA), nb * 64, P.in[5], scr, kb * 64, lane); tr_item(P.in[6], INW, DM, -1, (bf16*)(ws + O_WINA), nb * 64 + 32, P.in[5], scr, kb * 64, lane); }
            else tr_item64(P.in[6], INW, DM, ina_src(nb * 64), (bf16*)(ws + O_WINA), nb * 64, P.in[5], scr, kb * 64, lane);
            continue; } r -= I_A;
        if (r < I_B) { const int nblk = NB / 64, kb = r / nblk, nb = r % nblk; tr_item64(P.in[6], INW, DM, 6712 + nb * 64, (bf16*)(ws + O_WINB), nb * 64, P.in[5], scr, kb * 64, lane); continue; } r -= I_B;
        if (r < I_BN) { tr_plain(P.in[21], 1024, DM, (bf16*)(ws + O_WBN), nullptr, scr, r, lane); continue; } r -= I_BN;
        if (r < I_BN) { tr_plain(P.in[22], 1024, DM, (bf16*)(ws + O_WBM), P.in[20], scr, r, lane); continue; } r -= I_BN;
        if (r < I_O) { tr_plain(P.in[23], DM, DM, (bf16*)(ws + O_WOUT), nullptr, scr, r, lane); continue; } r -= I_O;
        if (r < I_C) { tr_plain(P.in[13], 2048, 256, (bf16*)(ws + O_WC1K), nullptr, scr, r, lane); continue; } r -= I_C;
        tr_plain(P.in[16], 2048, 256, (bf16*)(ws + O_WC1V), nullptr, scr, r, lane);
    }
    { const int gt = gw * 64 + lane, ngt = ngw * 64; float* ba = (float*)(ws + O_BIASA); float* bb = (float*)(ws + O_BIASB);
      for (int n = gt; n < NA; n += ngt) { const int s = ina_src(n); ba[n] = s >= 0 ? P.in[7][s] : 0.f; }
      for (int n = gt; n < NB; n += ngt) bb[n] = P.in[7][6712 + n]; }
    for (int m = gw; m < TOK; m += ngw) norm_row(P.in[0] + (size_t)m * DM, (bf16*)(ws + O_XN) + (size_t)m * DM, lane);
}
__device__ __forceinline__ void phase_norm(const float* src, bf16* dst, int gw, int ngw, int lane) {
    for (int m = gw; m < TOK; m += ngw) norm_row(src + (size_t)m * DM, dst + (size_t)m * DM, lane);
}
__device__ __forceinline__ void phase_conv_ffn2(const Params& P, unsigned char* lds, int gw, int ngw, int wave, int lane) {
    float* scr = (float*)(lds + wave * 16640);
    constexpr int I_GU = 32 * 176, I_D = 88 * 32;
    for (int it = gw; it < I_GU + I_D; it += ngw) {
        if (it < I_GU) tr_gu(P.in[25], P.in[26], (bf16*)(P.ws + O_WGU), P.in[24], scr, it, lane);
        else tr_plain(P.in[27], FF, DM, (bf16*)(P.ws + O_WD), nullptr, scr, it - I_GU, lane);
    }
}

__device__ __forceinline__ void phase_prep(const Params& P, int gw, int ngw, int lane) {
    unsigned char* ws = P.ws; bf16* PA = (bf16*)(ws + O_PA);
    { const float qg = P.in[8][lane] * (0.125f * 1.4426950408889634f), ksg = P.in[10][lane], kwg = P.in[11][lane];
      for (int m = gw; m < TOK; m += ngw) { bf16* pr = PA + (size_t)m * NA; float x[24];
#pragma unroll
        for (int v = 0; v < 24; ++v) { const int col = (v < 16) ? (PA_Q + v * 64) : (v < 20 ? (PA_KV + 2 * 256 + (v - 16) * 64) : (PA_KV + 4 * 256 + (v - 20) * 64)); x[v] = bf2f(pr[col + lane]); }
#pragma unroll
        for (int v = 0; v < 24; ++v) { const int col = (v < 16) ? (PA_Q + v * 64) : (v < 20 ? (PA_KV + 2 * 256 + (v - 16) * 64) : (PA_KV + 4 * 256 + (v - 20) * 64));
            const float gn = (v < 16) ? qg : (v < 20 ? ksg : kwg); const float ss = wave_sum(x[v] * x[v]); pr[col + lane] = (bf16)f2bf(x[v] * rsqrtf(ss * (1.f / 64.f) + EPS) * gn); } } }
    { const size_t gt = (size_t)gw * 64 + lane, ngt = (size_t)ngw * 64; bf16* CBK = (bf16*)(ws + O_CBK); bf16* CBV = (bf16*)(ws + O_CBV);
      const int k8 = (int)(gt & 255) * 8, l = k8 >> 6, d = k8 & 63; float pk[8], pv[8];
#pragma unroll
      for (int i = 0; i < 8; ++i) { pk[i] = P.in[12][l * 64 + d + i]; pv[i] = P.in[15][l * 64 + d + i]; }
      for (size_t idx = gt; idx < (size_t)4096 * 256; idx += ngt) { const int r = (int)(idx >> 8);
        v4u ok = (v4u){0u, 0u, 0u, 0u}, ov = ok;
        if (r < 4080) { const int bg = r / 255, c = r % 255, b = bg >> 2, g = bg & 3; const bf16* src = PA + ((size_t)b * SEQ + 16 * c + l) * NA + PA_KV + g * 64 + d;
            const v4u kw = *(const v4u*)src, vw = *(const v4u*)(src + 256);
            ok.x = pk2(lo16(kw.x) + pk[0], hi16(kw.x) + pk[1]); ok.y = pk2(lo16(kw.y) + pk[2], hi16(kw.y) + pk[3]); ok.z = pk2(lo16(kw.z) + pk[4], hi16(kw.z) + pk[5]); ok.w = pk2(lo16(kw.w) + pk[6], hi16(kw.w) + pk[7]);
            ov.x = pk2(lo16(vw.x) + pv[0], hi16(vw.x) + pv[1]); ov.y = pk2(lo16(vw.y) + pv[2], hi16(vw.y) + pv[3]); ov.z = pk2(lo16(vw.z) + pv[4], hi16(vw.z) + pv[5]); ov.w = pk2(lo16(vw.w) + pv[6], hi16(vw.w) + pv[7]); }
        *(v4u*)(CBK + (size_t)r * 2048 + k8) = ok; *(v4u*)(CBV + (size_t)r * 2048 + k8) = ov; } }
    { const size_t gt = (size_t)gw * 64 + lane, ngt = (size_t)ngw * 64; bf16* MQK = (bf16*)(ws + O_MQK); const float* cw = P.in[18]; const float* cb = P.in[19];
      const int c8 = (int)(gt & 255) * 8; float wt[4][8], bs[8];
#pragma unroll
      for (int i = 0; i < 8; ++i) { bs[i] = cb[c8 + i];
#pragma unroll
          for (int j = 0; j < 4; ++j) wt[j][i] = cw[j * 2048 + c8 + i]; }
#pragma unroll 2
      for (size_t idx = gt; idx < (size_t)TOK * 256; idx += ngt) { const int m = (int)(idx >> 8), t = m & (SEQ - 1);
        float a[8]; v4u w[4];
#pragma unroll
        for (int j = 0; j < 4; ++j) { const int mm = (t - 3 + j >= 0) ? (m - 3 + j) : m; w[j] = *(const v4u*)(PA + (size_t)mm * NA + PA_MQ + c8); }
#pragma unroll
        for (int i = 0; i < 8; ++i) a[i] = bs[i];
#pragma unroll
        for (int j = 0; j < 4; ++j) { const float z = (t - 3 + j >= 0) ? 1.f : 0.f;
            a[0] += wt[j][0] * z * lo16(w[j].x); a[1] += wt[j][1] * z * hi16(w[j].x); a[2] += wt[j][2] * z * lo16(w[j].y); a[3] += wt[j][3] * z * hi16(w[j].y);
            a[4] += wt[j][4] * z * lo16(w[j].z); a[5] += wt[j][5] * z * hi16(w[j].z); a[6] += wt[j][6] * z * lo16(w[j].w); a[7] += wt[j][7] * z * hi16(w[j].w); }
#pragma unroll
        for (int i = 0; i < 8; ++i) a[i] = a[i] * sigmf(a[i]);
        v4u o; o.x = pk2(a[0], a[1]); o.y = pk2(a[2], a[3]); o.z = pk2(a[4], a[5]); o.w = pk2(a[6], a[7]);
        *(v4u*)(MQK + (size_t)m * 2048 + c8) = o; } }
    { const bf16* PAc = (const bf16*)(ws + O_PA);
      for (int it = gw; it < 2048; it += ngw) { const int j = it & 1, g = (it >> 1) & 3, tb = (it >> 3) & 63, b = it >> 9; const int bg = b * 4 + g;
        const bf16* src = PAc + ((size_t)b * SEQ + 64 * tb + lane) * NA + PA_KV + (j ? 5 : 3) * 256 + g * 64; bf16* dst = (bf16*)(ws + (j ? O_VTW : O_VTS)) + (size_t)bg * 64 * SEQ + (size_t)tb * 4096 + lane;
#pragma unroll
        for (int d8 = 0; d8 < 8; ++d8) { const v4u w = *(const v4u*)(src + 8 * d8);
            dst[(size_t)(8 * d8 + 0) * 64] = (bf16)(w.x & 0xffffu); dst[(size_t)(8 * d8 + 1) * 64] = (bf16)(w.x >> 16); dst[(size_t)(8 * d8 + 2) * 64] = (bf16)(w.y & 0xffffu); dst[(size_t)(8 * d8 + 3) * 64] = (bf16)(w.y >> 16);
            dst[(size_t)(8 * d8 + 4) * 64] = (bf16)(w.z & 0xffffu); dst[(size_t)(8 * d8 + 5) * 64] = (bf16)(w.z >> 16); dst[(size_t)(8 * d8 + 6) * 64] = (bf16)(w.w & 0xffffu); dst[(size_t)(8 * d8 + 7) * 64] = (bf16)(w.w >> 16); } } }
    { const float* SM = (const float*)(ws + O_SM); float* GA = (float*)(ws + O_GA); float* GLA = (float*)(ws + O_GLA); float* GPM = (float*)(ws + O_GPM); float* GG = (float*)(ws + O_GG); float* GMX = (float*)(ws + O_GMX);
      for (int it = gw; it < 1024; it += ngw) { const int bh = it >> 6, c = it & 63, b = bh >> 2, h = bh & 3; const size_t m = (size_t)b * SEQ + 64 * c + lane;
        const float ip = SM[m * 64 + 48 + h], fp = SM[m * 64 + 52 + h];
        const float lf = fminf(fp, 0.f) - log1pf(__expf(-fabsf(fp)));
        float a = lf;
#pragma unroll
        for (int o = 1; o < 64; o <<= 1) { const float y = __shfl_up(a, o); if (lane >= o) a += y; }
        const float g = __shfl(a, 63); const float la = ip - a; const float mx = wave_max(g + la);
        float pm = la;
#pragma unroll
        for (int o = 1; o < 64; o <<= 1) { const float y = __shfl_up(pm, o); if (lane >= o) pm = fmaxf(pm, y); }
        const size_t o1 = (size_t)bh * SEQ + 64 * c + lane; GA[o1] = a; GLA[o1] = la; GPM[o1] = a + pm;
        if (lane == 0) { GG[it] = g; GMX[it] = mx; } } }
    for (int it = gw; it < 16; it += ngw) { ((bf16*)(ws + O_KCB))[((size_t)it * 256 + 255) * 64 + lane] = 0; ((bf16*)(ws + O_VCT))[((size_t)it * 64 + lane) * 256 + 255] = 0; }
}

typedef short cbf16x8 __attribute__((ext_vector_type(8)));
__device__ __forceinline__ void cmp2_block(const Params& P, unsigned char* lds, int pm, int kv, int tid) {
    unsigned char* ws = P.ws; const int lane = tid & 63, wave = __builtin_amdgcn_readfirstlane(tid >> 6), m16 = lane & 15, quad = lane >> 4;
    bf16* W2T = (bf16*)lds;
    {
        const float* w2 = P.in[kv ? 17 : 14]; const bf16* CH = (const bf16*)(ws + (kv ? O_CHV : O_CHK));
        __syncthreads();
#pragma unroll 8
        for (int i = 0; i < 32; ++i) { const int idx = i * NT + tid, hh = idx >> 6, j = idx & 63; W2T[j * 264 + hh] = (bf16)f2bf(w2[idx]); }
        __syncthreads();
#pragma unroll 1
        for (int mi = 0; mi < 2; ++mi) { const int mt = 2 * wave + mi; const int rbase = 256 * pm + 16 * mt;
            cbf16x8 af[8];
#pragma unroll
            for (int kk = 0; kk < 8; ++kk) af[kk] = *(const cbf16x8*)(CH + (size_t)(rbase + m16) * 256 + 32 * kk + 8 * quad);
            f32x4 acc[4];
#pragma unroll
            for (int nt = 0; nt < 4; ++nt) acc[nt] = (f32x4){0.f, 0.f, 0.f, 0.f};
#pragma unroll
            for (int kk = 0; kk < 8; ++kk)
#pragma unroll
                for (int nt = 0; nt < 4; ++nt) { const cbf16x8 bfr = *(const cbf16x8*)(W2T + (16 * nt + m16) * 264 + 32 * kk + 8 * quad); acc[nt] = __builtin_amdgcn_mfma_f32_16x16x32_bf16(af[kk], bfr, acc[nt], 0, 0, 0); }
#pragma unroll
            for (int i = 0; i < 4; ++i) { const int r = rbase + 4 * quad + i; float ss = acc[0][i] * acc[0][i] + acc[1][i] * acc[1][i] + acc[2][i] * acc[2][i] + acc[3][i] * acc[3][i];
                ss += __shfl_xor(ss, 1); ss += __shfl_xor(ss, 2); ss += __shfl_xor(ss, 4); ss += __shfl_xor(ss, 8);
                if (r < 4080) { const int bg = r / 255, c = r % 255;
                    if (kv == 0) { const float rstd = rsqrtf(ss * (1.f / 64.f) + EPS);
#pragma unroll
                        for (int nt = 0; nt < 4; ++nt) { const int j = 16 * nt + m16; ((bf16*)(ws + O_KCB))[((size_t)bg * 256 + c) * 64 + j] = (bf16)f2bf(acc[nt][i] * rstd * P.in[9][j]); } }
                    else {
#pragma unroll
                        for (int nt = 0; nt < 4; ++nt) { const int j = 16 * nt + m16; ((bf16*)(ws + O_VCT))[((size_t)bg * 64 + j) * 256 + c] = (bf16)f2bf(acc[nt][i]); } } } }
        }
    }
    __syncthreads();
}

constexpr int SCAN_N1 = 9, SCAN_NFLAG = SCAN_N1 + 1;
__device__ __forceinline__ void mlstm_intra_item(const Params& P, unsigned char* lds, int it, int tid) {
    unsigned char* ws = P.ws; const int bh = it >> 6, c = it & 63, b = bh >> 2, h = bh & 3;
    const int lane = tid & 63, wave = __builtin_amdgcn_readfirstlane(tid >> 6), m16 = lane & 15, quad = lane >> 4, jt = wave >> 1, sh = wave & 1;
    float* PART = (float*)lds;
    const bf16* MQK = (const bf16*)(ws + O_MQK); const size_t row0 = (size_t)b * SEQ + 64 * c;
    cbf16x8 qf[8], kf[2][8];
    { const bf16* qp = MQK + (row0 + 16 * jt + m16) * 2048 + h * 256 + 8 * quad;
#pragma unroll
      for (int kk = 0; kk < 8; ++kk) qf[kk] = *(const cbf16x8*)(qp + 32 * kk);
#pragma unroll
      for (int t2 = 0; t2 < 2; ++t2) { const bf16* kp = MQK + (row0 + 16 * (2 * sh + t2) + m16) * 2048 + 1024 + h * 256 + 8 * quad;
#pragma unroll
          for (int kk = 0; kk < 8; ++kk) kf[t2][kk] = *(const cbf16x8*)(kp + 32 * kk); } }
    const size_t o1 = (size_t)bh * SEQ + 64 * c;
    const float* GA = (const float*)(ws + O_GA) + o1; const float* GLA = (const float*)(ws + O_GLA) + o1; const float* GPM = (const float*)(ws + O_GPM) + o1;
    float aj[4], mij[4], las[2];
#pragma unroll
    for (int i = 0; i < 4; ++i) { aj[i] = GA[16 * jt + 4 * quad + i]; mij[i] = GPM[16 * jt + 4 * quad + i]; }
#pragma unroll
    for (int t2 = 0; t2 < 2; ++t2) las[t2] = GLA[16 * (2 * sh + t2) + m16];
    float mprev = 0.f; { const float* GG = (const float*)(ws + O_GG) + bh * 64; const float* GMX = (const float*)(ws + O_GMX) + bh * 64; for (int cc = 0; cc < c; ++cc) mprev = fmaxf(GG[cc] + mprev, GMX[cc]); }
    f32x4 acc[2];
#pragma unroll
    for (int t2 = 0; t2 < 2; ++t2) { acc[t2] = (f32x4){0.f, 0.f, 0.f, 0.f};
#pragma unroll
        for (int kk = 0; kk < 8; ++kk) acc[t2] = __builtin_amdgcn_mfma_f32_16x16x32_bf16(qf[kk], kf[t2][kk], acc[t2], 0, 0, 0); }
    if (jt == 0) {
        const float g = ((const float*)(ws + O_GG))[bh * 64 + c], mnew = fmaxf(g + mprev, ((const float*)(ws + O_GMX))[bh * 64 + c]);
        bf16* KU = (bf16*)(ws + O_KTU) + (size_t)it * 16384;
#pragma unroll
        for (int t2 = 0; t2 < 2; ++t2) { const int s = 16 * (2 * sh + t2) + m16; const float us = __expf(g + las[t2] - mnew) * 0.0625f;
#pragma unroll
            for (int kk = 0; kk < 8; ++kk) { const cbf16x8 kv = kf[t2][kk];
#pragma unroll
                for (int i = 0; i < 8; ++i) KU[(size_t)(32 * kk + 8 * quad + i) * 64 + s] = (bf16)f2bf(bf2f((unsigned short)kv[i]) * us); } } }
    bf16* WT = (bf16*)(ws + O_WT) + (size_t)it * 4096;
    __syncthreads();
#pragma unroll
    for (int i = 0; i < 4; ++i) { const int j = 16 * jt + 4 * quad + i; const float mc = fmaxf(aj[i] + mprev, mij[i]); float rs = 0.f;
#pragma unroll
        for (int t2 = 0; t2 < 2; ++t2) { const int s = 16 * (2 * sh + t2) + m16; const float w = (s <= j) ? __expf(aj[i] + las[t2] - mc) * acc[t2][i] * 0.0625f : 0.f; WT[j * 64 + s] = (bf16)f2bf(w); rs += w; }
        rs += __shfl_xor(rs, 1); rs += __shfl_xor(rs, 2); rs += __shfl_xor(rs, 4); rs += __shfl_xor(rs, 8);
        if (m16 == 0) PART[sh * 64 + j] = rs; }
    __syncthreads();
    if (tid < 64) ((float*)(ws + O_DENI))[o1 + tid] = PART[tid] + PART[64 + tid];
    if (c < SCAN_NFLAG) {
        asm volatile("s_waitcnt vmcnt(0)" ::: "memory"); __syncthreads();
        if (tid == 0) { __builtin_amdgcn_fence(__ATOMIC_RELEASE, "agent"); asm volatile("s_waitcnt vmcnt(0)" ::: "memory");
            __hip_atomic_store((unsigned*)ws + 3700 + bh * 16 + c, 1u, __ATOMIC_RELAXED, __HIP_MEMORY_SCOPE_AGENT); } }
}

typedef short sbf16x8 __attribute__((ext_vector_type(8)));
#define LBAR() asm volatile("s_waitcnt lgkmcnt(0)\n\ts_barrier" ::: "memory")
__device__ __forceinline__ unsigned cvtpk2(float lo, float hi) { typedef float f2_ __attribute__((ext_vector_type(2))); typedef __bf16 b2_ __attribute__((ext_vector_type(2))); const f2_ v = {lo, hi}; return __builtin_bit_cast(unsigned, __builtin_convertvector(v, b2_)); }
constexpr int SC_QL = 0, SC_KT = 33792, SC_VT = 70656, SC_WB = 89088, SC_NL = 98304, SC_RS = 100352, SC_OUT = 101376;
struct ScanState { f32x4 acc[16]; float mst, gnx, mxnx, pla, pa, pmi, pdn; v4u pq[4], pk[4], pv[2], pw; };
__device__ __forceinline__ void scan_wait_flag(const Params& P, int bh, int c, int tid) {
    if (tid == 0) { unsigned* f = (unsigned*)P.ws + 3700 + bh * 16 + c; unsigned sp = 0;
        while (__hip_atomic_load(f, __ATOMIC_RELAXED, __HIP_MEMORY_SCOPE_AGENT) == 0u && ++sp < (1u << 22)) __builtin_amdgcn_s_sleep(2);
        __builtin_amdgcn_fence(__ATOMIC_ACQUIRE, "agent"); asm volatile("s_waitcnt vmcnt(0)" ::: "memory"); }
    __syncthreads();
}
__device__ __forceinline__ void mlstm_scan_item(const Params& P, unsigned char* lds, int it, int tid, ScanState& S, int c0, int c1) {
    unsigned char* ws = P.ws; const int bh = it >> 1, eh = it & 1, b = bh >> 2, h = bh & 3;
    const int lane = tid & 63, wave = __builtin_amdgcn_readfirstlane(tid >> 6);
    bf16* QL = (bf16*)(lds + SC_QL); bf16* KT = (bf16*)(lds + SC_KT); bf16* VT = (bf16*)(lds + SC_VT); bf16* WB = (bf16*)(lds + SC_WB); float* NL = (float*)(lds + SC_NL); float* RS = (float*)(lds + SC_RS); float* RD = RS + 64; bf16* OUTL = (bf16*)(lds + SC_OUT);
    const bf16* MQK = (const bf16*)(ws + O_MQK); const bf16* PA = (const bf16*)(ws + O_PA); const bf16* WT = (const bf16*)(ws + O_WT); bf16* HC = (bf16*)(ws + O_HC); const bf16* KTU = (const bf16*)(ws + O_KTU) + (size_t)(bh * 64) * 16384;
    const float* GG = (const float*)(ws + O_GG) + bh * 64; const float* GMX = (const float*)(ws + O_GMX) + bh * 64;
    const float* GA = (const float*)(ws + O_GA) + (size_t)bh * SEQ; const float* GLA = (const float*)(ws + O_GLA) + (size_t)bh * SEQ; const float* GPM = (const float*)(ws + O_GPM) + (size_t)bh * SEQ; const float* DENI = (const float*)(ws + O_DENI) + (size_t)bh * SEQ;
    f32x4 (&acc)[16] = S.acc; float& mst = S.mst;
    if (c0 == 0) {
#pragma unroll
        for (int i = 0; i < 16; ++i) acc[i] = (f32x4){0.f, 0.f, 0.f, 0.f};
        mst = 0.f; }
    v4u (&pq)[4] = S.pq; v4u (&pk)[4] = S.pk; v4u (&pv)[2] = S.pv; v4u& pw = S.pw; float& pla = S.pla; float& pa = S.pa; float& pmi = S.pmi; float& pdn = S.pdn; float& gnx = S.gnx; float& mxnx = S.mxnx;
    if (c0 == 0) {
    __syncthreads();
    if (tid < 256) { NL[tid] = 0.f; NL[256 + tid] = 0.f; }
    scan_wait_flag(P, bh, 0, tid);
    { const size_t row0 = (size_t)b * SEQ; const int ts = tid & 63, tc = tid >> 6, qr_ = tid >> 5, qc8 = (tid & 31) * 8, wr_ = tid >> 3, wc8 = (tid & 7) * 8, dj = tid >> 3;
#pragma unroll
      for (int p = 0; p < 4; ++p) { pq[p] = *(const v4u*)(MQK + (row0 + 16 * p + qr_) * 2048 + h * 256 + qc8); pk[p] = *(const v4u*)(KTU + (size_t)(p * NT + tid) * 8); }
#pragma unroll
      for (int p = 0; p < 2; ++p) pv[p] = *(const v4u*)(PA + (row0 + ts) * NA + PA_MV + h * 256 + eh * 128 + (tc + 8 * p) * 8);
      pw = *(const v4u*)(WT + (size_t)(bh * 64) * 4096 + wr_ * 64 + wc8);
      pla = GLA[ts]; pa = GA[dj]; pmi = GPM[dj]; pdn = DENI[dj]; }
    gnx = GG[0]; mxnx = GMX[0]; }
    for (int c = c0; c < c1; ++c) {
        const size_t row0 = (size_t)b * SEQ + 64 * c;
        const float g = gnx, mx = mxnx; const float mnew = fmaxf(g + mst, mx); const float dec = __expf(g + mst - mnew);
        const float mc = fmaxf(pa + mst, pmi); const float si = __expf(pa + mst - mc), emc = __expf(-mc), dni = pdn;
        const int cur = c & 1;
        int lane_o = lane, tid_o = tid; asm volatile("" : "+v"(lane_o), "+v"(tid_o)); const int m16 = lane_o & 15, quad = lane_o >> 4;
        const int ts = tid_o & 63, tc = tid_o >> 6, qr_ = tid_o >> 5, qc8 = (tid_o & 31) * 8, wr_ = tid_o >> 3, wc8 = (tid_o & 7) * 8, dj = tid_o >> 3, dpart = tid_o & 7; const int tid = tid_o;
        LBAR();
        if (c > 0) {
#pragma unroll
            for (int p = 0; p < 2; ++p) { const int idx = p * NT + tid, j = idx >> 4, c8 = (idx & 15) * 8; *(v4u*)(HC + (row0 - 64 + j) * 1024 + h * 256 + eh * 128 + c8) = *(const v4u*)(OUTL + j * 136 + c8); } }
#pragma unroll
        for (int p = 0; p < 4; ++p) { *(v4u*)(QL + (16 * p + qr_) * 264 + qc8) = pq[p];
            { const int idx = p * NT + tid; *(v4u*)(KT + (idx >> 3) * 72 + (idx & 7) * 8) = pk[p]; } }
#pragma unroll
        for (int p = 0; p < 2; ++p) { bf16* vd = VT + (size_t)((tc + 8 * p) * 8) * 72 + ts; const v4u w = pv[p];
            vd[0 * 72] = (bf16)(w.x & 0xffffu); vd[1 * 72] = (bf16)(w.x >> 16); vd[2 * 72] = (bf16)(w.y & 0xffffu); vd[3 * 72] = (bf16)(w.y >> 16);
            vd[4 * 72] = (bf16)(w.z & 0xffffu); vd[5 * 72] = (bf16)(w.z >> 16); vd[6 * 72] = (bf16)(w.w & 0xffffu); vd[7 * 72] = (bf16)(w.w >> 16); }
        *(v4u*)(WB + wr_ * 72 + wc8) = pw;
        LBAR();
        if (c + 1 < SCAN_NFLAG && c1 < 64) scan_wait_flag(P, bh, c + 1, tid);
        if (c + 1 < 64) { const size_t r1 = row0 + 64;
#pragma unroll
            for (int p = 0; p < 4; ++p) { pq[p] = *(const v4u*)(MQK + (r1 + 16 * p + qr_) * 2048 + h * 256 + qc8); pk[p] = *(const v4u*)(KTU + (size_t)(c + 1) * 16384 + (size_t)(p * NT + tid) * 8); }
#pragma unroll
            for (int p = 0; p < 2; ++p) pv[p] = *(const v4u*)(PA + (r1 + ts) * NA + PA_MV + h * 256 + eh * 128 + (tc + 8 * p) * 8);
            pw = *(const v4u*)(WT + (size_t)(bh * 64 + c + 1) * 4096 + wr_ * 64 + wc8);
            gnx = GG[c + 1]; mxnx = GMX[c + 1]; pla = GLA[64 * (c + 1) + ts]; pa = GA[64 * (c + 1) + dj]; pmi = GPM[64 * (c + 1) + dj]; pdn = DENI[64 * (c + 1) + dj]; }
        { const float* ncur = NL + cur * 256; float dn = 0.f; v4u qw4[4]; f32x4 n4[8];
#pragma unroll
          for (int i = 0; i < 4; ++i) { qw4[i] = *(const v4u*)(QL + dj * 264 + dpart * 32 + 8 * i); n4[2 * i] = *(const f32x4*)(ncur + dpart * 32 + 8 * i); n4[2 * i + 1] = *(const f32x4*)(ncur + dpart * 32 + 8 * i + 4); }
          asm volatile("" ::: "memory");
#pragma unroll
          for (int i = 0; i < 4; ++i) { const v4u qw = qw4[i]; const f32x4 na = n4[2 * i], nb = n4[2 * i + 1];
              dn += lo16(qw.x) * na.x + hi16(qw.x) * na.y + lo16(qw.y) * na.z + hi16(qw.y) * na.w + lo16(qw.z) * nb.x + hi16(qw.z) * nb.y + lo16(qw.w) * nb.z + hi16(qw.w) * nb.w; }
          dn += __shfl_xor(dn, 1); dn += __shfl_xor(dn, 2); dn += __shfl_xor(dn, 4);
          if (dpart == 0) { RS[dj] = si; RD[dj] = 1.f / fmaxf(fabsf(si * dn + dni), emc); }
          if (tid < 256) { float ks = 0.f;
#pragma unroll
              for (int s8 = 0; s8 < 64; s8 += 8) { const v4u kw = *(const v4u*)(KT + tid * 72 + s8); ks += (lo16(kw.x) + hi16(kw.x)) + (lo16(kw.y) + hi16(kw.y)) + (lo16(kw.z) + hi16(kw.z)) + (lo16(kw.w) + hi16(kw.w)); }
              NL[(cur ^ 1) * 256 + tid] = dec * ncur[tid] + ks; } }
        f32x4 oi[4], oa[4];
#pragma unroll
        for (int jt = 0; jt < 4; ++jt) { oi[jt] = (f32x4){0.f, 0.f, 0.f, 0.f}; oa[jt] = (f32x4){0.f, 0.f, 0.f, 0.f}; }
        sbf16x8 vfr[2]; sbf16x8 wfr[4][2];
#pragma unroll
        for (int ks = 0; ks < 2; ++ks) vfr[ks] = *(const sbf16x8*)(VT + (16 * wave + m16) * 72 + 32 * ks + 8 * quad);
#pragma unroll
        for (int jt = 0; jt < 4; ++jt)
#pragma unroll
            for (int ks = 0; ks < 2; ++ks) wfr[jt][ks] = *(const sbf16x8*)(WB + (16 * jt + m16) * 72 + 32 * ks + 8 * quad);
        asm volatile("" ::: "memory");
#pragma unroll
        for (int jt = 0; jt < 4; ++jt)
#pragma unroll
            for (int ks = 0; ks < 2; ++ks) oa[jt] = __builtin_amdgcn_mfma_f32_16x16x32_bf16(wfr[jt][ks], vfr[ks], oa[jt], 0, 0, 0);
        v2u qa[2][4][2];
#pragma unroll
        for (int jt = 0; jt < 4; ++jt) { const bf16* qp = QL + (16 * jt + m16) * 264 + 4 * quad; qa[0][jt][0] = *(const v2u*)qp; qa[0][jt][1] = *(const v2u*)(qp + 16); }
        asm volatile("" ::: "memory");
#pragma unroll
        for (int kk = 0; kk < 8; ++kk) {
            if (kk + 1 < 8) {
#pragma unroll
                for (int jt = 0; jt < 4; ++jt) { const bf16* qp = QL + (16 * jt + m16) * 264 + 32 * (kk + 1) + 4 * quad; qa[(kk + 1) & 1][jt][0] = *(const v2u*)qp; qa[(kk + 1) & 1][jt][1] = *(const v2u*)(qp + 16); }
                asm volatile("" ::: "memory");
            }
            v4u cw; cw.x = cvtpk2(acc[2 * kk][0], acc[2 * kk][1]); cw.y = cvtpk2(acc[2 * kk][2], acc[2 * kk][3]); cw.z = cvtpk2(acc[2 * kk + 1][0], acc[2 * kk + 1][1]); cw.w = cvtpk2(acc[2 * kk + 1][2], acc[2 * kk + 1][3]);
            const sbf16x8 bfr = __builtin_bit_cast(sbf16x8, cw);
#pragma unroll
            for (int jt = 0; jt < 4; ++jt) { const v4u aw = (v4u){qa[kk & 1][jt][0].x, qa[kk & 1][jt][0].y, qa[kk & 1][jt][1].x, qa[kk & 1][jt][1].y};
                oi[jt] = __builtin_amdgcn_mfma_f32_16x16x32_bf16(__builtin_bit_cast(sbf16x8, aw), bfr, oi[jt], 0, 0, 0); } }
        LBAR();
        { bf16* hp = OUTL + (4 * quad) * 136 + 16 * wave + m16; f32x4 rs4[4], rd4[4];
#pragma unroll
          for (int jt = 0; jt < 4; ++jt) { rs4[jt] = *(const f32x4*)(RS + 16 * jt + 4 * quad); rd4[jt] = *(const f32x4*)(RD + 16 * jt + 4 * quad); }
#pragma unroll
          for (int jt = 0; jt < 4; ++jt)
#pragma unroll
              for (int i = 0; i < 4; ++i) hp[(16 * jt + i) * 136] = (bf16)f2bf((rs4[jt][i] * oi[jt][i] + oa[jt][i]) * rd4[jt][i]); }
        { sbf16x8 kfa[4], kfb[4];
#pragma unroll
          for (int i = 0; i < 4; ++i) kfa[i] = *(const sbf16x8*)(KT + (16 * (i >> 1) + m16) * 72 + 32 * (i & 1) + 8 * quad);
          asm volatile("" ::: "memory");
#pragma unroll
          for (int db = 0; db < 8; ++db) {
            if (db + 1 < 8) {
#pragma unroll
                for (int i = 0; i < 4; ++i) kfb[i] = *(const sbf16x8*)(KT + (16 * (2 * (db + 1) + (i >> 1)) + m16) * 72 + 32 * (i & 1) + 8 * quad);
                asm volatile("" ::: "memory");
            }
#pragma unroll
            for (int i = 0; i < 2; ++i) { const int dt = 2 * db + i; acc[dt] = acc[dt] * dec;
                acc[dt] = __builtin_amdgcn_mfma_f32_16x16x32_bf16(kfa[2 * i], vfr[0], acc[dt], 0, 0, 0); acc[dt] = __builtin_amdgcn_mfma_f32_16x16x32_bf16(kfa[2 * i + 1], vfr[1], acc[dt], 0, 0, 0); }
            if (db + 1 < 8) {
#pragma unroll
                for (int i = 0; i < 4; ++i) kfa[i] = kfb[i];
            }
          } }
        mst = mnew;
    }
    if (c1 == 64) { LBAR();
    { const size_t rowl = (size_t)b * SEQ + 64 * 63;
#pragma unroll
      for (int p = 0; p < 2; ++p) { const int idx = p * NT + tid, j = idx >> 4, c8 = (idx & 15) * 8; *(v4u*)(HC + (rowl + j) * 1024 + h * 256 + eh * 128 + c8) = *(const v4u*)(OUTL + j * 136 + c8); } }
}
}
#define GAS __attribute__((address_space(1)))
typedef GAS unsigned gu32;
typedef GAS unsigned long long gu64;
#define RLX_AGENT __ATOMIC_RELAXED, __HIP_MEMORY_SCOPE_AGENT
#define LDS_WAIT() asm volatile("s_waitcnt lgkmcnt(0)" ::: "memory")
#define VM_WAIT() asm volatile("s_waitcnt vmcnt(0)" ::: "memory")
__device__ __forceinline__ unsigned long long rt() { return __builtin_amdgcn_s_memrealtime(); }
#define XB_TMO      128
#define XB_XCNT(j)  (256  + 64 * (j))
#define XB_XSUB(j)  (1280 + 64 * (j))
#define XB_XGEN(j)  (2304 + 64 * (j))
#define XB_TOP      3328
#define XB_TOPGEN   3392
#define XCD_BAR_WORDS 3456
#define XB_SPIN_CAP (1u << 18)

__device__ __forceinline__ unsigned xb_ld(unsigned* p)              { return __hip_atomic_load(p, __ATOMIC_RELAXED, __HIP_MEMORY_SCOPE_AGENT); }
__device__ __forceinline__ unsigned xb_add(unsigned* p, unsigned v) { return __hip_atomic_fetch_add(p, v, __ATOMIC_RELAXED, __HIP_MEMORY_SCOPE_AGENT); }
__device__ __forceinline__ unsigned xb_xcc_id() { return (unsigned)__builtin_amdgcn_s_getreg((3 << 11) | 20) & 0xFu; }
#define XB_SPIN(cond, bar) do { unsigned _sp = 0; while (cond) { __builtin_amdgcn_s_sleep(1); \
    if ((++_sp & 255u) == 0u) { if (xb_ld(&(bar)[XB_TMO])) break; if (_sp > XB_SPIN_CAP) { atomicAdd(&(bar)[XB_TMO], 1u); break; } } } } while (0)

struct XcdBarrier {
    unsigned* bar; unsigned x;
    volatile LAS unsigned* st;
};

__device__ __forceinline__ XcdBarrier xcd_barrier_post(unsigned* bar, volatile LAS unsigned* st) {
    XcdBarrier b; b.bar = bar; b.x = xb_xcc_id(); b.st = st;
    if (threadIdx.x == 0) (void)xb_add(&bar[XB_XCNT(b.x)], 1u);
    return b;
}
__device__ __forceinline__ void xcd_barrier_complete(unsigned* bar, unsigned x, unsigned& nloc, unsigned& nx) {
    const unsigned G = gridDim.x * gridDim.y * gridDim.z;
    unsigned sum, cnt, mine, sp = 0u;
    for (;;) {
        sum = 0u; cnt = 0u; mine = 0u;
#pragma unroll
        for (unsigned j = 0; j < 16; ++j) { const unsigned c = xb_ld(&bar[XB_XCNT(j)]); sum += c; cnt += (c > 0u) ? 1u : 0u; mine = (j == x) ? c : mine; }
        if (sum == G) break;
        __builtin_amdgcn_s_sleep(1);
        if ((++sp & 255u) == 0u) { if (xb_ld(&bar[XB_TMO])) break; if (sp > XB_SPIN_CAP) { atomicAdd(&bar[XB_TMO], 1u); break; } }
    }
    nloc = mine > 0u ? mine : 1u; nx = cnt > 0u ? cnt : 1u;
}

__device__ __forceinline__ void xcd_barrier(const XcdBarrier& b) {
    asm volatile("s_waitcnt vmcnt(0)" ::: "memory");
    __syncthreads();
    if (threadIdx.x == 0) {
        unsigned* bar = b.bar;
        __builtin_amdgcn_s_waitcnt(0);
        unsigned nloc = b.st[0], nx = b.st[1];
        if (nloc == 0u) { xcd_barrier_complete(bar, b.x, nloc, nx); b.st[0] = nloc; b.st[1] = nx; }
        const unsigned old = xb_add(&bar[XB_XSUB(b.x)], 1u);
        const unsigned gen = old / nloc;
        if (old + 1u == (gen + 1u) * nloc) {
            __builtin_amdgcn_fence(__ATOMIC_RELEASE, "agent");
            asm volatile("s_waitcnt vmcnt(0)" ::: "memory");
            const unsigned og = xb_add(&bar[XB_TOP], 1u);
            const unsigned tg = og / nx;
            if (og + 1u == (tg + 1u) * nx) xb_add(&bar[XB_TOPGEN], 1u);
            else XB_SPIN(xb_ld(&bar[XB_TOPGEN]) == tg, bar);
            __builtin_amdgcn_fence(__ATOMIC_ACQUIRE, "agent");
            xb_add(&bar[XB_XGEN(b.x)], 1u);
            asm volatile("s_waitcnt vmcnt(0)" ::: "memory");
        } else {
            XB_SPIN(xb_ld(&bar[XB_XGEN(b.x)]) == gen, bar);
            __builtin_amdgcn_fence(__ATOMIC_ACQUIRE, "agent");
            asm volatile("s_waitcnt vmcnt(0)" ::: "memory");
        }
    }
    __syncthreads();
}

typedef float f32x16 __attribute__((ext_vector_type(16)));
typedef short bf16x8 __attribute__((ext_vector_type(8)));
constexpr int NSA_KL = 0, NSA_VL = 9216, NSA_SET = 27648  , NSA_IMP = 55296, NSA_SEL = 120832, NSA_FAC = 121856, NSA_VALS = 123904;
__device__ __forceinline__ unsigned cvtpk(float lo, float hi) { typedef float f2_ __attribute__((ext_vector_type(2))); typedef __bf16 b2_ __attribute__((ext_vector_type(2))); const f2_ v = {lo, hi}; return __builtin_bit_cast(unsigned, __builtin_convertvector(v, b2_)); }
__device__ __forceinline__ int crow(int r, int hi) { return (r & 3) + 8 * (r >> 2) + 4 * hi; }
#define CBAR() asm volatile("" ::: "memory")
template <int ND, bool MASK = true>
__device__ __forceinline__ void nsa_tile(const bf16* KL, const bf16* VL, const bf16x8 (&qr)[4], float negM, int klo, int khi, float& lsum, f32x16 (&o)[4], int r32, int hi) {
    f32x16 p0, p1; { float nm = negM; asm volatile("" : "+v"(nm));
#pragma unroll
    for (int r = 0; r < 16; ++r) { p0[r] = nm; p1[r] = nm; } }
    bf16x8 kf[8];
#pragma unroll
    for (int d0 = 0; d0 < 4; ++d0) { kf[2 * d0] = *(const bf16x8*)(KL + r32 * 72 + 16 * d0 + 8 * hi); kf[2 * d0 + 1] = *(const bf16x8*)(KL + (32 + r32) * 72 + 16 * d0 + 8 * hi); }
    CBAR();
#pragma unroll
    for (int d0 = 0; d0 < 4; ++d0) { p0 = __builtin_amdgcn_mfma_f32_32x32x16_bf16(kf[2 * d0], qr[d0], p0, 0, 0, 0); p1 = __builtin_amdgcn_mfma_f32_32x32x16_bf16(kf[2 * d0 + 1], qr[d0], p1, 0, 0, 0); }
    v2u va[4][2];
#pragma unroll
    for (int ks = 0; ks < 4; ++ks) { const bf16* vp = VL + r32 * 72 + 16 * ks + 4 * hi; va[ks][0] = *(const v2u*)vp; va[ks][1] = *(const v2u*)(vp + 8); }
    CBAR();
    const int lo2 = klo - 4 * hi, hi2 = khi - 4 * hi; float ls = 0.f;
#pragma unroll
    for (int r = 0; r < 16; ++r) { const int cr = (r & 3) + 8 * (r >> 2);
        if constexpr (MASK) { p0[r] = (cr > lo2 && cr <= hi2) ? __builtin_amdgcn_exp2f(p0[r]) : 0.f; p1[r] = (cr + 32 > lo2 && cr + 32 <= hi2) ? __builtin_amdgcn_exp2f(p1[r]) : 0.f; }
        else { p0[r] = __builtin_amdgcn_exp2f(p0[r]); p1[r] = __builtin_amdgcn_exp2f(p1[r]); }
        ls += p0[r] + p1[r]; }
    lsum += ls;
    bf16x8 pf[4];
    { v4u w; w.x = cvtpk(p0[0], p0[1]); w.y = cvtpk(p0[2], p0[3]); w.z = cvtpk(p0[4], p0[5]); w.w = cvtpk(p0[6], p0[7]); pf[0] = __builtin_bit_cast(bf16x8, w);
      w.x = cvtpk(p0[8], p0[9]); w.y = cvtpk(p0[10], p0[11]); w.z = cvtpk(p0[12], p0[13]); w.w = cvtpk(p0[14], p0[15]); pf[1] = __builtin_bit_cast(bf16x8, w);
      w.x = cvtpk(p1[0], p1[1]); w.y = cvtpk(p1[2], p1[3]); w.z = cvtpk(p1[4], p1[5]); w.w = cvtpk(p1[6], p1[7]); pf[2] = __builtin_bit_cast(bf16x8, w);
      w.x = cvtpk(p1[8], p1[9]); w.y = cvtpk(p1[10], p1[11]); w.z = cvtpk(p1[12], p1[13]); w.w = cvtpk(p1[14], p1[15]); pf[3] = __builtin_bit_cast(bf16x8, w); }
#pragma unroll
    for (int d0 = 0; d0 < ND; ++d0) {
        v2u vb[4][2];
        if (d0 + 1 < ND) {
#pragma unroll
            for (int ks = 0; ks < 4; ++ks) { const bf16* vp = VL + (32 * (d0 + 1) + r32) * 72 + 16 * ks + 4 * hi; vb[ks][0] = *(const v2u*)vp; vb[ks][1] = *(const v2u*)(vp + 8); }
            CBAR();
        }
#pragma unroll
        for (int ks = 0; ks < 4; ++ks) { const v4u w = (v4u){va[ks][0].x, va[ks][0].y, va[ks][1].x, va[ks][1].y}; o[d0] = __builtin_amdgcn_mfma_f32_32x32x16_bf16(pf[ks], __builtin_bit_cast(bf16x8, w), o[d0], 0, 0, 0); }
        if (d0 + 1 < ND) {
#pragma unroll
            for (int ks = 0; ks < 4; ++ks) { va[ks][0] = vb[ks][0]; va[ks][1] = vb[ks][1]; }
        }
    }
}
__device__ __forceinline__ void nsa_unit(const Params& P, unsigned char* lds, int bg, int qi, int tid, int lane, int wave, float negMc, float negMs, float negMw) {
    asm volatile("" : "+v"(lane), "+v"(tid));
    unsigned char* ws = P.ws; const int b = bg >> 2, g = bg & 3, r32 = lane & 31, hi = lane >> 5, head = wave >> 1, half = wave & 1;
    const int tq = 64 * qi + 32 * half + r32;
    bf16* KL = (bf16*)(lds + NSA_KL); bf16* VL = (bf16*)(lds + NSA_VL); float* IMP = (float*)(lds + NSA_IMP); unsigned long long* SEL = (unsigned long long*)(lds + NSA_SEL);
    float* FAC = (float*)(lds + NSA_FAC) + wave * 64; float* VALS = (float*)(lds + NSA_VALS) + wave * 64;
    const bf16* PA = (const bf16*)(ws + O_PA); const size_t rowq = (size_t)b * SEQ + tq;
    bf16x8 qr[4]; { const bf16* qp = PA + rowq * NA + PA_Q + (g * 4 + head) * 64 + 8 * hi;
#pragma unroll
        for (int d0 = 0; d0 < 4; ++d0) qr[d0] = *(const bf16x8*)(qp + 16 * d0); }
    const int ldr = tid >> 3, ldc8 = (tid & 7) * 8;
    float* OSW = (float*)(lds + NSA_IMP) + wave * 2048;
#define OSWI(q_, blk_) (((blk_) * 32 + r32) * 32 + ((q_) ^ r32))
    f32x16 o[4];
    __syncthreads();
    if (tid == 0) SEL[64] = 0ull;
    bf16* KL1 = (bf16*)(lds + NSA_SET + NSA_KL); bf16* VL1 = (bf16*)(lds + NSA_SET + NSA_VL);
    const int so = ldr * 72 + ldc8;
#define NSA_LBAR() asm volatile("s_waitcnt lgkmcnt(0)\n\ts_barrier" ::: "memory")
#define NSA_LOAD(n, kr, vr) do { if ((n) >= 0) { kr = *(const v4u*)(KSRC(n)); vr = *(const v4u*)(VSRC(n)); } } while (0)
#define NSA_STAGE(na, nb, ka, va, kb, vb) do { NSA_LBAR(); *(v4u*)(KL + so) = ka; *(v4u*)(VL + so) = va; if ((nb) >= 0) { *(v4u*)(KL1 + so) = kb; *(v4u*)(VL1 + so) = vb; } EXTRA(na, nb); NSA_LBAR(); } while (0)
#define NSA_PIPE() do { int a0, b0, a1, b1; v4u k0a, v0a, k0b, v0b, k1a, v1a, k1b, v1b; k0a = v0a = k0b = v0b = k1a = v1a = k1b = v1b = (v4u){0u, 0u, 0u, 0u}; \
        POPN(a0); POPN(b0); POPN(a1); POPN(b1); NSA_LOAD(a0, k0a, v0a); NSA_LOAD(b0, k0b, v0b); NSA_LOAD(a1, k1a, v1a); NSA_LOAD(b1, k1b, v1b); \
        while (a0 >= 0) { \
            NSA_STAGE(a0, b0, k0a, v0a, k0b, v0b); \
            { const int ca = a0, cb = b0; POPN(a0); POPN(b0); NSA_LOAD(a0, k0a, v0a); NSA_LOAD(b0, k0b, v0b); TILE(KL, VL, ca); if (cb >= 0) TILE(KL1, VL1, cb); } \
            if (a1 < 0) break; \
            NSA_STAGE(a1, b1, k1a, v1a, k1b, v1b); \
            { const int ca = a1, cb = b1; POPN(a1); POPN(b1); NSA_LOAD(a1, k1a, v1a); NSA_LOAD(b1, k1b, v1b); TILE(KL, VL, ca); if (cb >= 0) TILE(KL1, VL1, cb); } \
        } } while (0)
    {
#pragma unroll
        for (int d0 = 0; d0 < 4; ++d0)
#pragma unroll
            for (int r = 0; r < 16; ++r) o[d0][r] = 0.f;
        const bf16* Kc = (const bf16*)(ws + O_KCB) + (size_t)bg * 256 * 64 + (size_t)ldr * 64 + ldc8; const bf16* Vc = (const bf16*)(ws + O_VCT) + (size_t)bg * 64 * 256 + (size_t)ldr * 256 + ldc8;
        const int ntile = ((4 * qi + 2) >> 6) + 1; const int cmaxq = (tq >= 31) ? ((tq - 31) >> 4) : -1; float lsum = 0.f; int tl = 0;
#define POPN(n) do { n = (tl < ntile) ? tl : -1; ++tl; } while (0)
#define KSRC(n) (Kc + (size_t)64 * (n) * 64)
#define VSRC(n) (Vc + 64 * (n))
#define OVROW(dst, n) do { const int cb_ = 64 * (n) + ldc8, lo_ = 4 * ldr - 1, hi_ = (4 * ldr + 3 < 254) ? 4 * ldr + 3 : 254; v4u w_; \
            w_.x = (((cb_ + 0) >= lo_ && (cb_ + 0) <= hi_) ? 0x3F80u : 0u) | (((cb_ + 1) >= lo_ && (cb_ + 1) <= hi_) ? 0x3F800000u : 0u); w_.y = (((cb_ + 2) >= lo_ && (cb_ + 2) <= hi_) ? 0x3F80u : 0u) | (((cb_ + 3) >= lo_ && (cb_ + 3) <= hi_) ? 0x3F800000u : 0u); \
            w_.z = (((cb_ + 4) >= lo_ && (cb_ + 4) <= hi_) ? 0x3F80u : 0u) | (((cb_ + 5) >= lo_ && (cb_ + 5) <= hi_) ? 0x3F800000u : 0u); w_.w = (((cb_ + 6) >= lo_ && (cb_ + 6) <= hi_) ? 0x3F80u : 0u) | (((cb_ + 7) >= lo_ && (cb_ + 7) <= hi_) ? 0x3F800000u : 0u); \
            *(v4u*)((dst) + (64 + ldr) * 72 + ldc8) = w_; } while (0)
#define EXTRA(na, nb) do { OVROW(VL, na); if ((nb) >= 0) OVROW(VL1, nb); } while (0)
#define TILE(K_, V_, n) nsa_tile<4, true>(K_, V_, qr, negMc, -1, cmaxq - 64 * (n), lsum, o, r32, hi)
        NSA_PIPE();
#undef POPN
#undef KSRC
#undef VSRC
#undef EXTRA
#undef TILE
        lsum += __shfl_xor(lsum, 32); const float inv = lsum > 0.f ? 1.f / lsum : 0.f;
        if (hi == 0) { FAC[r32] = inv * sigmf(((const float*)(ws + O_SM))[rowq * 64 + (g * 4 + head) * 3 + 0]); FAC[32 + r32] = inv; }
        WSYNC();
#pragma unroll
        for (int r = 0; r < 16; ++r) { const int q = crow(r, hi); const float f = FAC[q], f2 = FAC[32 + q];
            o[0][r] *= f; o[1][r] *= f;
            float* ip = IMP + ((size_t)head * 64 + 32 * half + q) * 64 + r32; ip[0] = o[2][r] * f2; ip[32] = o[3][r] * f2; }
        __syncthreads();
#pragma unroll 1
        for (int tk = 0; tk < 8; ++tk) { const int tok = 8 * wave + tk; const float* ip = IMP + (size_t)tok * 64 + lane;
            const float impv = ip[0] + ip[4096] + ip[8192] + ip[12288];
            const float val = (lane == 0 || lane == qi || lane == qi - 1) ? 1e4f : ((lane <= qi) ? impv : -1.f);
            const unsigned ub = __float_as_uint(val); const unsigned key = (ub & 0x80000000u) ? ~ub : (ub | 0x80000000u);
            unsigned thr = 0u;
#pragma unroll
            for (int bit = 31; bit >= 0; --bit) { const unsigned cand = thr | (1u << bit); if (__popcll(__ballot(key >= cand)) >= 16) thr = cand; }
            const unsigned long long gtm = __ballot(key > thr), eqm = __ballot(key == thr); const int need = 16 - __popcll(gtm);
            const int below = __popcll(eqm & ((1ull << lane) - 1ull));
            const bool sel = (key > thr) || (key == thr && below < need);
            const unsigned long long mask = __ballot(sel && lane <= qi);
            if (lane == 0) { SEL[tok] = mask; atomicOr(&SEL[64], mask); } }
        __syncthreads();
#pragma unroll
        for (int r = 0; r < 16; ++r) { const int q = crow(r, hi); OSW[OSWI(q, 0)] = o[0][r]; OSW[OSWI(q, 1)] = o[1][r]; }
    }
#define EXTRA(na, nb) do { } while (0)
    {
        const unsigned long long mysel = SEL[32 * half + r32]; unsigned long long om = SEL[64];
#pragma unroll
        for (int d0 = 0; d0 < 2; ++d0)
#pragma unroll
            for (int r = 0; r < 16; ++r) o[d0][r] = 0.f;
        const bf16* Ks = PA + (size_t)b * SEQ * NA + PA_KV + 2 * 256 + g * 64 + (size_t)ldr * NA + ldc8; const bf16* Vs = (const bf16*)(ws + O_VTS) + (size_t)bg * 64 * SEQ + (size_t)ldr * 64 + ldc8; float lsum = 0.f;
#define POPN(n) do { if (om) { n = __builtin_ctzll(om); om &= om - 1; } else n = -1; } while (0)
#define KSRC(n) (Ks + (size_t)64 * (n) * NA)
#define VSRC(n) (Vs + (size_t)4096 * (n))
#define TILE(K_, V_, n) do { const bool selb = (mysel >> (n)) & 1ull; \
            if ((n) == qi) nsa_tile<2, true>(K_, V_, qr, negMs, -1, tq - 64 * (n), lsum, o, r32, hi);        \
            else if (__any(selb)) nsa_tile<2, false>(K_, V_, qr, selb ? negMs : -1e30f, 0, 0, lsum, o, r32, hi); } while (0)
        NSA_PIPE();
#undef POPN
#undef KSRC
#undef VSRC
#undef TILE
        lsum += __shfl_xor(lsum, 32); const float inv = lsum > 0.f ? 1.f / lsum : 0.f;
        WSYNC(); if (hi == 0) FAC[r32] = inv * sigmf(((const float*)(ws + O_SM))[rowq * 64 + (g * 4 + head) * 3 + 1]); WSYNC();
#pragma unroll
        for (int r = 0; r < 16; ++r) { const int q = crow(r, hi); const float f = FAC[q]; OSW[OSWI(q, 0)] += o[0][r] * f; OSW[OSWI(q, 1)] += o[1][r] * f; }
    }
    {
#pragma unroll
        for (int d0 = 0; d0 < 2; ++d0)
#pragma unroll
            for (int r = 0; r < 16; ++r) o[d0][r] = 0.f;
        const bf16* Kw = PA + (size_t)b * SEQ * NA + PA_KV + 4 * 256 + g * 64 + (size_t)ldr * NA + ldc8; const bf16* Vw = (const bf16*)(ws + O_VTW) + (size_t)bg * 64 * SEQ + (size_t)ldr * 64 + ldc8; float lsum = 0.f;
        int wn = qi >= 8 ? qi - 8 : 0;
#define POPN(n) do { n = (wn <= qi) ? wn : -1; ++wn; } while (0)
#define KSRC(n) (Kw + (size_t)64 * (n) * NA)
#define VSRC(n) (Vw + (size_t)4096 * (n))
#define TILE(K_, V_, n) do { if ((n) == qi || (n) == qi - 8) nsa_tile<2, true>(K_, V_, qr, negMw, tq - 512 - 64 * (n), tq - 64 * (n), lsum, o, r32, hi); \
            else nsa_tile<2, false>(K_, V_, qr, negMw, 0, 0, lsum, o, r32, hi); } while (0)
        NSA_PIPE();
#undef POPN
#undef KSRC
#undef VSRC
#undef TILE
        lsum += __shfl_xor(lsum, 32); const float inv = lsum > 0.f ? 1.f / lsum : 0.f;
        WSYNC(); if (hi == 0) FAC[r32] = inv * sigmf(((const float*)(ws + O_SM))[rowq * 64 + (g * 4 + head) * 3 + 2]); WSYNC();
#pragma unroll
        for (int r = 0; r < 16; ++r) { const int q = crow(r, hi); const float f = FAC[q]; OSW[OSWI(q, 0)] += o[0][r] * f; OSW[OSWI(q, 1)] += o[1][r] * f; }
    }
#undef EXTRA
    { WSYNC(); const int q = lane >> 1, dh = lane & 1; float v[32];
#pragma unroll
      for (int j = 0; j < 32; ++j) v[j] = OSW[(32 * dh + j) * 32 + (q ^ j)];
      bf16* op = (bf16*)(ws + O_ONSA) + ((size_t)b * SEQ + 64 * qi + 32 * half + q) * 1024 + (g * 4 + head) * 64 + 32 * dh;
#pragma unroll
      for (int k = 0; k < 4; ++k) { v4u w; w.x = cvtpk(v[8 * k], v[8 * k + 1]); w.y = cvtpk(v[8 * k + 2], v[8 * k + 3]); w.z = cvtpk(v[8 * k + 4], v[8 * k + 5]); w.w = cvtpk(v[8 * k + 6], v[8 * k + 7]); *(v4u*)(op + 8 * k) = w; }
      WSYNC(); }
#undef OSWI
}
__device__ __forceinline__ void hm_item4(const Params& P, int it0, int lane) {
    unsigned char* ws = P.ws; f32x4 hc[4]; v2u mo[4];
#pragma unroll
    for (int k = 0; k < 4; ++k) { const int it = it0 + k, row = it >> 2, h = it & 3;
        { const v2u hw = *(const v2u*)((const bf16*)(ws + O_HC) + (size_t)row * 1024 + h * 256 + 4 * lane); hc[k] = (f32x4){lo16(hw.x), hi16(hw.x), lo16(hw.y), hi16(hw.y)}; }
        mo[k] = *(const v2u*)((const bf16*)(ws + O_PA) + (size_t)row * NA + PA_MO + h * 256 + 4 * lane); }
#pragma unroll
    for (int k = 0; k < 4; ++k) { const int it = it0 + k, row = it >> 2, h = it & 3;
        const float ss = wave_sum(hc[k].x * hc[k].x + hc[k].y * hc[k].y + hc[k].z * hc[k].z + hc[k].w * hc[k].w); const float rstd = rsqrtf(ss * (1.f / 256.f) + EPS);
        v2u o; o.x = pk2(sigmf(lo16(mo[k].x)) * hc[k].x * rstd, sigmf(hi16(mo[k].x)) * hc[k].y * rstd); o.y = pk2(sigmf(lo16(mo[k].y)) * hc[k].z * rstd, sigmf(hi16(mo[k].y)) * hc[k].w * rstd);
        *(v2u*)((bf16*)(ws + O_HM) + (size_t)row * 1024 + h * 256 + 4 * lane) = o; }
}

constexpr int N_PHASES = 16;
__global__ void __launch_bounds__(NT, 2) mk_fwd(Params P) {
    extern __shared__ __attribute__((aligned(16))) unsigned char lds[];
    cg::grid_group grid = cg::this_grid();
    const int G = gridDim.x, bx = blockIdx.x, ngw = G * NWV;
#define TIDS() int tid = threadIdx.x; asm volatile("" : "+v"(tid)); const int lane = tid & 63, wave = __builtin_amdgcn_readfirstlane(tid >> 6), gw = bx * NWV + wave; (void)gw; (void)lane
    unsigned char* ws = P.ws; const int lo = P.ph_lo, hi = P.ph_hi;
    PG8_LAS unsigned char* lds3 = (PG8_LAS unsigned char*)lds;
#define IN(k) (lo <= (k) && (k) < hi)
    const bool multi = (hi - lo) > 1;
    volatile LAS unsigned* bst = (volatile LAS unsigned*)((LAS unsigned char*)lds + (LDS_BYTES - 64));
    XcdBarrier xbar; xbar.bar = (unsigned*)ws; xbar.x = 0; xbar.st = bst;
    if (multi) { if (threadIdx.x < 2) bst[threadIdx.x] = 0u; __syncthreads(); xbar = xcd_barrier_post((unsigned*)ws, bst); }
#define SEAM(k) do { if (IN(k) && IN((k) + 1)) { if ((k) == 0) grid.sync(); else xcd_barrier(xbar); } } while (0)
#define GEMMC(EPI, Aoff, Boff, MM, NN, KK, E, CID) do { pg8::Gemm g_{(const pg8::bf16_t*)(ws + (Aoff)), (const pg8::bf16_t*)(ws + (Boff)), (MM), (NN), (KK)}; pg8::StaticOrder S_; S_.init((MM), (NN), G, (CID)); \
        pg8::gemm_phase<EPI, pg8::StaticOrder, true, true>(lds3, g_, S_, (E)); } while (0)
#define GEMMNA(EPI, Aoff, Boff, MM, NN, KK, E) do { pg8::Gemm g_{(const pg8::bf16_t*)(ws + (Aoff)), (const pg8::bf16_t*)(ws + (Boff)), (MM), (NN), (KK)}; pg8::StaticOrder S_; S_.init((MM), (NN), G, bx); \
        pg8::gemm_phase<EPI, pg8::StaticOrder, false, true>(lds3, g_, S_, (E)); } while (0)
#define GEMM(EPI, Aoff, Boff, MM, NN, KK, E) do { pg8::Gemm g_{(const pg8::bf16_t*)(ws + (Aoff)), (const pg8::bf16_t*)(ws + (Boff)), (MM), (NN), (KK)}; pg8::StaticOrder S_; S_.init((MM), (NN), G, bx); \
        pg8::gemm_phase<EPI, pg8::StaticOrder, true, true>(lds3, g_, S_, (E)); } while (0)
    ScanState sst;
    const bool scanwg = (bx >= 32 && bx < 64 && G >= 64);
    if (IN(0)) { TIDS(); phase_prologue(P, lds, gw, ngw, wave, lane, tid); } SEAM(0);
    if (IN(1)) { pg8::EpiP<0> E{(pg8::bf16_t*)(ws + O_H), FF, nullptr, nullptr, 0, nullptr}; GEMM(pg8::EpiP<0>, O_XN, O_WGU, TOK, 2 * FF, DM, E); } SEAM(1);
    if (IN(2)) { pg8::EpiResid E{P.in[0], P.out, DM, 0.5f}; GEMMNA(pg8::EpiResid, O_H, O_WD, TOK, DM, FF, E); } SEAM(2);
    if (IN(3)) { TIDS(); phase_norm(P.out, (bf16*)(ws + O_XN), gw, ngw, lane); } SEAM(3);
    if (IN(4)) { pg8::EpiP<1> E{(pg8::bf16_t*)(ws + O_PA), NA, (const float*)(ws + O_BIASA), nullptr, 0, (float*)(ws + O_SM)}; GEMM(pg8::EpiP<1>, O_XN, O_WINA, TOK, NA, DM, E); } SEAM(4);
    if (IN(5)) { TIDS(); phase_prep(P, gw, ngw, lane); } SEAM(5);
    if (IN(6)) {
        { pg8::EpiP<3> E{(pg8::bf16_t*)(ws + O_CHK), 256, nullptr, nullptr, 0, nullptr}; GEMM(pg8::EpiP<3>, O_CBK, O_WC1K, 4096, 256, 2048, E); }
        { pg8::EpiP<3> E{(pg8::bf16_t*)(ws + O_CHV), 256, nullptr, nullptr, 0, nullptr}; GEMMC(pg8::EpiP<3>, O_CBV, O_WC1V, 4096, 256, 2048, E, (bx + G - 16) % G); }
        { TIDS(); if (bx < 32 && G >= 32) { const int cid = bx & 15; cmp2_block(P, lds, (cid % 8) * 2 + cid / 8, bx >> 4, tid); }
          unsigned* ictr = (unsigned*)ws + 3502;
          if (scanwg && multi) mlstm_scan_item(P, lds, bx - 32, tid, sst, 0, SCAN_N1);
          else for (;;) { __syncthreads(); if (tid == 0) bst[4] = __hip_atomic_fetch_add(ictr, 1u, __ATOMIC_RELAXED, __HIP_MEMORY_SCOPE_AGENT); __syncthreads();
              const int v = (int)bst[4]; if (v >= 1024) break; mlstm_intra_item(P, lds, (v & 15) * 64 + (v >> 4), tid); } }
    } SEAM(6);
    if (IN(8)) { TIDS();
#define UNI(x) __builtin_bit_cast(float, __builtin_amdgcn_readfirstlane(__builtin_bit_cast(int, (x))))
        const float mq = UNI(wave_max(fabsf(P.in[8][lane]))) * (8.f * 1.4426950408889634f);
        const float negMc = -mq * UNI(wave_max(fabsf(P.in[9][lane]))), negMs = -mq * UNI(wave_max(fabsf(P.in[10][lane]))), negMw = -mq * UNI(wave_max(fabsf(P.in[11][lane])));
#undef UNI
        if (scanwg) mlstm_scan_item(P, lds, bx - 32, tid, sst, multi ? SCAN_N1 : 0, 64);
        unsigned* qctr = (unsigned*)ws + 3500;
        for (;;) { __syncthreads(); if (tid == 0) bst[4] = __hip_atomic_fetch_add(qctr, 1u, __ATOMIC_RELAXED, __HIP_MEMORY_SCOPE_AGENT); __syncthreads();
            const int u = (int)bst[4]; if (u >= 1024) break; nsa_unit(P, lds, u & 15, 63 - (u >> 4), tid, lane, wave, negMc, negMs, negMw); }
    } SEAM(8);
    if (IN(9)) { { TIDS(); for (int it = gw * 4; it < 65536; it += ngw * 4) { hm_item4(P, it, lane); } }
        if (multi) xcd_barrier(xbar);
        pg8::EpiP<2> E{(pg8::bf16_t*)(ws + O_MG), NB, (const float*)(ws + O_BIASB), nullptr, 0, nullptr}; GEMM(pg8::EpiP<2>, O_XN, O_WINB, TOK, NB, DM, E); } SEAM(9);
    if (IN(10)) { pg8::EpiP<4> E{(pg8::bf16_t*)(ws + O_XN), DM, nullptr, (const pg8::bf16_t*)(ws + O_MG), NB, nullptr}; GEMM(pg8::EpiP<4>, O_ONSA, O_WBN, TOK, DM, 1024, E); }
    if (IN(11)) { pg8::EpiP<5> E{(pg8::bf16_t*)(ws + O_XN), DM, nullptr, (const pg8::bf16_t*)(ws + O_MG), NB, nullptr}; GEMM(pg8::EpiP<5>, O_HM, O_WBM, TOK, DM, 1024, E); } SEAM(11);
    if (IN(12)) { pg8::EpiResid E{P.out, P.out, DM, 1.0f}; GEMMNA(pg8::EpiResid, O_XN, O_WOUT, TOK, DM, DM, E); } SEAM(12);
    if (IN(13)) { TIDS(); phase_norm(P.out, (bf16*)(ws + O_XN), gw, ngw, lane); phase_conv_ffn2(P, lds, gw, ngw, wave, lane); } SEAM(13);
    if (IN(14)) { pg8::EpiP<0> E{(pg8::bf16_t*)(ws + O_H), FF, nullptr, nullptr, 0, nullptr}; GEMM(pg8::EpiP<0>, O_XN, O_WGU, TOK, 2 * FF, DM, E); } SEAM(14);
    if (IN(15)) { pg8::EpiResid E{P.out, P.out, DM, 0.5f}; GEMMNA(pg8::EpiResid, O_H, O_WD, TOK, DM, FF, E); }
#undef IN
#undef SEAM
#undef GEMM
#undef GEMMNA
}

#ifndef MK_COOP
#define MK_COOP 0
#endif
extern "C" void kernel_launch(void* const* d_in, const int* in_sizes, int n_in, void* d_out, int out_size, void* d_ws, size_t ws_size, hipStream_t stream) {
    static int grid = 0;
    if (grid == 0) {
        if (n_in != 28 || ws_size < WS_NEED) { fprintf(stderr, "kernel_launch: unexpected n_in %d / ws_size %zu\n", n_in, ws_size); grid = -1; return; }
        int dev = 0, cus = 0, per_cu = 0;
        hipGetDevice(&dev); hipDeviceGetAttribute(&cus, hipDeviceAttributeMultiprocessorCount, dev);
        hipFuncSetAttribute((const void*)mk_fwd, hipFuncAttributeMaxDynamicSharedMemorySize, LDS_BYTES);
        hipOccupancyMaxActiveBlocksPerMultiprocessor(&per_cu, (const void*)mk_fwd, NT, LDS_BYTES);
        (void)hipGetLastError();
        if (per_cu < 1) per_cu = 1;
        grid = cus * 1;
        if (grid < 8) grid = 256;
    }
    if (grid < 0) return;
    Params p{};
    for (int i = 0; i < 28; ++i) p.in[i] = (const float*)d_in[i];
    p.out = (float*)d_out; p.ws = (unsigned char*)d_ws;
    if (hipMemsetAsync(d_ws, 0, 16384, stream) != hipSuccess) fprintf(stderr, "memset failed\n");
#if MK_COOP
    p.ph_lo = 0; p.ph_hi = N_PHASES;
    void* args[] = {&p};
    hipError_t e = hipLaunchCooperativeKernel((const void*)mk_fwd, dim3(grid), dim3(NT), args, LDS_BYTES, stream);
    if (e != hipSuccess) fprintf(stderr, "cooperative launch failed: %s (grid %d)\n", hipGetErrorString(e), grid);
#else
    for (int k = 0; k < N_PHASES; ++k) { p.ph_lo = k; p.ph_hi = k + 1; hipLaunchKernelGGL(mk_fwd, dim3(grid), dim3(NT), LDS_BYTES, stream, p); }
#endif
}
```

```cpp
#include <hip/hip_runtime.h>
#include <hip/hip_cooperative_groups.h>
#include <cstdio>
#include <cstdint>
namespace cg = cooperative_groups;
#define MK_COOP 1
namespace pg8 {
#define PG8_LAS __attribute__((address_space(3)))
typedef unsigned short bf16_t;
typedef short bf16x8 __attribute__((ext_vector_type(8)));
typedef float f32x4 __attribute__((ext_vector_type(4)));
typedef unsigned u32x4 __attribute__((ext_vector_type(4)));
constexpr int BM = 256, BK = 64, HALF = 128, HTB = HALF * BK * 2  , STAGE_BYTES = 8 * HTB, NXCD = 8, WGM = 8;

__host__ __device__ __forceinline__ int lds_byte(int r, int c) { const int st = (r >> 4) * 2 + (c >> 5), rr = r & 15, cc = c & 31, ob = rr * 64 + cc * 2; return st * 1024 + (ob ^ (((ob >> 9) & 1) << 5)); }
__host__ __device__ __forceinline__ void stage_rc(int b, int& R, int& C) { const int st = b / 1024, sb = b % 1024, swz = sb ^ (((sb >> 9) & 1) << 5); R = (st >> 1) * 16 + swz / 64; C = (st & 1) * 32 + (swz % 64) / 2; }
__host__ __device__ __forceinline__ int perm32(int rho) { const int n = rho >> 4, i = rho & 15; return 8 * (i >> 2) + 4 * n + (i & 3); }

struct Unit { int pm, pn; };
struct Gemm { const bf16_t* A; const bf16_t* Bt; int M, N, K; };

struct StaticOrder {
    int nM, nN, nwg, G, c;
    __host__ __device__ void init(int M, int N, int G_, int c_) { nM = M / BM; nN = N / BM; nwg = nM * nN; G = G_; c = c_; }
    __host__ __device__ bool next(int i, Unit& u) const {
        const long L = (long)i * G + c; if (L >= nwg) return false;
        int wgid = (int)L; { const int q = nwg / NXCD, r = nwg % NXCD, xcd = wgid % NXCD, off = wgid / NXCD; wgid = (xcd < r ? xcd * (q + 1) : r * (q + 1) + (xcd - r) * q) + off; }
        const int nig = WGM * nN, gid = wgid / nig, fm = gid * WGM, gsz = (nM - fm) < WGM ? (nM - fm) : WGM;
        u.pm = fm + ((wgid % nig) % gsz); u.pn = (wgid % nig) / gsz; return true;
    }
    __device__ __forceinline__ void a_ready(const Unit&) const {}
    __device__ __forceinline__ void done(const Unit&) const {}
};

__device__ __forceinline__ unsigned cvt_pk_bf16(float lo, float hi) { typedef float f2_ __attribute__((ext_vector_type(2))); typedef __bf16 b2_ __attribute__((ext_vector_type(2))); const f2_ v = {lo, hi}; return __builtin_bit_cast(unsigned, __builtin_convertvector(v, b2_)); }
typedef float f32x2 __attribute__((ext_vector_type(2)));
__device__ __forceinline__ float sigm(float x) { return __builtin_amdgcn_rcpf(1.f + __builtin_amdgcn_exp2f(x * -1.4426950408889634f)); }
__device__ __forceinline__ float gelu_tanh(float x) { const float u = 1.5957691216f * (x + 0.044715f * x * x * x); return x - x * __builtin_amdgcn_rcpf(__builtin_amdgcn_exp2f(u * 1.4426950408889634f) + 1.f); }
template <int MODE> struct EpiP {
    static constexpr bool PERM = true, AFTER_DRAIN = false;
    bf16_t* O; int ldc; const float* bias; const bf16_t* G; int ldg; float* SMo;
    __device__ __forceinline__ void operator()(const f32x4 (&acc)[2][2][4][2], const Unit& u, int wr, int wc, int fr, int fq) const {
        const int row0 = u.pm * BM + wr * 64 + fr;
        if constexpr (MODE == 0) {
            const int col = u.pn * 128 + wc * 32 + 8 * fq;
#pragma unroll
            for (int ai = 0; ai < 2; ++ai)
#pragma unroll
                for (int m = 0; m < 4; ++m) {
                    const int row = row0 + ai * HALF + m * 16; float o[8];
#pragma unroll
                    for (int n = 0; n < 2; ++n)
#pragma unroll
                        for (int i = 0; i < 4; ++i) { const float g = acc[ai][0][m][n][i], uu = acc[ai][1][m][n][i]; o[4 * n + i] = g * sigm(g) * uu; }
                    u32x4 w; w.x = cvt_pk_bf16(o[0], o[1]); w.y = cvt_pk_bf16(o[2], o[3]); w.z = cvt_pk_bf16(o[4], o[5]); w.w = cvt_pk_bf16(o[6], o[7]);
                    *(u32x4*)(O + (size_t)row * ldc + col) = w;
                }
        } else if constexpr (MODE == 4 || MODE == 5) {
#pragma unroll
            for (int ai = 0; ai < 2; ++ai) { u32x4 gw[4][2], ow[4][2];
#pragma unroll
                for (int m = 0; m < 4; ++m)
#pragma unroll
                    for (int bj = 0; bj < 2; ++bj) { const int row = row0 + ai * HALF + m * 16, col = u.pn * BM + bj * HALF + wc * 32 + 8 * fq;
                        gw[m][bj] = *(const u32x4*)(G + (size_t)row * ldg + (MODE == 5 ? 2048 : 0) + col); if constexpr (MODE == 5) ow[m][bj] = *(const u32x4*)(O + (size_t)row * ldc + col); }
#pragma unroll
                for (int m = 0; m < 4; ++m)
#pragma unroll
                    for (int bj = 0; bj < 2; ++bj) { const int row = row0 + ai * HALF + m * 16, col = u.pn * BM + bj * HALF + wc * 32 + 8 * fq; const u32x4 g_ = gw[m][bj];
                        f32x4 v0 = acc[ai][bj][m][0] * (f32x4){__uint_as_float(g_.x << 16), __uint_as_float(g_.x & 0xffff0000u), __uint_as_float(g_.y << 16), __uint_as_float(g_.y & 0xffff0000u)};
                        f32x4 v1 = acc[ai][bj][m][1] * (f32x4){__uint_as_float(g_.z << 16), __uint_as_float(g_.z & 0xffff0000u), __uint_as_float(g_.w << 16), __uint_as_float(g_.w & 0xffff0000u)};
                        if constexpr (MODE == 5) { const u32x4 o_ = ow[m][bj];
                            v0 = v0 + (f32x4){__uint_as_float(o_.x << 16), __uint_as_float(o_.x & 0xffff0000u), __uint_as_float(o_.y << 16), __uint_as_float(o_.y & 0xffff0000u)};
                            v1 = v1 + (f32x4){__uint_as_float(o_.z << 16), __uint_as_float(o_.z & 0xffff0000u), __uint_as_float(o_.w << 16), __uint_as_float(o_.w & 0xffff0000u)}; }
                        u32x4 w; w.x = cvt_pk_bf16(v0[0], v0[1]); w.y = cvt_pk_bf16(v0[2], v0[3]); w.z = cvt_pk_bf16(v1[0], v1[1]); w.w = cvt_pk_bf16(v1[2], v1[3]);
                        *(u32x4*)(O + (size_t)row * ldc + col) = w; } }
        } else {
#pragma unroll
            for (int bj = 0; bj < 2; ++bj) {
                const int col = u.pn * BM + bj * HALF + wc * 32 + 8 * fq;
                f32x4 b0 = (f32x4){0.f, 0.f, 0.f, 0.f}, b1 = b0;
                if constexpr (MODE == 1 || MODE == 2) { b0 = *(const f32x4*)(bias + col); b1 = *(const f32x4*)(bias + col + 4); }
#pragma unroll
                for (int ai = 0; ai < 2; ++ai)
#pragma unroll
                    for (int m = 0; m < 4; ++m) {
                        const int row = row0 + ai * HALF + m * 16;
                        f32x4 v0 = acc[ai][bj][m][0] + b0, v1 = acc[ai][bj][m][1] + b1;
                        if constexpr (MODE == 1) {
                            if (SMo != nullptr && u.pn == 26 && bj == 0 && wc < 2) { float* sp = SMo + (size_t)row * 64 + wc * 32 + 8 * fq; *(f32x4*)sp = v0; *(f32x4*)(sp + 4) = v1; }
                        }
                        if constexpr (MODE == 2) {
#pragma unroll
                            for (int i = 0; i < 4; ++i) { v0[i] = sigm(v0[i]); v1[i] = sigm(v1[i]); }
                        }
                        if constexpr (MODE == 3) {
#pragma unroll
                            for (int i = 0; i < 4; ++i) { v0[i] = gelu_tanh(v0[i]); v1[i] = gelu_tanh(v1[i]); }
                        }
                        if constexpr (MODE == 4 || MODE == 5) {
                            const u32x4 gw = *(const u32x4*)(G + (size_t)row * ldg + (MODE == 5 ? 2048 : 0) + col);
                            const float g0 = __uint_as_float(gw.x << 16), g1 = __uint_as_float(gw.x & 0xffff0000u), g2 = __uint_as_float(gw.y << 16), g3 = __uint_as_float(gw.y & 0xffff0000u);
                            const float g4 = __uint_as_float(gw.z << 16), g5 = __uint_as_float(gw.z & 0xffff0000u), g6 = __uint_as_float(gw.w << 16), g7 = __uint_as_float(gw.w & 0xffff0000u);
                            v0 = v0 * (f32x4){g0, g1, g2, g3}; v1 = v1 * (f32x4){g4, g5, g6, g7};
                            if constexpr (MODE == 5) {
                                const u32x4 ow = *(const u32x4*)(O + (size_t)row * ldc + col);
                                v0 = v0 + (f32x4){__uint_as_float(ow.x << 16), __uint_as_float(ow.x & 0xffff0000u), __uint_as_float(ow.y << 16), __uint_as_float(ow.y & 0xffff0000u)};
                                v1 = v1 + (f32x4){__uint_as_float(ow.z << 16), __uint_as_float(ow.z & 0xffff0000u), __uint_as_float(ow.w << 16), __uint_as_float(ow.w & 0xffff0000u)};
                            }
                        }
                        u32x4 w; w.x = cvt_pk_bf16(v0[0], v0[1]); w.y = cvt_pk_bf16(v0[2], v0[3]); w.z = cvt_pk_bf16(v1[0], v1[1]); w.w = cvt_pk_bf16(v1[2], v1[3]);
                        *(u32x4*)(O + (size_t)row * ldc + col) = w;
                    }
            }
        }
    }
};
struct EpiResid {
    static constexpr bool PERM = false, AFTER_DRAIN = false;
    const float* res; float* out; int ldc; float scale;
    __device__ __forceinline__ void operator()(const f32x4 (&acc)[2][2][4][2], const Unit& u, int wr, int wc, int fr, int fq) const {
        const int row0 = u.pm * BM + wr * 64 + fr, col0 = u.pn * BM + wc * 32 + 4 * fq;
#pragma unroll
        for (int ai = 0; ai < 2; ++ai) { f32x4 r[4][2][2];
#pragma unroll
            for (int m = 0; m < 4; ++m) { const size_t off = (size_t)(row0 + ai * HALF + m * 16) * ldc + col0;
#pragma unroll
                for (int bj = 0; bj < 2; ++bj)
#pragma unroll
                    for (int n = 0; n < 2; ++n) r[m][bj][n] = *(const f32x4*)(res + off + bj * HALF + n * 16); }
#pragma unroll
            for (int m = 0; m < 4; ++m) { const size_t off = (size_t)(row0 + ai * HALF + m * 16) * ldc + col0;
#pragma unroll
                for (int bj = 0; bj < 2; ++bj)
#pragma unroll
                    for (int n = 0; n < 2; ++n) *(f32x4*)(out + off + bj * HALF + n * 16) = r[m][bj][n] + acc[ai][bj][m][n] * scale; } }
    }
};
template <class Epi, class Sched, bool ALIGN_EPI = false, bool SP2 = false>
__device__ __forceinline__ void gemm_phase(PG8_LAS unsigned char* lds, const Gemm g, const Sched& S, const Epi& E) {
    int tid_o = threadIdx.x; asm volatile("" : "+v"(tid_o));
    const int tid = tid_o, wid = __builtin_amdgcn_readfirstlane(tid >> 6), lane = tid & 63, wr = wid >> 2, wc = wid & 3, fr = lane & 15, fq = lane >> 4;
    const int K = g.K, nt = K / BK;
    unsigned voffA[2], voffB[2];
#pragma unroll
    for (int i = 0; i < 2; ++i) { int R, C; stage_rc(tid * 16 + i * 8192, R, C); const int Rb = Epi::PERM ? ((R & ~31) + perm32(R & 31)) : R;
        voffA[i] = (unsigned)(R * K + C) * 2u; voffB[i] = (unsigned)(Rb * K + C) * 2u; }
    const size_t kstep = (size_t)(BK * 2);
    const size_t hstep = (size_t)HALF * K * 2;
    const size_t tstep = 2 * hstep;
    const unsigned ldsw = (unsigned)wid * 1024u;
    const int aoff = lds_byte(wr * 64 + fr, fq * 8), boff = lds_byte(wc * 32 + fr, fq * 8);
#define PG8_SA(b, h) (((b) * 2 + (h)) * HTB)
#define PG8_SB(b, h) ((4 + (b) * 2 + (h)) * HTB)
#define PG8_STAGE(bufoff, gbase, voff) do { _Pragma("unroll") for (int _i = 0; _i < 2; ++_i) \
        __builtin_amdgcn_global_load_lds((const unsigned*)((const char*)(gbase) + (voff)[_i]), (PG8_LAS unsigned*)(lds + (bufoff) + ldsw + _i * 8192), 16, 0, 0); } while (0)
#define PG8_LDA(dst, b, h) do { _Pragma("unroll") for (int m = 0; m < 4; ++m) _Pragma("unroll") for (int k = 0; k < 2; ++k) dst[m][k] = *(const PG8_LAS bf16x8*)(lds + PG8_SA(b, h) + aoff + m * 2048 + k * 1024); } while (0)
#define PG8_LDB(dst, b, h) do { _Pragma("unroll") for (int n = 0; n < 2; ++n) _Pragma("unroll") for (int k = 0; k < 2; ++k) dst[n][k] = *(const PG8_LAS bf16x8*)(lds + PG8_SB(b, h) + boff + n * 2048 + k * 1024); } while (0)
#define PG8_MMA(ai, bj, At, Bt) do { __builtin_amdgcn_s_setprio(1); _Pragma("unroll") for (int m = 0; m < 4; ++m) _Pragma("unroll") for (int n = 0; n < 2; ++n) _Pragma("unroll") for (int k = 0; k < 2; ++k) \
        acc[ai][bj][m][n] = __builtin_amdgcn_mfma_f32_16x16x32_bf16(Bt[n][k], At[m][k], acc[ai][bj][m][n], 0, 0, 0); __builtin_amdgcn_s_setprio(0); } while (0)
#define PG8_WAIT_V(n) asm volatile("s_waitcnt vmcnt(" #n ")" ::: "memory")
#define PG8_WAIT_L(n) asm volatile("s_waitcnt lgkmcnt(" #n ")" ::: "memory")
#define PG8_BAR __builtin_amdgcn_s_barrier()
#define PG8_SCHED __builtin_amdgcn_sched_barrier(0)
    Unit cur, nxt; int ui = 0;
    if (!S.next(0, cur)) return;
    f32x4 acc[2][2][4][2];
#pragma unroll
    for (int a = 0; a < 2; ++a)
#pragma unroll
        for (int b = 0; b < 2; ++b)
#pragma unroll
            for (int m = 0; m < 4; ++m)
#pragma unroll
                for (int n = 0; n < 2; ++n) acc[a][b][m][n] = (f32x4){0.f, 0.f, 0.f, 0.f};
    bf16x8 At[4][2], B0[2][2], B1[2][2];
    const char* cA = (const char*)g.A + (size_t)cur.pm * tstep; const char* cB = (const char*)g.Bt + (size_t)cur.pn * tstep;
    S.a_ready(cur);
    if constexpr (SP2) {
        PG8_STAGE(PG8_SB(0, 0), cB, voffB); PG8_STAGE(PG8_SB(0, 1), cB + hstep, voffB); PG8_STAGE(PG8_SA(0, 0), cA, voffA); PG8_STAGE(PG8_SA(0, 1), cA + hstep, voffA);
        if (wr == 1) PG8_BAR;
        PG8_WAIT_V(2); PG8_BAR;
        PG8_STAGE(PG8_SB(1, 0), cB + kstep, voffB); PG8_STAGE(PG8_SA(1, 0), cA + kstep, voffA); PG8_STAGE(PG8_SB(1, 1), cB + hstep + kstep, voffB);
        PG8_WAIT_V(6); PG8_BAR;
    } else {
        PG8_STAGE(PG8_SB(0, 0), cB, voffB); PG8_STAGE(PG8_SA(0, 0), cA, voffA); PG8_STAGE(PG8_SB(0, 1), cB + hstep, voffB); PG8_STAGE(PG8_SA(0, 1), cA + hstep, voffA);
        if (wr == 1) PG8_BAR;
        PG8_WAIT_V(4); PG8_BAR;
        PG8_STAGE(PG8_SB(1, 0), cB + kstep, voffB); PG8_STAGE(PG8_SA(1, 0), cA + kstep, voffA); PG8_STAGE(PG8_SB(1, 1), cB + hstep + kstep, voffB);
        PG8_WAIT_V(6); PG8_BAR;
    }
    for (;;) {
        const bool has_next = S.next(ui + 1, nxt);
        const char* nA = has_next ? (const char*)g.A + (size_t)nxt.pm * tstep : cA; const char* nB = has_next ? (const char*)g.Bt + (size_t)nxt.pn * tstep : cB;
        for (int t = 0; t < nt; t += 2) {
            const bool last = (t == nt - 2);
            const char* a1 = cA + (size_t)(t + 1) * kstep;
            const char* a2 = last ? nA : cA + (size_t)(t + 2) * kstep; const char* b2 = last ? nB : cB + (size_t)(t + 2) * kstep;
            const char* a3 = a2 + kstep; const char* b3 = b2 + kstep;
            if (last && has_next) S.a_ready(nxt);
            if constexpr (SP2) {
            PG8_LDB(B0, 0, 0); PG8_LDB(B1, 0, 1); PG8_SCHED; PG8_LDA(At, 0, 0); PG8_STAGE(PG8_SA(1, 1), a1 + hstep, voffA);
            PG8_WAIT_V(8); PG8_WAIT_L(0); PG8_BAR; PG8_MMA(0, 0, At, B0); PG8_MMA(0, 1, At, B1); PG8_BAR; PG8_SCHED;
            PG8_LDA(At, 0, 1); PG8_STAGE(PG8_SB(0, 0), b2, voffB); PG8_STAGE(PG8_SB(0, 1), b2 + hstep, voffB); PG8_STAGE(PG8_SA(0, 0), a2, voffA);
            PG8_WAIT_V(8); PG8_WAIT_L(0); PG8_BAR; PG8_MMA(1, 0, At, B0); PG8_MMA(1, 1, At, B1); PG8_BAR; PG8_SCHED;
            PG8_LDB(B0, 1, 0); PG8_LDB(B1, 1, 1); PG8_SCHED; PG8_LDA(At, 1, 0); PG8_STAGE(PG8_SA(0, 1), a2 + hstep, voffA);
            PG8_WAIT_V(8); PG8_WAIT_L(0); PG8_BAR; PG8_MMA(0, 0, At, B0); PG8_MMA(0, 1, At, B1); PG8_BAR; PG8_SCHED;
            PG8_LDA(At, 1, 1); PG8_STAGE(PG8_SB(1, 0), b3, voffB); PG8_STAGE(PG8_SB(1, 1), b3 + hstep, voffB); PG8_STAGE(PG8_SA(1, 0), a3, voffA);
            PG8_WAIT_V(8); PG8_WAIT_L(0); PG8_BAR; PG8_MMA(1, 0, At, B0); PG8_MMA(1, 1, At, B1); PG8_BAR; PG8_SCHED;
            } else {
            PG8_LDB(B0, 0, 0); PG8_SCHED; PG8_LDA(At, 0, 0); PG8_STAGE(PG8_SA(1, 1), a1 + hstep, voffA);
            PG8_WAIT_L(8); PG8_BAR; PG8_WAIT_L(0); PG8_MMA(0, 0, At, B0); PG8_BAR; PG8_SCHED;
            PG8_LDB(B1, 0, 1); PG8_STAGE(PG8_SB(0, 0), b2, voffB);
            PG8_BAR; PG8_WAIT_L(0); PG8_MMA(0, 1, At, B1); PG8_BAR;
            PG8_LDA(At, 0, 1); PG8_STAGE(PG8_SA(0, 0), a2, voffA);
            PG8_BAR; PG8_WAIT_L(0); PG8_MMA(1, 0, At, B0); PG8_BAR; PG8_SCHED;
            PG8_STAGE(PG8_SB(0, 1), b2 + hstep, voffB);
            PG8_WAIT_V(6); PG8_BAR; PG8_MMA(1, 1, At, B1); PG8_BAR;
            PG8_LDB(B0, 1, 0); PG8_SCHED; PG8_LDA(At, 1, 0); PG8_STAGE(PG8_SA(0, 1), a2 + hstep, voffA);
            PG8_WAIT_L(8); PG8_BAR; PG8_WAIT_L(0); PG8_MMA(0, 0, At, B0); PG8_BAR; PG8_SCHED;
            PG8_LDB(B1, 1, 1); PG8_STAGE(PG8_SB(1, 0), b3, voffB);
            PG8_BAR; PG8_WAIT_L(0); PG8_MMA(0, 1, At, B1); PG8_BAR;
            PG8_LDA(At, 1, 1); PG8_STAGE(PG8_SA(1, 0), a3, voffA);
            PG8_BAR; PG8_WAIT_L(0); PG8_MMA(1, 0, At, B0); PG8_BAR; PG8_SCHED;
            PG8_STAGE(PG8_SB(1, 1), b3 + hstep, voffB);
            PG8_WAIT_V(6); PG8_BAR; PG8_MMA(1, 1, At, B1); PG8_BAR;
            }
        }
        if constexpr (ALIGN_EPI) { if (wr == 0) PG8_BAR; }
        if constexpr (!Epi::AFTER_DRAIN) { E(acc, cur, wr, wc, fr, fq); S.done(cur); }
        if (!has_next) break;
#pragma unroll
        for (int a = 0; a < 2; ++a)
#pragma unroll
            for (int b = 0; b < 2; ++b)
#pragma unroll
                for (int m = 0; m < 4; ++m)
#pragma unroll
                    for (int n = 0; n < 2; ++n) acc[a][b][m][n] = (f32x4){0.f, 0.f, 0.f, 0.f};
        cur = nxt; cA = nA; cB = nB; ++ui;
        if constexpr (ALIGN_EPI) { if (wr == 1) PG8_BAR; }
    }
    PG8_WAIT_V(0);
    if constexpr (!ALIGN_EPI) { if (wr == 0) PG8_BAR; }
    PG8_BAR;
    if constexpr (Epi::AFTER_DRAIN) { E.fused(acc, cur, wr, wc, fr, fq, lds, wid, lane); S.done(cur); }
#undef PG8_SA
#undef PG8_SB
#undef PG8_STAGE
#undef PG8_LDA
#undef PG8_LDB
#undef PG8_MMA
#undef PG8_WAIT_V
#undef PG8_WAIT_L
#undef PG8_BAR
#undef PG8_SCHED
}
}
#define LAS __attribute__((address_space(3)))
typedef unsigned short bf16;
typedef unsigned v4u __attribute__((ext_vector_type(4)));
typedef unsigned v2u __attribute__((ext_vector_type(2)));
typedef float f32x4 __attribute__((ext_vector_type(4)));
typedef float f32x2 __attribute__((ext_vector_type(2)));
#define WSYNC() asm volatile("s_waitcnt lgkmcnt(0)" ::: "memory")

constexpr int NT = 512, NWV = 8;
constexpr int TOK = 16384, SEQ = 4096, DM = 2048, FF = 5632, NA = 6912, NB = 4096, INW = 10808;
constexpr int PA_Q = 0, PA_KV = 1024, PA_MQ = 2560, PA_MK = 3584, PA_MV = 4608, PA_MO = 5632, PA_SM = 6656;
constexpr float EPS = 1e-6f;
constexpr size_t MiB = 1u << 20;
constexpr size_t O_BIASA = 64 * 1024, O_BIASB = 128 * 1024, O_GG = 192 * 1024, O_GMX = 200 * 1024, O_DENI = 256 * 1024;
constexpr size_t O_WGU = 1 * MiB, O_WD = 45 * MiB, O_WINA = 67 * MiB, O_WINB = 94 * MiB, O_WBN = 110 * MiB, O_WBM = 114 * MiB, O_WOUT = 118 * MiB, O_WC1K = 126 * MiB, O_WC1V = 127 * MiB;
constexpr size_t O_MQK = 1 * MiB, O_HM = 1 * MiB;
constexpr size_t O_KTU = 472 * MiB;
constexpr size_t O_VTS = 67 * MiB, O_VTW = 75 * MiB, O_KCB = 83 * MiB, O_VCT = 83 * MiB + 512 * 1024;
constexpr size_t O_XN = 128 * MiB, O_PA = 192 * MiB, O_H = 192 * MiB, O_MG = 192 * MiB;
constexpr size_t O_ONSA = 408 * MiB, O_WT = 84 * MiB, O_HC = 440 * MiB, O_CBK = 408 * MiB, O_CBV = 424 * MiB, O_CHK = 65 * MiB, O_CHV = 92 * MiB;
constexpr size_t O_SM = 504 * MiB, O_KC = 508 * MiB, O_VC = 509 * MiB, O_SEL = 510 * MiB, O_GA = 510 * MiB + 512 * 1024, O_GLA = 510 * MiB + 768 * 1024, O_GPM = 511 * MiB;
constexpr size_t WS_NEED = 512 * MiB;
constexpr int LDS_BYTES = 147456;

struct Params { const float* in[28]; float* out; unsigned char* ws; int ph_lo, ph_hi; };

__device__ __forceinline__ float bf2f(unsigned short b) { return __uint_as_float(((unsigned)b) << 16); }
__device__ __forceinline__ unsigned pk2(float lo, float hi) { typedef float f2_ __attribute__((ext_vector_type(2))); typedef __bf16 b2_ __attribute__((ext_vector_type(2))); const f2_ v = {lo, hi}; return __builtin_bit_cast(unsigned, __builtin_convertvector(v, b2_)); }
__device__ __forceinline__ unsigned f2bf(float f) { return pk2(f, 0.f) & 0xffffu; }
__device__ __forceinline__ float lo16(unsigned w) { return __uint_as_float(w << 16); }
__device__ __forceinline__ float hi16(unsigned w) { return __uint_as_float(w & 0xffff0000u); }
__device__ __forceinline__ float wave_sum(float v) {
#pragma unroll
    for (int o = 1; o < 64; o <<= 1) v += __shfl_xor(v, o);
    return v;
}
__device__ __forceinline__ float wave_max(float v) {
#pragma unroll
    for (int o = 1; o < 64; o <<= 1) v = fmaxf(v, __shfl_xor(v, o));
    return v;
}
__device__ __forceinline__ float sigmf(float x) { return __builtin_amdgcn_rcpf(1.f + __builtin_amdgcn_exp2f(x * -1.4426950408889634f)); }

__device__ __forceinline__ void tr_item(const float* W, int ldw, int K, int srccol  , bf16* WT, int outrow0, const float* kscale, float* scr, int k0, int lane) {
#pragma unroll 8
    for (int i = 0; i < 32; ++i) { const int kk = 2 * i + (lane >> 5); float v = 0.f; if (srccol >= 0) v = W[(size_t)(k0 + kk) * ldw + srccol]; if (kscale) v *= kscale[k0 + kk]; scr[kk * 33 + (lane & 31)] = v; }
    WSYNC();
    const int c = lane & 7;
#pragma unroll
    for (int j = 0; j < 4; ++j) { const int n = (lane >> 3) + 8 * j; const float* s = scr + (8 * c) * 33 + n;
        v4u o; o.x = pk2(s[0 * 33], s[1 * 33]); o.y = pk2(s[2 * 33], s[3 * 33]); o.z = pk2(s[4 * 33], s[5 * 33]); o.w = pk2(s[6 * 33], s[7 * 33]);
        *(v4u*)(WT + (size_t)(outrow0 + n) * K + k0 + 8 * c) = o; }
    WSYNC();
}
__device__ __forceinline__ void tr_item64(const float* W, int ldw, int K, int srccol0, bf16* WT, int outrow0, const float* kscale, float* scr, int k0, int lane) {
    const int kr = lane >> 4, c4 = (lane & 15) * 4; f32x4 v[16];
#pragma unroll
    for (int i = 0; i < 16; ++i) v[i] = *(const f32x4*)(W + (size_t)(k0 + 4 * i + kr) * ldw + srccol0 + c4);
#pragma unroll
    for (int i = 0; i < 16; ++i) { const int k = 4 * i + kr; const float sc = kscale ? kscale[k0 + k] : 1.f; float* s = scr + k * 65 + c4; s[0] = v[i].x * sc; s[1] = v[i].y * sc; s[2] = v[i].z * sc; s[3] = v[i].w * sc; }
    WSYNC();
    const int c = lane & 7;
#pragma unroll
    for (int j = 0; j < 8; ++j) { const int n = (lane >> 3) + 8 * j; const float* s = scr + (8 * c) * 65 + n;
        v4u o; o.x = pk2(s[0 * 65], s[1 * 65]); o.y = pk2(s[2 * 65], s[3 * 65]); o.z = pk2(s[4 * 65], s[5 * 65]); o.w = pk2(s[6 * 65], s[7 * 65]);
        *(v4u*)(WT + (size_t)(outrow0 + n) * K + k0 + 8 * c) = o; }
    WSYNC();
}
__device__ __forceinline__ void tr_plain(const float* W, int K, int N, bf16* WT, const float* kscale, float* scr, int item, int lane) {
    const int nblk = N / 64, kb = item / nblk, nb = item % nblk;
    tr_item64(W, N, K, nb * 64, WT, nb * 64, kscale, scr, kb * 64, lane);
}
__device__ __forceinline__ void tr_gu(const float* Wg, const float* Wu, bf16* WT, const float* kscale, float* scr, int item, int lane) {
    const int nblk = (2 * FF) / 64, kb = item / nblk, nb = item % nblk, n0 = nb * 64, pn = n0 >> 8, within = n0 & 255;
    const float* W = (within >= 128) ? Wu : Wg;
    tr_item64(W, FF, DM, pn * 128 + (within & 127), WT, n0, kscale, scr, kb * 64, lane);
}
__device__ __forceinline__ int ina_src(int n) {
    if (n < 2560) return n;
    if (n < 5632) return n + 48;
    if (n < 6656) return 5688 + (n - 5632);
    if (n < 6704) return 2560 + (n - 6656);
    if (n < 6708) return 5680 + (n - 6704);
    if (n < 6712) return 5684 + (n - 6708);
    return -1;
}
__device__ __forceinline__ void norm_row(const float* xrow, bf16* orow, int lane) {
    const f32x4* xr = (const f32x4*)xrow + lane; f32x4 v[8]; float s = 0.f;
#pragma unroll
    for (int j = 0; j < 8; ++j) { v[j] = xr[64 * j]; s += (v[j].x * v[j].x + v[j].y * v[j].y) + (v[j].z * v[j].z + v[j].w * v[j].w); }
    const float rstd = rsqrtf(wave_sum(s) * (1.f / DM) + EPS);
    v2u* o8 = (v2u*)orow + lane;
#pragma unroll
    for (int j = 0; j < 8; ++j) { v2u w; w.x = pk2(v[j].x * rstd, v[j].y * rstd); w.y = pk2(v[j].z * rstd, v[j].w * rstd); o8[64 * j] = w; }
}

__device__ __forceinline__ void phase_prologue(const Params& P, unsigned char* lds, int gw, int ngw, int wave, int lane, int tid) {
    unsigned char* ws = P.ws; float* scr = (float*)(lds + wave * 16640);
    constexpr int I_GU = 32 * 176, I_D = 88 * 32, I_A = 32 * 108, I_B = 32 * 64, I_BN = 16 * 32, I_O = 32 * 32, I_C = 32 * 4;
    constexpr int NITEMS = I_GU + I_D + I_A + I_B + 2 * I_BN + I_O + 2 * I_C;
    for (int it = gw; it < NITEMS; it += ngw) {
        int r = it;
        if (r < I_GU) { tr_gu(P.in[2], P.in[3], (bf16*)(ws + O_WGU), P.in[1], scr, r, lane); continue; } r -= I_GU;
        if (r < I_D) { tr_plain(P.in[4], FF, DM, (bf16*)(ws + O_WD), nullptr, scr, r, lane); continue; } r -= I_D;
        if (r < I_A) { const int nblk = NA / 64, kb = r / nblk, nb = r % nblk;
            if (nb == 104) { tr_item(P.in[6], INW, DM, ina_src(6656 + (lane & 31)), (bf16*)(ws + O_WINA), 6656, P.in[5], scr, kb * 64, lane); tr_item(P.in[6], INW, DM, ina_src(6688 + (lane & 31)), (bf16*)(ws + O_WINA), 6688, P.in[5], scr, kb * 64, lane); }
            else if (nb > 104) { tr_item(P.in[6], INW, DM, -1, (bf16*)(ws + O_WINA), nb * 64, P.in[5], scr, kb * 64, lane); tr_item(P.in[6], INW, DM, -1, (bf16*)(ws + O_WINA), nb * 64 + 32, P.in[5], scr, kb * 64, lane); }
            else tr_item64(P.in[6], INW, DM, ina_src(nb * 64), (bf16*)(ws + O_WINA), nb * 64, P.in[5], scr, kb * 64, lane);
            continue; } r -= I_A;
        if (r < I_B) { const int nblk = NB / 64, kb = r / nblk, nb = r % nblk; tr_item64(P.in[6], INW, DM, 6712 + nb * 64, (bf16*)(ws + O_WINB), nb * 64, P.in[5], scr, kb * 64, lane); continue; } r -= I_B;
        if (r < I_BN) { tr_plain(P.in[21], 1024, DM, (bf16*)(ws + O_WBN), nullptr, scr, r, lane); continue; } r -= I_BN;
        if (r < I_BN) { tr_plain(P.in[22], 1024, DM, (bf16*)(ws + O_WBM), P.in[20], scr, r, lane); continue; } r -= I_BN;
        if (r < I_O) { tr_plain(P.in[23], DM, DM, (bf16*)(ws + O_WOUT), nullptr, scr, r, lane); continue; } r -= I_O;
        if (r < I_C) { tr_plain(P.in[13], 2048, 256, (bf16*)(ws + O_WC1K), nullptr, scr, r, lane); continue; } r -= I_C;
        tr_plain(P.in[16], 2048, 256, (bf16*)(ws + O_WC1V), nullptr, scr, r, lane);
    }
    { const int gt = gw * 64 + lane, ngt = ngw * 64; float* ba = (float*)(ws + O_BIASA); float* bb = (float*)(ws + O_BIASB);
      for (int n = gt; n < NA; n += ngt) { const int s = ina_src(n); ba[n] = s >= 0 ? P.in[7][s] : 0.f; }
      for (int n = gt; n < NB; n += ngt) bb[n] = P.in[7][6712 + n]; }
    for (int m = gw; m < TOK; m += ngw) norm_row(P.in[0] + (size_t)m * DM, (bf16*)(ws + O_XN) + (size_t)m * DM, lane);
}
__device__ __forceinline__ void phase_norm(const float* src, bf16* dst, int gw, int ngw, int lane) {
    for (int m = gw; m < TOK; m += ngw) norm_row(src + (size_t)m * DM, dst + (size_t)m * DM, lane);
}
__device__ __forceinline__ void phase_conv_ffn2(const Params& P, unsigned char* lds, int gw, int ngw, int wave, int lane) {
    float* scr = (float*)(lds + wave * 16640);
    constexpr int I_GU = 32 * 176, I_D = 88 * 32;
    for (int it = gw; it < I_GU + I_D; it += ngw) {
        if (it < I_GU) tr_gu(P.in[25], P.in[26], (bf16*)(P.ws + O_WGU), P.in[24], scr, it, lane);
        else tr_plain(P.in[27], FF, DM, (bf16*)(P.ws + O_WD), nullptr, scr, it - I_GU, lane);
    }
}

__device__ __forceinline__ void phase_prep(const Params& P, int gw, int ngw, int lane) {
    unsigned char* ws = P.ws; bf16* PA = (bf16*)(ws + O_PA);
    { const float qg = P.in[8][lane] * (0.125f * 1.4426950408889634f), ksg = P.in[10][lane], kwg = P.in[11][lane];
      for (int m = gw; m < TOK; m += ngw) { bf16* pr = PA + (size_t)m * NA; float x[24];
#pragma unroll
        for (int v = 0; v < 24; ++v) { const int col = (v < 16) ? (PA_Q + v * 64) : (v < 20 ? (PA_KV + 2 * 256 + (v - 16) * 64) : (PA_KV + 4 * 256 + (v - 20) * 64)); x[v] = bf2f(pr[col + lane]); }
#pragma unroll
        for (int v = 0; v < 24; ++v) { const int col = (v < 16) ? (PA_Q + v * 64) : (v < 20 ? (PA_KV + 2 * 256 + (v - 16) * 64) : (PA_KV + 4 * 256 + (v - 20) * 64));
            const float gn = (v < 16) ? qg : (v < 20 ? ksg : kwg); const float ss = wave_sum(x[v] * x[v]); pr[col + lane] = (bf16)f2bf(x[v] * rsqrtf(ss * (1.f / 64.f) + EPS) * gn); } } }
    { const size_t gt = (size_t)gw * 64 + lane, ngt = (size_t)ngw * 64; bf16* CBK = (bf16*)(ws + O_CBK); bf16* CBV = (bf16*)(ws + O_CBV);
      const int k8 = (int)(gt & 255) * 8, l = k8 >> 6, d = k8 & 63; float pk[8], pv[8];
#pragma unroll
      for (int i = 0; i < 8; ++i) { pk[i] = P.in[12][l * 64 + d + i]; pv[i] = P.in[15][l * 64 + d + i]; }
      for (size_t idx = gt; idx < (size_t)4096 * 256; idx += ngt) { const int r = (int)(idx >> 8);
        v4u ok = (v4u){0u, 0u, 0u, 0u}, ov = ok;
        if (r < 4080) { const int bg = r / 255, c = r % 255, b = bg >> 2, g = bg & 3; const bf16* src = PA + ((size_t)b * SEQ + 16 * c + l) * NA + PA_KV + g * 64 + d;
            const v4u kw = *(const v4u*)src, vw = *(const v4u*)(src + 256);
            ok.x = pk2(lo16(kw.x) + pk[0], hi16(kw.x) + pk[1]); ok.y = pk2(lo16(kw.y) + pk[2], hi16(kw.y) + pk[3]); ok.z = pk2(lo16(kw.z) + pk[4], hi16(kw.z) + pk[5]); ok.w = pk2(lo16(kw.w) + pk[6], hi16(kw.w) + pk[7]);
            ov.x = pk2(lo16(vw.x) + pv[0], hi16(vw.x) + pv[1]); ov.y = pk2(lo16(vw.y) + pv[2], hi16(vw.y) + pv[3]); ov.z = pk2(lo16(vw.z) + pv[4], hi16(vw.z) + pv[5]); ov.w = pk2(lo16(vw.w) + pv[6], hi16(vw.w) + pv[7]); }
        *(v4u*)(CBK + (size_t)r * 2048 + k8) = ok; *(v4u*)(CBV + (size_t)r * 2048 + k8) = ov; } }
    { const size_t gt = (size_t)gw * 64 + lane, ngt = (size_t)ngw * 64; bf16* MQK = (bf16*)(ws + O_MQK); const float* cw = P.in[18]; const float* cb = P.in[19];
      const int c8 = (int)(gt & 255) * 8; float wt[4][8], bs[8];
#pragma unroll
      for (int i = 0; i < 8; ++i) { bs[i] = cb[c8 + i];
#pragma unroll
          for (int j = 0; j < 4; ++j) wt[j][i] = cw[j * 2048 + c8 + i]; }
#pragma unroll 2
      for (size_t idx = gt; idx < (size_t)TOK * 256; idx += ngt) { const int m = (int)(idx >> 8), t = m & (SEQ - 1);
        float a[8]; v4u w[4];
#pragma unroll
        for (int j = 0; j < 4; ++j) { const int mm = (t - 3 + j >= 0) ? (m - 3 + j) : m; w[j] = *(const v4u*)(PA + (size_t)mm * NA + PA_MQ + c8); }
#pragma unroll
        for (int i = 0; i < 8; ++i) a[i] = bs[i];
#pragma unroll
        for (int j = 0; j < 4; ++j) { const float z = (t - 3 + j >= 0) ? 1.f : 0.f;
            a[0] += wt[j][0] * z * lo16(w[j].x); a[1] += wt[j][1] * z * hi16(w[j].x); a[2] += wt[j][2] * z * lo16(w[j].y); a[3] += wt[j][3] * z * hi16(w[j].y);
            a[4] += wt[j][4] * z * lo16(w[j].z); a[5] += wt[j][5] * z * hi16(w[j].z); a[6] += wt[j][6] * z * lo16(w[j].w); a[7] += wt[j][7] * z * hi16(w[j].w); }
#pragma unroll
        for (int i = 0; i < 8; ++i) a[i] = a[i] * sigmf(a[i]);
        v4u o; o.x = pk2(a[0], a[1]); o.y = pk2(a[2], a[3]); o.z = pk2(a[4], a[5]); o.w = pk2(a[6], a[7]);
        *(v4u*)(MQK + (size_t)m * 2048 + c8) = o; } }
    { const bf16* PAc = (const bf16*)(ws + O_PA);
      for (int it = gw; it < 2048; it += ngw) { const int j = it & 1, g = (it >> 1) & 3, tb = (it >> 3) & 63, b = it >> 9; const int bg = b * 4 + g;
        const bf16* src = PAc + ((size_t)b * SEQ + 64 * tb + lane) * NA + PA_KV + (j ? 5 : 3) * 256 + g * 64; bf16* dst = (bf16*)(ws + (j ? O_VTW : O_VTS)) + (size_t)bg * 64 * SEQ + (size_t)tb * 4096 + lane;
#pragma unroll
        for (int d8 = 0; d8 < 8; ++d8) { const v4u w = *(const v4u*)(src + 8 * d8);
            dst[(size_t)(8 * d8 + 0) * 64] = (bf16)(w.x & 0xffffu); dst[(size_t)(8 * d8 + 1) * 64] = (bf16)(w.x >> 16); dst[(size_t)(8 * d8 + 2) * 64] = (bf16)(w.y & 0xffffu); dst[(size_t)(8 * d8 + 3) * 64] = (bf16)(w.y >> 16);
            dst[(size_t)(8 * d8 + 4) * 64] = (bf16)(w.z & 0xffffu); dst[(size_t)(8 * d8 + 5) * 64] = (bf16)(w.z >> 16); dst[(size_t)(8 * d8 + 6) * 64] = (bf16)(w.w & 0xffffu); dst[(size_t)(8 * d8 + 7) * 64] = (bf16)(w.w >> 16); } } }
    { const float* SM = (const float*)(ws + O_SM); float* GA = (float*)(ws + O_GA); float* GLA = (float*)(ws + O_GLA); float* GPM = (float*)(ws + O_GPM); float* GG = (float*)(ws + O_GG); float* GMX = (float*)(ws + O_GMX);
      for (int it = gw; it < 1024; it += ngw) { const int bh = it >> 6, c = it & 63, b = bh >> 2, h = bh & 3; const size_t m = (size_t)b * SEQ + 64 * c + lane;
        const float ip = SM[m * 64 + 48 + h], fp = SM[m * 64 + 52 + h];
        const float lf = fminf(fp, 0.f) - log1pf(__expf(-fabsf(fp)));
        float a = lf;
#pragma unroll
        for (int o = 1; o < 64; o <<= 1) { const float y = __shfl_up(a, o); if (lane >= o) a += y; }
        const float g = __shfl(a, 63); const float la = ip - a; const float mx = wave_max(g + la);
        float pm = la;
#pragma unroll
        for (int o = 1; o < 64; o <<= 1) { const float y = __shfl_up(pm, o); if (lane >= o) pm = fmaxf(pm, y); }
        const size_t o1 = (size_t)bh * SEQ + 64 * c + lane; GA[o1] = a; GLA[o1] = la; GPM[o1] = a + pm;
        if (lane == 0) { GG[it] = g; GMX[it] = mx; } } }
    for (int it = gw; it < 16; it += ngw) { ((bf16*)(ws + O_KCB))[((size_t)it * 256 + 255) * 64 + lane] = 0; ((bf16*)(ws + O_VCT))[((size_t)it * 64 + lane) * 256 + 255] = 0; }
}

typedef short cbf16x8 __attribute__((ext_vector_type(8)));
__device__ __forceinline__ void cmp2_block(const Params& P, unsigned char* lds, int pm, int kv, int tid) {
    unsigned char* ws = P.ws; const int lane = tid & 63, wave = __builtin_amdgcn_readfirstlane(tid >> 6), m16 = lane & 15, quad = lane >> 4;
    bf16* W2T = (bf16*)lds;
    {
        const float* w2 = P.in[kv ? 17 : 14]; const bf16* CH = (const bf16*)(ws + (kv ? O_CHV : O_CHK));
        __syncthreads();
#pragma unroll 8
        for (int i = 0; i < 32; ++i) { const int idx = i * NT + tid, hh = idx >> 6, j = idx & 63; W2T[j * 264 + hh] = (bf16)f2bf(w2[idx]); }
        __syncthreads();
#pragma unroll 1
        for (int mi = 0; mi < 2; ++mi) { const int mt = 2 * wave + mi; const int rbase = 256 * pm + 16 * mt;
            cbf16x8 af[8];
#pragma unroll
            for (int kk = 0; kk < 8; ++kk) af[kk] = *(const cbf16x8*)(CH + (size_t)(rbase + m16) * 256 + 32 * kk + 8 * quad);
            f32x4 acc[4];
#pragma unroll
            for (int nt = 0; nt < 4; ++nt) acc[nt] = (f32x4){0.f, 0.f, 0.f, 0.f};
#pragma unroll
            for (int kk = 0; kk < 8; ++kk)
#pragma unroll
                for (int nt = 0; nt < 4; ++nt) { const cbf16x8 bfr = *(const cbf16x8*)(W2T + (16 * nt + m16) * 264 + 32 * kk + 8 * quad); acc[nt] = __builtin_amdgcn_mfma_f32_16x16x32_bf16(af[kk], bfr, acc[nt], 0, 0, 0); }
#pragma unroll
            for (int i = 0; i < 4; ++i) { const int r = rbase + 4 * quad + i; float ss = acc[0][i] * acc[0][i] + acc[1][i] * acc[1][i] + acc[2][i] * acc[2][i] + acc[3][i] * acc[3][i];
                ss += __shfl_xor(ss, 1); ss += __shfl_xor(ss, 2); ss += __shfl_xor(ss, 4); ss += __shfl_xor(ss, 8);
                if (r < 4080) { const int bg = r / 255, c = r % 255;
                    if (kv == 0) { const float rstd = rsqrtf(ss * (1.f / 64.f) + EPS);
#pragma unroll
                        for (int nt = 0; nt < 4; ++nt) { const int j = 16 * nt + m16; ((bf16*)(ws + O_KCB))[((size_t)bg * 256 + c) * 64 + j] = (bf16)f2bf(acc[nt][i] * rstd * P.in[9][j]); } }
                    else {
#pragma unroll
                        for (int nt = 0; nt < 4; ++nt) { const int j = 16 * nt + m16; ((bf16*)(ws + O_VCT))[((size_t)bg * 64 + j) * 256 + c] = (bf16)f2bf(acc[nt][i]); } } } }
        }
    }
    __syncthreads();
}

constexpr int SCAN_N1 = 9, SCAN_NFLAG = SCAN_N1 + 1;
__device__ __forceinline__ void mlstm_intra_item(const Params& P, unsigned char* lds, int it, int tid) {
    unsigned char* ws = P.ws; const int bh = it >> 6, c = it & 63, b = bh >> 2, h = bh & 3;
    const int lane = tid & 63, wave = __builtin_amdgcn_readfirstlane(tid >> 6), m16 = lane & 15, quad = lane >> 4, jt = wave >> 1, sh = wave & 1;
    float* PART = (float*)lds;
    const bf16* MQK = (const bf16*)(ws + O_MQK); const size_t row0 = (size_t)b * SEQ + 64 * c;
    cbf16x8 qf[8], kf[2][8];
    { const bf16* qp = MQK + (row0 + 16 * jt + m16) * 2048 + h * 256 + 8 * quad;
#pragma unroll
      for (int kk = 0; kk < 8; ++kk) qf[kk] = *(const cbf16x8*)(qp + 32 * kk);
#pragma unroll
      for (int t2 = 0; t2 < 2; ++t2) { const bf16* kp = MQK + (row0 + 16 * (2 * sh + t2) + m16) * 2048 + 1024 + h * 256 + 8 * quad;
#pragma unroll
          for (int kk = 0; kk < 8; ++kk) kf[t2][kk] = *(const cbf16x8*)(kp + 32 * kk); } }
    const size_t o1 = (size_t)bh * SEQ + 64 * c;
    const float* GA = (const float*)(ws + O_GA) + o1; const float* GLA = (const float*)(ws + O_GLA) + o1; const float* GPM = (const float*)(ws + O_GPM) + o1;
    float aj[4], mij[4], las[2];
#pragma unroll
    for (int i = 0; i < 4; ++i) { aj[i] = GA[16 * jt + 4 * quad + i]; mij[i] = GPM[16 * jt + 4 * quad + i]; }
#pragma unroll
    for (int t2 = 0; t2 < 2; ++t2) las[t2] = GLA[16 * (2 * sh + t2) + m16];
    float mprev = 0.f; { const float* GG = (const float*)(ws + O_GG) + bh * 64; const float* GMX = (const float*)(ws + O_GMX) + bh * 64; for (int cc = 0; cc < c; ++cc) mprev = fmaxf(GG[cc] + mprev, GMX[cc]); }
    f32x4 acc[2];
#pragma unroll
    for (int t2 = 0; t2 < 2; ++t2) { acc[t2] = (f32x4){0.f, 0.f, 0.f, 0.f};
#pragma unroll
        for (int kk = 0; kk < 8; ++kk) acc[t2] = __builtin_amdgcn_mfma_f32_16x16x32_bf16(qf[kk], kf[t2][kk], acc[t2], 0, 0, 0); }
    if (jt == 0) {
        const float g = ((const float*)(ws + O_GG))[bh * 64 + c], mnew = fmaxf(g + mprev, ((const float*)(ws + O_GMX))[bh * 64 + c]);
        bf16* KU = (bf16*)(ws + O_KTU) + (size_t)it * 16384;
#pragma unroll
        for (int t2 = 0; t2 < 2; ++t2) { const int s = 16 * (2 * sh + t2) + m16; const float us = __expf(g + las[t2] - mnew) * 0.0625f;
#pragma unroll
            for (int kk = 0; kk < 8; ++kk) { const cbf16x8 kv = kf[t2][kk];
#pragma unroll
                for (int i = 0; i < 8; ++i) KU[(size_t)(32 * kk + 8 * quad + i) * 64 + s] = (bf16)f2bf(bf2f((unsigned short)kv[i]) * us); } } }
    bf16* WT = (bf16*)(ws + O_WT) + (size_t)it * 4096;
    __syncthreads();
#pragma unroll
    for (int i = 0; i < 4; ++i) { const int j = 16 * jt + 4 * quad + i; const float mc = fmaxf(aj[i] + mprev, mij[i]); float rs = 0.f;
#pragma unroll
        for (int t2 = 0; t2 < 2; ++t2) { const int s = 16 * (2 * sh + t2) + m16; const float w = (s <= j) ? __expf(aj[i] + las[t2] - mc) * acc[t2][i] * 0.0625f : 0.f; WT[j * 64 + s] = (bf16)f2bf(w); rs += w; }
        rs += __shfl_xor(rs, 1); rs += __shfl_xor(rs, 2); rs += __shfl_xor(rs, 4); rs += __shfl_xor(rs, 8);
        if (m16 == 0) PART[sh * 64 + j] = rs; }
    __syncthreads();
    if (tid < 64) ((float*)(ws + O_DENI))[o1 + tid] = PART[tid] + PART[64 + tid];
    if (c < SCAN_NFLAG) {
        asm volatile("s_waitcnt vmcnt(0)" ::: "memory"); __syncthreads();
        if (tid == 0) { __builtin_amdgcn_fence(__ATOMIC_RELEASE, "agent"); asm volatile("s_waitcnt vmcnt(0)" ::: "memory");
            __hip_atomic_store((unsigned*)ws + 3700 + bh * 16 + c, 1u, __ATOMIC_RELAXED, __HIP_MEMORY_SCOPE_AGENT); } }
}

typedef short sbf16x8 __attribute__((ext_vector_type(8)));
#define LBAR() asm volatile("s_waitcnt lgkmcnt(0)\n\ts_barrier" ::: "memory")
__device__ __forceinline__ unsigned cvtpk2(float lo, float hi) { typedef float f2_ __attribute__((ext_vector_type(2))); typedef __bf16 b2_ __attribute__((ext_vector_type(2))); const f2_ v = {lo, hi}; return __builtin_bit_cast(unsigned, __builtin_convertvector(v, b2_)); }
constexpr int SC_QL = 0, SC_KT = 33792, SC_VT = 70656, SC_WB = 89088, SC_NL = 98304, SC_RS = 100352, SC_OUT = 101376;
struct ScanState { f32x4 acc[16]; float mst, gnx, mxnx, pla, pa, pmi, pdn; v4u pq[4], pk[4], pv[2], pw; };
__device__ __forceinline__ void scan_wait_flag(const Params& P, int bh, int c, int tid) {
    if (tid == 0) { unsigned* f = (unsigned*)P.ws + 3700 + bh * 16 + c; unsigned sp = 0;
        while (__hip_atomic_load(f, __ATOMIC_RELAXED, __HIP_MEMORY_SCOPE_AGENT) == 0u && ++sp < (1u << 22)) __builtin_amdgcn_s_sleep(2);
        __builtin_amdgcn_fence(__ATOMIC_ACQUIRE, "agent"); asm volatile("s_waitcnt vmcnt(0)" ::: "memory"); }
    __syncthreads();
}
__device__ __forceinline__ void mlstm_scan_item(const Params& P, unsigned char* lds, int it, int tid, ScanState& S, int c0, int c1) {
    unsigned char* ws = P.ws; const int bh = it >> 1, eh = it & 1, b = bh >> 2, h = bh & 3;
    const int lane = tid & 63, wave = __builtin_amdgcn_readfirstlane(tid >> 6);
    bf16* QL = (bf16*)(lds + SC_QL); bf16* KT = (bf16*)(lds + SC_KT); bf16* VT = (bf16*)(lds + SC_VT); bf16* WB = (bf16*)(lds + SC_WB); float* NL = (float*)(lds + SC_NL); float* RS = (float*)(lds + SC_RS); float* RD = RS + 64; bf16* OUTL = (bf16*)(lds + SC_OUT);
    const bf16* MQK = (const bf16*)(ws + O_MQK); const bf16* PA = (const bf16*)(ws + O_PA); const bf16* WT = (const bf16*)(ws + O_WT); bf16* HC = (bf16*)(ws + O_HC); const bf16* KTU = (const bf16*)(ws + O_KTU) + (size_t)(bh * 64) * 16384;
    const float* GG = (const float*)(ws + O_GG) + bh * 64; const float* GMX = (const float*)(ws + O_GMX) + bh * 64;
    const float* GA = (const float*)(ws + O_GA) + (size_t)bh * SEQ; const float* GLA = (const float*)(ws + O_GLA) + (size_t)bh * SEQ; const float* GPM = (const float*)(ws + O_GPM) + (size_t)bh * SEQ; const float* DENI = (const float*)(ws + O_DENI) + (size_t)bh * SEQ;
    f32x4 (&acc)[16] = S.acc; float& mst = S.mst;
    if (c0 == 0) {
#pragma unroll
        for (int i = 0; i < 16; ++i) acc[i] = (f32x4){0.f, 0.f, 0.f, 0.f};
        mst = 0.f; }
    v4u (&pq)[4] = S.pq; v4u (&pk)[4] = S.pk; v4u (&pv)[2] = S.pv; v4u& pw = S.pw; float& pla = S.pla; float& pa = S.pa; float& pmi = S.pmi; float& pdn = S.pdn; float& gnx = S.gnx; float& mxnx = S.mxnx;
    if (c0 == 0) {
    __syncthreads();
    if (tid < 256) { NL[tid] = 0.f; NL[256 + tid] = 0.f; }
    scan_wait_flag(P, bh, 0, tid);
    { const size_t row0 = (size_t)b * SEQ; const int ts = tid & 63, tc = tid >> 6, qr_ = tid >> 5, qc8 = (tid & 31) * 8, wr_ = tid >> 3, wc8 = (tid & 7) * 8, dj = tid >> 3;
#pragma unroll
      for (int p = 0; p < 4; ++p) { pq[p] = *(const v4u*)(MQK + (row0 + 16 * p + qr_) * 2048 + h * 256 + qc8); pk[p] = *(const v4u*)(KTU + (size_t)(p * NT + tid) * 8); }
#pragma unroll
      for (int p = 0; p < 2; ++p) pv[p] = *(const v4u*)(PA + (row0 + ts) * NA + PA_MV + h * 256 + eh * 128 + (tc + 8 * p) * 8);
      pw = *(const v4u*)(WT + (size_t)(bh * 64) * 4096 + wr_ * 64 + wc8);
      pla = GLA[ts]; pa = GA[dj]; pmi = GPM[dj]; pdn = DENI[dj]; }
    gnx = GG[0]; mxnx = GMX[0]; }
    for (int c = c0; c < c1; ++c) {
        const size_t row0 = (size_t)b * SEQ + 64 * c;
        const float g = gnx, mx = mxnx; const float mnew = fmaxf(g + mst, mx); const float dec = __expf(g + mst - mnew);
        const float mc = fmaxf(pa + mst, pmi); const float si = __expf(pa + mst - mc), emc = __expf(-mc), dni = pdn;
        const int cur = c & 1;
        int lane_o = lane, tid_o = tid; asm volatile("" : "+v"(lane_o), "+v"(tid_o)); const int m16 = lane_o & 15, quad = lane_o >> 4;
        const int ts = tid_o & 63, tc = tid_o >> 6, qr_ = tid_o >> 5, qc8 = (tid_o & 31) * 8, wr_ = tid_o >> 3, wc8 = (tid_o & 7) * 8, dj = tid_o >> 3, dpart = tid_o & 7; const int tid = tid_o;
        LBAR();
        if (c > 0) {
#pragma unroll
            for (int p = 0; p < 2; ++p) { const int idx = p * NT + tid, j = idx >> 4, c8 = (idx & 15) * 8; *(v4u*)(HC + (row0 - 64 + j) * 1024 + h * 256 + eh * 128 + c8) = *(const v4u*)(OUTL + j * 136 + c8); } }
#pragma unroll
        for (int p = 0; p < 4; ++p) { *(v4u*)(QL + (16 * p + qr_) * 264 + qc8) = pq[p];
            { const int idx = p * NT + tid; *(v4u*)(KT + (idx >> 3) * 72 + (idx & 7) * 8) = pk[p]; } }
#pragma unroll
        for (int p = 0; p < 2; ++p) { bf16* vd = VT + (size_t)((tc + 8 * p) * 8) * 72 + ts; const v4u w = pv[p];
            vd[0 * 72] = (bf16)(w.x & 0xffffu); vd[1 * 72] = (bf16)(w.x >> 16); vd[2 * 72] = (bf16)(w.y & 0xffffu); vd[3 * 72] = (bf16)(w.y >> 16);
            vd[4 * 72] = (bf16)(w.z & 0xffffu); vd[5 * 72] = (bf16)(w.z >> 16); vd[6 * 72] = (bf16)(w.w & 0xffffu); vd[7 * 72] = (bf16)(w.w >> 16); }
        *(v4u*)(WB + wr_ * 72 + wc8) = pw;
        LBAR();
        if (c + 1 < SCAN_NFLAG && c1 < 64) scan_wait_flag(P, bh, c + 1, tid);
        if (c + 1 < 64) { const size_t r1 = row0 + 64;
#pragma unroll
            for (int p = 0; p < 4; ++p) { pq[p] = *(const v4u*)(MQK + (r1 + 16 * p + qr_) * 2048 + h * 256 + qc8); pk[p] = *(const v4u*)(KTU + (size_t)(c + 1) * 16384 + (size_t)(p * NT + tid) * 8); }
#pragma unroll
            for (int p = 0; p < 2; ++p) pv[p] = *(const v4u*)(PA + (r1 + ts) * NA + PA_MV + h * 256 + eh * 128 + (tc + 8 * p) * 8);
            pw = *(const v4u*)(WT + (size_t)(bh * 64 + c + 1) * 4096 + wr_ * 64 + wc8);
            gnx = GG[c + 1]; mxnx = GMX[c + 1]; pla = GLA[64 * (c + 1) + ts]; pa = GA[64 * (c + 1) + dj]; pmi = GPM[64 * (c + 1) + dj]; pdn = DENI[64 * (c + 1) + dj]; }
        { const float* ncur = NL + cur * 256; float dn = 0.f;
#pragma unroll
          for (int d8 = 0; d8 < 32; d8 += 8) { const v4u qw = *(const v4u*)(QL + dj * 264 + dpart * 32 + d8); const float* np = ncur + dpart * 32 + d8;
              dn += lo16(qw.x) * np[0] + hi16(qw.x) * np[1] + lo16(qw.y) * np[2] + hi16(qw.y) * np[3] + lo16(qw.z) * np[4] + hi16(qw.z) * np[5] + lo16(qw.w) * np[6] + hi16(qw.w) * np[7]; }
          dn += __shfl_xor(dn, 1); dn += __shfl_xor(dn, 2); dn += __shfl_xor(dn, 4);
          if (dpart == 0) { RS[dj] = si; RD[dj] = 1.f / fmaxf(fabsf(si * dn + dni), emc); }
          if (tid < 256) { float ks = 0.f;
#pragma unroll
              for (int s8 = 0; s8 < 64; s8 += 8) { const v4u kw = *(const v4u*)(KT + tid * 72 + s8); ks += (lo16(kw.x) + hi16(kw.x)) + (lo16(kw.y) + hi16(kw.y)) + (lo16(kw.z) + hi16(kw.z)) + (lo16(kw.w) + hi16(kw.w)); }
              NL[(cur ^ 1) * 256 + tid] = dec * ncur[tid] + ks; } }
        f32x4 oi[4], oa[4];
#pragma unroll
        for (int jt = 0; jt < 4; ++jt) { oi[jt] = (f32x4){0.f, 0.f, 0.f, 0.f}; oa[jt] = (f32x4){0.f, 0.f, 0.f, 0.f}; }
        sbf16x8 vfr[2]; sbf16x8 wfr[4][2];
#pragma unroll
        for (int ks = 0; ks < 2; ++ks) vfr[ks] = *(const sbf16x8*)(VT + (16 * wave + m16) * 72 + 32 * ks + 8 * quad);
#pragma unroll
        for (int jt = 0; jt < 4; ++jt)
#pragma unroll
            for (int ks = 0; ks < 2; ++ks) wfr[jt][ks] = *(const sbf16x8*)(WB + (16 * jt + m16) * 72 + 32 * ks + 8 * quad);
        asm volatile("" ::: "memory");
#pragma unroll
        for (int jt = 0; jt < 4; ++jt)
#pragma unroll
            for (int ks = 0; ks < 2; ++ks) oa[jt] = __builtin_amdgcn_mfma_f32_16x16x32_bf16(wfr[jt][ks], vfr[ks], oa[jt], 0, 0, 0);
        v2u qa[2][4][2];
#pragma unroll
        for (int jt = 0; jt < 4; ++jt) { const bf16* qp = QL + (16 * jt + m16) * 264 + 4 * quad; qa[0][jt][0] = *(const v2u*)qp; qa[0][jt][1] = *(const v2u*)(qp + 16); }
        asm volatile("" ::: "memory");
#pragma unroll
        for (int kk = 0; kk < 8; ++kk) {
            if (kk + 1 < 8) {
#pragma unroll
                for (int jt = 0; jt < 4; ++jt) { const bf16* qp = QL + (16 * jt + m16) * 264 + 32 * (kk + 1) + 4 * quad; qa[(kk + 1) & 1][jt][0] = *(const v2u*)qp; qa[(kk + 1) & 1][jt][1] = *(const v2u*)(qp + 16); }
                asm volatile("" ::: "memory");
            }
            v4u cw; cw.x = cvtpk2(acc[2 * kk][0], acc[2 * kk][1]); cw.y = cvtpk2(acc[2 * kk][2], acc[2 * kk][3]); cw.z = cvtpk2(acc[2 * kk + 1][0], acc[2 * kk + 1][1]); cw.w = cvtpk2(acc[2 * kk + 1][2], acc[2 * kk + 1][3]);
            const sbf16x8 bfr = __builtin_bit_cast(sbf16x8, cw);
#pragma unroll
            for (int jt = 0; jt < 4; ++jt) { const v4u aw = (v4u){qa[kk & 1][jt][0].x, qa[kk & 1][jt][0].y, qa[kk & 1][jt][1].x, qa[kk & 1][jt][1].y};
                oi[jt] = __builtin_amdgcn_mfma_f32_16x16x32_bf16(__builtin_bit_cast(sbf16x8, aw), bfr, oi[jt], 0, 0, 0); } }
        LBAR();
        { bf16* hp = OUTL + (4 * quad) * 136 + 16 * wave + m16; f32x4 rs4[4], rd4[4];
#pragma unroll
          for (int jt = 0; jt < 4; ++jt) { rs4[jt] = *(const f32x4*)(RS + 16 * jt + 4 * quad); rd4[jt] = *(const f32x4*)(RD + 16 * jt + 4 * quad); }
#pragma unroll
          for (int jt = 0; jt < 4; ++jt)
#pragma unroll
              for (int i = 0; i < 4; ++i) hp[(16 * jt + i) * 136] = (bf16)f2bf((rs4[jt][i] * oi[jt][i] + oa[jt][i]) * rd4[jt][i]); }
        { sbf16x8 kfa[4], kfb[4];
#pragma unroll
          for (int i = 0; i < 4; ++i) kfa[i] = *(const sbf16x8*)(KT + (16 * (i >> 1) + m16) * 72 + 32 * (i & 1) + 8 * quad);
          asm volatile("" ::: "memory");
#pragma unroll
          for (int db = 0; db < 8; ++db) {
            if (db + 1 < 8) {
#pragma unroll
                for (int i = 0; i < 4; ++i) kfb[i] = *(const sbf16x8*)(KT + (16 * (2 * (db + 1) + (i >> 1)) + m16) * 72 + 32 * (i & 1) + 8 * quad);
                asm volatile("" ::: "memory");
            }
#pragma unroll
            for (int i = 0; i < 2; ++i) { const int dt = 2 * db + i; acc[dt] = acc[dt] * dec;
                acc[dt] = __builtin_amdgcn_mfma_f32_16x16x32_bf16(kfa[2 * i], vfr[0], acc[dt], 0, 0, 0); acc[dt] = __builtin_amdgcn_mfma_f32_16x16x32_bf16(kfa[2 * i + 1], vfr[1], acc[dt], 0, 0, 0); }
            if (db + 1 < 8) {
#pragma unroll
                for (int i = 0; i < 4; ++i) kfa[i] = kfb[i];
            }
          } }
        mst = mnew;
    }
    if (c1 == 64) { LBAR();
    { const size_t rowl = (size_t)b * SEQ + 64 * 63;
#pragma unroll
      for (int p = 0; p < 2; ++p) { const int idx = p * NT + tid, j = idx >> 4, c8 = (idx & 15) * 8; *(v4u*)(HC + (rowl + j) * 1024 + h * 256 + eh * 128 + c8) = *(const v4u*)(OUTL + j * 136 + c8); } }
}
}
#define GAS __attribute__((address_space(1)))
typedef GAS unsigned gu32;
typedef GAS unsigned long long gu64;
#define RLX_AGENT __ATOMIC_RELAXED, __HIP_MEMORY_SCOPE_AGENT
#define LDS_WAIT() asm volatile("s_waitcnt lgkmcnt(0)" ::: "memory")
#define VM_WAIT() asm volatile("s_waitcnt vmcnt(0)" ::: "memory")
__device__ __forceinline__ unsigned long long rt() { return __builtin_amdgcn_s_memrealtime(); }
#define XB_TMO      128
#define XB_XCNT(j)  (256  + 64 * (j))
#define XB_XSUB(j)  (1280 + 64 * (j))
#define XB_XGEN(j)  (2304 + 64 * (j))
#define XB_TOP      3328
#define XB_TOPGEN   3392
#define XCD_BAR_WORDS 3456
#define XB_SPIN_CAP (1u << 18)

__device__ __forceinline__ unsigned xb_ld(unsigned* p)              { return __hip_atomic_load(p, __ATOMIC_RELAXED, __HIP_MEMORY_SCOPE_AGENT); }
__device__ __forceinline__ unsigned xb_add(unsigned* p, unsigned v) { return __hip_atomic_fetch_add(p, v, __ATOMIC_RELAXED, __HIP_MEMORY_SCOPE_AGENT); }
__device__ __forceinline__ unsigned xb_xcc_id() { return (unsigned)__builtin_amdgcn_s_getreg((3 << 11) | 20) & 0xFu; }
#define XB_SPIN(cond, bar) do { unsigned _sp = 0; while (cond) { __builtin_amdgcn_s_sleep(1); \
    if ((++_sp & 255u) == 0u) { if (xb_ld(&(bar)[XB_TMO])) break; if (_sp > XB_SPIN_CAP) { atomicAdd(&(bar)[XB_TMO], 1u); break; } } } } while (0)

struct XcdBarrier {
    unsigned* bar; unsigned x;
    volatile LAS unsigned* st;
};

__device__ __forceinline__ XcdBarrier xcd_barrier_post(unsigned* bar, volatile LAS unsigned* st) {
    XcdBarrier b; b.bar = bar; b.x = xb_xcc_id(); b.st = st;
    if (threadIdx.x == 0) (void)xb_add(&bar[XB_XCNT(b.x)], 1u);
    return b;
}
__device__ __forceinline__ void xcd_barrier_complete(unsigned* bar, unsigned x, unsigned& nloc, unsigned& nx) {
    const unsigned G = gridDim.x * gridDim.y * gridDim.z;
    unsigned sum, cnt, mine, sp = 0u;
    for (;;) {
        sum = 0u; cnt = 0u; mine = 0u;
#pragma unroll
        for (unsigned j = 0; j < 16; ++j) { const unsigned c = xb_ld(&bar[XB_XCNT(j)]); sum += c; cnt += (c > 0u) ? 1u : 0u; mine = (j == x) ? c : mine; }
        if (sum == G) break;
        __builtin_amdgcn_s_sleep(1);
        if ((++sp & 255u) == 0u) { if (xb_ld(&bar[XB_TMO])) break; if (sp > XB_SPIN_CAP) { atomicAdd(&bar[XB_TMO], 1u); break; } }
    }
    nloc = mine > 0u ? mine : 1u; nx = cnt > 0u ? cnt : 1u;
}

__device__ __forceinline__ void xcd_barrier(const XcdBarrier& b) {
    asm volatile("s_waitcnt vmcnt(0)" ::: "memory");
    __syncthreads();
    if (threadIdx.x == 0) {
        unsigned* bar = b.bar;
        __builtin_amdgcn_s_waitcnt(0);
        unsigned nloc = b.st[0], nx = b.st[1];
        if (nloc == 0u) { xcd_barrier_complete(bar, b.x, nloc, nx); b.st[0] = nloc; b.st[1] = nx; }
        const unsigned old = xb_add(&bar[XB_XSUB(b.x)], 1u);
        const unsigned gen = old / nloc;
        if (old + 1u == (gen + 1u) * nloc) {
            __builtin_amdgcn_fence(__ATOMIC_RELEASE, "agent");
            asm volatile("s_waitcnt vmcnt(0)" ::: "memory");
            const unsigned og = xb_add(&bar[XB_TOP], 1u);
            const unsigned tg = og / nx;
            if (og + 1u == (tg + 1u) * nx) xb_add(&bar[XB_TOPGEN], 1u);
            else XB_SPIN(xb_ld(&bar[XB_TOPGEN]) == tg, bar);
            __builtin_amdgcn_fence(__ATOMIC_ACQUIRE, "agent");
            xb_add(&bar[XB_XGEN(b.x)], 1u);
            asm volatile("s_waitcnt vmcnt(0)" ::: "memory");
        } else {
            XB_SPIN(xb_ld(&bar[XB_XGEN(b.x)]) == gen, bar);
            __builtin_amdgcn_fence(__ATOMIC_ACQUIRE, "agent");
            asm volatile("s_waitcnt vmcnt(0)" ::: "memory");
        }
    }
    __syncthreads();
}

typedef float f32x16 __attribute__((ext_vector_type(16)));
typedef short bf16x8 __attribute__((ext_vector_type(8)));
constexpr int NSA_KL = 0, NSA_VL = 9216, NSA_SET = 27648  , NSA_IMP = 55296, NSA_SEL = 120832, NSA_FAC = 121856, NSA_VALS = 123904;
__device__ __forceinline__ unsigned cvtpk(float lo, float hi) { typedef float f2_ __attribute__((ext_vector_type(2))); typedef __bf16 b2_ __attribute__((ext_vector_type(2))); const f2_ v = {lo, hi}; return __builtin_bit_cast(unsigned, __builtin_convertvector(v, b2_)); }
__device__ __forceinline__ int crow(int r, int hi) { return (r & 3) + 8 * (r >> 2) + 4 * hi; }
#define CBAR() asm volatile("" ::: "memory")
template <int ND, bool MASK = true>
__device__ __forceinline__ void nsa_tile(const bf16* KL, const bf16* VL, const bf16x8 (&qr)[4], float negM, int klo, int khi, float& lsum, f32x16 (&o)[4], int r32, int hi) {
    f32x16 p0, p1; { float nm = negM; asm volatile("" : "+v"(nm));
#pragma unroll
    for (int r = 0; r < 16; ++r) { p0[r] = nm; p1[r] = nm; } }
    bf16x8 kf[8];
#pragma unroll
    for (int d0 = 0; d0 < 4; ++d0) { kf[2 * d0] = *(const bf16x8*)(KL + r32 * 72 + 16 * d0 + 8 * hi); kf[2 * d0 + 1] = *(const bf16x8*)(KL + (32 + r32) * 72 + 16 * d0 + 8 * hi); }
    CBAR();
#pragma unroll
    for (int d0 = 0; d0 < 4; ++d0) { p0 = __builtin_amdgcn_mfma_f32_32x32x16_bf16(kf[2 * d0], qr[d0], p0, 0, 0, 0); p1 = __builtin_amdgcn_mfma_f32_32x32x16_bf16(kf[2 * d0 + 1], qr[d0], p1, 0, 0, 0); }
    v2u va[4][2];
#pragma unroll
    for (int ks = 0; ks < 4; ++ks) { const bf16* vp = VL + r32 * 72 + 16 * ks + 4 * hi; va[ks][0] = *(const v2u*)vp; va[ks][1] = *(const v2u*)(vp + 8); }
    CBAR();
    const int lo2 = klo - 4 * hi, hi2 = khi - 4 * hi; float ls = 0.f;
#pragma unroll
    for (int r = 0; r < 16; ++r) { const int cr = (r & 3) + 8 * (r >> 2);
        if constexpr (MASK) { p0[r] = (cr > lo2 && cr <= hi2) ? __builtin_amdgcn_exp2f(p0[r]) : 0.f; p1[r] = (cr + 32 > lo2 && cr + 32 <= hi2) ? __builtin_amdgcn_exp2f(p1[r]) : 0.f; }
        else { p0[r] = __builtin_amdgcn_exp2f(p0[r]); p1[r] = __builtin_amdgcn_exp2f(p1[r]); }
        ls += p0[r] + p1[r]; }
    lsum += ls;
    bf16x8 pf[4];
    { v4u w; w.x = cvtpk(p0[0], p0[1]); w.y = cvtpk(p0[2], p0[3]); w.z = cvtpk(p0[4], p0[5]); w.w = cvtpk(p0[6], p0[7]); pf[0] = __builtin_bit_cast(bf16x8, w);
      w.x = cvtpk(p0[8], p0[9]); w.y = cvtpk(p0[10], p0[11]); w.z = cvtpk(p0[12], p0[13]); w.w = cvtpk(p0[14], p0[15]); pf[1] = __builtin_bit_cast(bf16x8, w);
      w.x = cvtpk(p1[0], p1[1]); w.y = cvtpk(p1[2], p1[3]); w.z = cvtpk(p1[4], p1[5]); w.w = cvtpk(p1[6], p1[7]); pf[2] = __builtin_bit_cast(bf16x8, w);
      w.x = cvtpk(p1[8], p1[9]); w.y = cvtpk(p1[10], p1[11]); w.z = cvtpk(p1[12], p1[13]); w.w = cvtpk(p1[14], p1[15]); pf[3] = __builtin_bit_cast(bf16x8, w); }
#pragma unroll
    for (int d0 = 0; d0 < ND; ++d0) {
        v2u vb[4][2];
        if (d0 + 1 < ND) {
#pragma unroll
            for (int ks = 0; ks < 4; ++ks) { const bf16* vp = VL + (32 * (d0 + 1) + r32) * 72 + 16 * ks + 4 * hi; vb[ks][0] = *(const v2u*)vp; vb[ks][1] = *(const v2u*)(vp + 8); }
            CBAR();
        }
#pragma unroll
        for (int ks = 0; ks < 4; ++ks) { const v4u w = (v4u){va[ks][0].x, va[ks][0].y, va[ks][1].x, va[ks][1].y}; o[d0] = __builtin_amdgcn_mfma_f32_32x32x16_bf16(pf[ks], __builtin_bit_cast(bf16x8, w), o[d0], 0, 0, 0); }
        if (d0 + 1 < ND) {
#pragma unroll
            for (int ks = 0; ks < 4; ++ks) { va[ks][0] = vb[ks][0]; va[ks][1] = vb[ks][1]; }
        }
    }
}
__device__ __forceinline__ void nsa_unit(const Params& P, unsigned char* lds, int bg, int qi, int tid, int lane, int wave, float negMc, float negMs, float negMw) {
    asm volatile("" : "+v"(lane), "+v"(tid));
    unsigned char* ws = P.ws; const int b = bg >> 2, g = bg & 3, r32 = lane & 31, hi = lane >> 5, head = wave >> 1, half = wave & 1;
    const int tq = 64 * qi + 32 * half + r32;
    bf16* KL = (bf16*)(lds + NSA_KL); bf16* VL = (bf16*)(lds + NSA_VL); float* IMP = (float*)(lds + NSA_IMP); unsigned long long* SEL = (unsigned long long*)(lds + NSA_SEL);
    float* FAC = (float*)(lds + NSA_FAC) + wave * 64; float* VALS = (float*)(lds + NSA_VALS) + wave * 64;
    const bf16* PA = (const bf16*)(ws + O_PA); const size_t rowq = (size_t)b * SEQ + tq;
    bf16x8 qr[4]; { const bf16* qp = PA + rowq * NA + PA_Q + (g * 4 + head) * 64 + 8 * hi;
#pragma unroll
        for (int d0 = 0; d0 < 4; ++d0) qr[d0] = *(const bf16x8*)(qp + 16 * d0); }
    const int ldr = tid >> 3, ldc8 = (tid & 7) * 8;
    float* OSW = (float*)(lds + NSA_IMP) + wave * 2048;
#define OSWI(q_, blk_) (((blk_) * 32 + r32) * 32 + ((q_) ^ r32))
    f32x16 o[4];
    __syncthreads();
    if (tid == 0) SEL[64] = 0ull;
    bf16* KL1 = (bf16*)(lds + NSA_SET + NSA_KL); bf16* VL1 = (bf16*)(lds + NSA_SET + NSA_VL);
    const int so = ldr * 72 + ldc8;
#define NSA_LBAR() asm volatile("s_waitcnt lgkmcnt(0)\n\ts_barrier" ::: "memory")
#define NSA_LOAD(n, kr, vr) do { if ((n) >= 0) { kr = *(const v4u*)(KSRC(n)); vr = *(const v4u*)(VSRC(n)); } } while (0)
#define NSA_STAGE(na, nb, ka, va, kb, vb) do { NSA_LBAR(); *(v4u*)(KL + so) = ka; *(v4u*)(VL + so) = va; if ((nb) >= 0) { *(v4u*)(KL1 + so) = kb; *(v4u*)(VL1 + so) = vb; } EXTRA(na, nb); NSA_LBAR(); } while (0)
#define NSA_PIPE() do { int a0, b0, a1, b1; v4u k0a, v0a, k0b, v0b, k1a, v1a, k1b, v1b; k0a = v0a = k0b = v0b = k1a = v1a = k1b = v1b = (v4u){0u, 0u, 0u, 0u}; \
        POPN(a0); POPN(b0); POPN(a1); POPN(b1); NSA_LOAD(a0, k0a, v0a); NSA_LOAD(b0, k0b, v0b); NSA_LOAD(a1, k1a, v1a); NSA_LOAD(b1, k1b, v1b); \
        while (a0 >= 0) { \
            NSA_STAGE(a0, b0, k0a, v0a, k0b, v0b); \
            { const int ca = a0, cb = b0; POPN(a0); POPN(b0); NSA_LOAD(a0, k0a, v0a); NSA_LOAD(b0, k0b, v0b); TILE(KL, VL, ca); if (cb >= 0) TILE(KL1, VL1, cb); } \
            if (a1 < 0) break; \
            NSA_STAGE(a1, b1, k1a, v1a, k1b, v1b); \
            { const int ca = a1, cb = b1; POPN(a1); POPN(b1); NSA_LOAD(a1, k1a, v1a); NSA_LOAD(b1, k1b, v1b); TILE(KL, VL, ca); if (cb >= 0) TILE(KL1, VL1, cb); } \
        } } while (0)
    {
#pragma unroll
        for (int d0 = 0; d0 < 4; ++d0)
#pragma unroll
            for (int r = 0; r < 16; ++r) o[d0][r] = 0.f;
        const bf16* Kc = (const bf16*)(ws + O_KCB) + (size_t)bg * 256 * 64 + (size_t)ldr * 64 + ldc8; const bf16* Vc = (const bf16*)(ws + O_VCT) + (size_t)bg * 64 * 256 + (size_t)ldr * 256 + ldc8;
        const int ntile = ((4 * qi + 2) >> 6) + 1; const int cmaxq = (tq >= 31) ? ((tq - 31) >> 4) : -1; float lsum = 0.f; int tl = 0;
#define POPN(n) do { n = (tl < ntile) ? tl : -1; ++tl; } while (0)
#define KSRC(n) (Kc + (size_t)64 * (n) * 64)
#define VSRC(n) (Vc + 64 * (n))
#define OVROW(dst, n) do { const int cb_ = 64 * (n) + ldc8, lo_ = 4 * ldr - 1, hi_ = (4 * ldr + 3 < 254) ? 4 * ldr + 3 : 254; v4u w_; \
            w_.x = (((cb_ + 0) >= lo_ && (cb_ + 0) <= hi_) ? 0x3F80u : 0u) | (((cb_ + 1) >= lo_ && (cb_ + 1) <= hi_) ? 0x3F800000u : 0u); w_.y = (((cb_ + 2) >= lo_ && (cb_ + 2) <= hi_) ? 0x3F80u : 0u) | (((cb_ + 3) >= lo_ && (cb_ + 3) <= hi_) ? 0x3F800000u : 0u); \
            w_.z = (((cb_ + 4) >= lo_ && (cb_ + 4) <= hi_) ? 0x3F80u : 0u) | (((cb_ + 5) >= lo_ && (cb_ + 5) <= hi_) ? 0x3F800000u : 0u); w_.w = (((cb_ + 6) >= lo_ && (cb_ + 6) <= hi_) ? 0x3F80u : 0u) | (((cb_ + 7) >= lo_ && (cb_ + 7) <= hi_) ? 0x3F800000u : 0u); \
            *(v4u*)((dst) + (64 + ldr) * 72 + ldc8) = w_; } while (0)
#define EXTRA(na, nb) do { OVROW(VL, na); if ((nb) >= 0) OVROW(VL1, nb); } while (0)
#define TILE(K_, V_, n) nsa_tile<4, true>(K_, V_, qr, negMc, -1, cmaxq - 64 * (n), lsum, o, r32, hi)
        NSA_PIPE();
#undef POPN
#undef KSRC
#undef VSRC
#undef EXTRA
#undef TILE
        lsum += __shfl_xor(lsum, 32); const float inv = lsum > 0.f ? 1.f / lsum : 0.f;
        if (hi == 0) { FAC[r32] = inv * sigmf(((const float*)(ws + O_SM))[rowq * 64 + (g * 4 + head) * 3 + 0]); FAC[32 + r32] = inv; }
        WSYNC();
#pragma unroll
        for (int r = 0; r < 16; ++r) { const int q = crow(r, hi); const float f = FAC[q], f2 = FAC[32 + q];
            o[0][r] *= f; o[1][r] *= f;
            float* ip = IMP + ((size_t)head * 64 + 32 * half + q) * 64 + r32; ip[0] = o[2][r] * f2; ip[32] = o[3][r] * f2; }
        __syncthreads();
#pragma unroll 1
        for (int tk = 0; tk < 8; ++tk) { const int tok = 8 * wave + tk; const float* ip = IMP + (size_t)tok * 64 + lane;
            const float impv = ip[0] + ip[4096] + ip[8192] + ip[12288];
            const float val = (lane == 0 || lane == qi || lane == qi - 1) ? 1e4f : ((lane <= qi) ? impv : -1.f);
            const unsigned ub = __float_as_uint(val); const unsigned key = (ub & 0x80000000u) ? ~ub : (ub | 0x80000000u);
            unsigned thr = 0u;
#pragma unroll
            for (int bit = 31; bit >= 0; --bit) { const unsigned cand = thr | (1u << bit); if (__popcll(__ballot(key >= cand)) >= 16) thr = cand; }
            const unsigned long long gtm = __ballot(key > thr), eqm = __ballot(key == thr); const int need = 16 - __popcll(gtm);
            const int below = __popcll(eqm & ((1ull << lane) - 1ull));
            const bool sel = (key > thr) || (key == thr && below < need);
            const unsigned long long mask = __ballot(sel && lane <= qi);
            if (lane == 0) { SEL[tok] = mask; atomicOr(&SEL[64], mask); } }
        __syncthreads();
#pragma unroll
        for (int r = 0; r < 16; ++r) { const int q = crow(r, hi); OSW[OSWI(q, 0)] = o[0][r]; OSW[OSWI(q, 1)] = o[1][r]; }
    }
#define EXTRA(na, nb) do { } while (0)
    {
        const unsigned long long mysel = SEL[32 * half + r32]; unsigned long long om = SEL[64];
#pragma unroll
        for (int d0 = 0; d0 < 2; ++d0)
#pragma unroll
            for (int r = 0; r < 16; ++r) o[d0][r] = 0.f;
        const bf16* Ks = PA + (size_t)b * SEQ * NA + PA_KV + 2 * 256 + g * 64 + (size_t)ldr * NA + ldc8; const bf16* Vs = (const bf16*)(ws + O_VTS) + (size_t)bg * 64 * SEQ + (size_t)ldr * 64 + ldc8; float lsum = 0.f;
#define POPN(n) do { if (om) { n = __builtin_ctzll(om); om &= om - 1; } else n = -1; } while (0)
#define KSRC(n) (Ks + (size_t)64 * (n) * NA)
#define VSRC(n) (Vs + (size_t)4096 * (n))
#define TILE(K_, V_, n) do { const bool selb = (mysel >> (n)) & 1ull; \
            if ((n) == qi) nsa_tile<2, true>(K_, V_, qr, negMs, -1, tq - 64 * (n), lsum, o, r32, hi);        \
            else if (__any(selb)) nsa_tile<2, false>(K_, V_, qr, selb ? negMs : -1e30f, 0, 0, lsum, o, r32, hi); } while (0)
        NSA_PIPE();
#undef POPN
#undef KSRC
#undef VSRC
#undef TILE
        lsum += __shfl_xor(lsum, 32); const float inv = lsum > 0.f ? 1.f / lsum : 0.f;
        WSYNC(); if (hi == 0) FAC[r32] = inv * sigmf(((const float*)(ws + O_SM))[rowq * 64 + (g * 4 + head) * 3 + 1]); WSYNC();
        { f32x4 f4[4]; float t0[16], t1[16];
#pragma unroll
          for (int k = 0; k < 4; ++k) f4[k] = *(const f32x4*)(FAC + 8 * k + 4 * hi);
#pragma unroll
          for (int r = 0; r < 16; ++r) { const int q = crow(r, hi); t0[r] = OSW[OSWI(q, 0)]; t1[r] = OSW[OSWI(q, 1)]; }
          asm volatile("" ::: "memory");
#pragma unroll
          for (int r = 0; r < 16; ++r) { const int q = crow(r, hi); const float f = f4[r >> 2][r & 3]; OSW[OSWI(q, 0)] = t0[r] + o[0][r] * f; OSW[OSWI(q, 1)] = t1[r] + o[1][r] * f; } }
    }
    {
#pragma unroll
        for (int d0 = 0; d0 < 2; ++d0)
#pragma unroll
            for (int r = 0; r < 16; ++r) o[d0][r] = 0.f;
        const bf16* Kw = PA + (size_t)b * SEQ * NA + PA_KV + 4 * 256 + g * 64 + (size_t)ldr * NA + ldc8; const bf16* Vw = (const bf16*)(ws + O_VTW) + (size_t)bg * 64 * SEQ + (size_t)ldr * 64 + ldc8; float lsum = 0.f;
        int wn = qi >= 8 ? qi - 8 : 0;
#define POPN(n) do { n = (wn <= qi) ? wn : -1; ++wn; } while (0)
#define KSRC(n) (Kw + (size_t)64 * (n) * NA)
#define VSRC(n) (Vw + (size_t)4096 * (n))
#define TILE(K_, V_, n) do { if ((n) == qi || (n) == qi - 8) nsa_tile<2, true>(K_, V_, qr, negMw, tq - 512 - 64 * (n), tq - 64 * (n), lsum, o, r32, hi); \
            else nsa_tile<2, false>(K_, V_, qr, negMw, 0, 0, lsum, o, r32, hi); } while (0)
        NSA_PIPE();
#undef POPN
#undef KSRC
#undef VSRC
#undef TILE
        lsum += __shfl_xor(lsum, 32); const float inv = lsum > 0.f ? 1.f / lsum : 0.f;
        WSYNC(); if (hi == 0) FAC[r32] = inv * sigmf(((const float*)(ws + O_SM))[rowq * 64 + (g * 4 + head) * 3 + 2]); WSYNC();
        { f32x4 f4[4]; float t0[16], t1[16];
#pragma unroll
          for (int k = 0; k < 4; ++k) f4[k] = *(const f32x4*)(FAC + 8 * k + 4 * hi);
#pragma unroll
          for (int r = 0; r < 16; ++r) { const int q = crow(r, hi); t0[r] = OSW[OSWI(q, 0)]; t1[r] = OSW[OSWI(q, 1)]; }
          asm volatile("" ::: "memory");
#pragma unroll
          for (int r = 0; r < 16; ++r) { const int q = crow(r, hi); const float f = f4[r >> 2][r & 3]; OSW[OSWI(q, 0)] = t0[r] + o[0][r] * f; OSW[OSWI(q, 1)] = t1[r] + o[1][r] * f; } }
    }
#undef EXTRA
    { WSYNC(); const int q = lane >> 1, dh = lane & 1; float v[32];
#pragma unroll
      for (int j = 0; j < 32; ++j) v[j] = OSW[(32 * dh + j) * 32 + (q ^ j)];
      bf16* op = (bf16*)(ws + O_ONSA) + ((size_t)b * SEQ + 64 * qi + 32 * half + q) * 1024 + (g * 4 + head) * 64 + 32 * dh;
#pragma unroll
      for (int k = 0; k < 4; ++k) { v4u w; w.x = cvtpk(v[8 * k], v[8 * k + 1]); w.y = cvtpk(v[8 * k + 2], v[8 * k + 3]); w.z = cvtpk(v[8 * k + 4], v[8 * k + 5]); w.w = cvtpk(v[8 * k + 6], v[8 * k + 7]); *(v4u*)(op + 8 * k) = w; }
      WSYNC(); }
#undef OSWI
}
__device__ __forceinline__ void hm_item4(const Params& P, int it0, int lane) {
    unsigned char* ws = P.ws; f32x4 hc[4]; v2u mo[4];
#pragma unroll
    for (int k = 0; k < 4; ++k) { const int it = it0 + k, row = it >> 2, h = it & 3;
        { const v2u hw = *(const v2u*)((const bf16*)(ws + O_HC) + (size_t)row * 1024 + h * 256 + 4 * lane); hc[k] = (f32x4){lo16(hw.x), hi16(hw.x), lo16(hw.y), hi16(hw.y)}; }
        mo[k] = *(const v2u*)((const bf16*)(ws + O_PA) + (size_t)row * NA + PA_MO + h * 256 + 4 * lane); }
#pragma unroll
    for (int k = 0; k < 4; ++k) { const int it = it0 + k, row = it >> 2, h = it & 3;
        const float ss = wave_sum(hc[k].x * hc[k].x + hc[k].y * hc[k].y + hc[k].z * hc[k].z + hc[k].w * hc[k].w); const float rstd = rsqrtf(ss * (1.f / 256.f) + EPS);
        v2u o; o.x = pk2(sigmf(lo16(mo[k].x)) * hc[k].x * rstd, sigmf(hi16(mo[k].x)) * hc[k].y * rstd); o.y = pk2(sigmf(lo16(mo[k].y)) * hc[k].z * rstd, sigmf(hi16(mo[k].y)) * hc[k].w * rstd);
        *(v2u*)((bf16*)(ws + O_HM) + (size_t)row * 1024 + h * 256 + 4 * lane) = o; }
}

constexpr int N_PHASES = 16;
__global__ void __launch_bounds__(NT, 2) mk_fwd(Params P) {
    extern __shared__ __attribute__((aligned(16))) unsigned char lds[];
    cg::grid_group grid = cg::this_grid();
    const int G = gridDim.x, bx = blockIdx.x, ngw = G * NWV;
#define TIDS() int tid = threadIdx.x; asm volatile("" : "+v"(tid)); const int lane = tid & 63, wave = __builtin_amdgcn_readfirstlane(tid >> 6), gw = bx * NWV + wave; (void)gw; (void)lane
    unsigned char* ws = P.ws; const int lo = P.ph_lo, hi = P.ph_hi;
    PG8_LAS unsigned char* lds3 = (PG8_LAS unsigned char*)lds;
#define IN(k) (lo <= (k) && (k) < hi)
    const bool multi = (hi - lo) > 1;
    volatile LAS unsigned* bst = (volatile LAS unsigned*)((LAS unsigned char*)lds + (LDS_BYTES - 64));
    XcdBarrier xbar; xbar.bar = (unsigned*)ws; xbar.x = 0; xbar.st = bst;
    if (multi) { if (threadIdx.x < 2) bst[threadIdx.x] = 0u; __syncthreads(); xbar = xcd_barrier_post((unsigned*)ws, bst); }
#define SEAM(k) do { if (IN(k) && IN((k) + 1)) { if ((k) == 0) grid.sync(); else xcd_barrier(xbar); } } while (0)
#define GEMMC(EPI, Aoff, Boff, MM, NN, KK, E, CID) do { pg8::Gemm g_{(const pg8::bf16_t*)(ws + (Aoff)), (const pg8::bf16_t*)(ws + (Boff)), (MM), (NN), (KK)}; pg8::StaticOrder S_; S_.init((MM), (NN), G, (CID)); \
        pg8::gemm_phase<EPI, pg8::StaticOrder, true, true>(lds3, g_, S_, (E)); } while (0)
#define GEMMNA(EPI, Aoff, Boff, MM, NN, KK, E) do { pg8::Gemm g_{(const pg8::bf16_t*)(ws + (Aoff)), (const pg8::bf16_t*)(ws + (Boff)), (MM), (NN), (KK)}; pg8::StaticOrder S_; S_.init((MM), (NN), G, bx); \
        pg8::gemm_phase<EPI, pg8::StaticOrder, false, true>(lds3, g_, S_, (E)); } while (0)
#define GEMM(EPI, Aoff, Boff, MM, NN, KK, E) do { pg8::Gemm g_{(const pg8::bf16_t*)(ws + (Aoff)), (const pg8::bf16_t*)(ws + (Boff)), (MM), (NN), (KK)}; pg8::StaticOrder S_; S_.init((MM), (NN), G, bx); \
        pg8::gemm_phase<EPI, pg8::StaticOrder, true, true>(lds3, g_, S_, (E)); } while (0)
    ScanState sst;
    const bool scanwg = (bx >= 32 && bx < 64 && G >= 64);
    if (IN(0)) { TIDS(); phase_prologue(P, lds, gw, ngw, wave, lane, tid); } SEAM(0);
    if (IN(1)) { pg8::EpiP<0> E{(pg8::bf16_t*)(ws + O_H), FF, nullptr, nullptr, 0, nullptr}; GEMM(pg8::EpiP<0>, O_XN, O_WGU, TOK, 2 * FF, DM, E); } SEAM(1);
    if (IN(2)) { pg8::EpiResid E{P.in[0], P.out, DM, 0.5f}; GEMMNA(pg8::EpiResid, O_H, O_WD, TOK, DM, FF, E); } SEAM(2);
    if (IN(3)) { TIDS(); phase_norm(P.out, (bf16*)(ws + O_XN), gw, ngw, lane); } SEAM(3);
    if (IN(4)) { pg8::EpiP<1> E{(pg8::bf16_t*)(ws + O_PA), NA, (const float*)(ws + O_BIASA), nullptr, 0, (float*)(ws + O_SM)}; GEMM(pg8::EpiP<1>, O_XN, O_WINA, TOK, NA, DM, E); } SEAM(4);
    if (IN(5)) { TIDS(); phase_prep(P, gw, ngw, lane); } SEAM(5);
    if (IN(6)) {
        { pg8::EpiP<3> E{(pg8::bf16_t*)(ws + O_CHK), 256, nullptr, nullptr, 0, nullptr}; GEMM(pg8::EpiP<3>, O_CBK, O_WC1K, 4096, 256, 2048, E); }
        { pg8::EpiP<3> E{(pg8::bf16_t*)(ws + O_CHV), 256, nullptr, nullptr, 0, nullptr}; GEMMC(pg8::EpiP<3>, O_CBV, O_WC1V, 4096, 256, 2048, E, (bx + G - 16) % G); }
        { TIDS(); if (bx < 32 && G >= 32) { const int cid = bx & 15; cmp2_block(P, lds, (cid % 8) * 2 + cid / 8, bx >> 4, tid); }
          unsigned* ictr = (unsigned*)ws + 3502;
          if (scanwg && multi) mlstm_scan_item(P, lds, bx - 32, tid, sst, 0, SCAN_N1);
          else for (;;) { __syncthreads(); if (tid == 0) bst[4] = __hip_atomic_fetch_add(ictr, 1u, __ATOMIC_RELAXED, __HIP_MEMORY_SCOPE_AGENT); __syncthreads();
              const int v = (int)bst[4]; if (v >= 1024) break; mlstm_intra_item(P, lds, (v & 15) * 64 + (v >> 4), tid); } }
    } SEAM(6);
    if (IN(8)) { TIDS();
#define UNI(x) __builtin_bit_cast(float, __builtin_amdgcn_readfirstlane(__builtin_bit_cast(int, (x))))
        const float mq = UNI(wave_max(fabsf(P.in[8][lane]))) * (8.f * 1.4426950408889634f);
        const float negMc = -mq * UNI(wave_max(fabsf(P.in[9][lane]))), negMs = -mq * UNI(wave_max(fabsf(P.in[10][lane]))), negMw = -mq * UNI(wave_max(fabsf(P.in[11][lane])));
#undef UNI
        if (scanwg) mlstm_scan_item(P, lds, bx - 32, tid, sst, multi ? SCAN_N1 : 0, 64);
        unsigned* qctr = (unsigned*)ws + 3500;
        for (;;) { __syncthreads(); if (tid == 0) bst[4] = __hip_atomic_fetch_add(qctr, 1u, __ATOMIC_RELAXED, __HIP_MEMORY_SCOPE_AGENT); __syncthreads();
            const int u = (int)bst[4]; if (u >= 1024) break; nsa_unit(P, lds, u & 15, 63 - (u >> 4), tid, lane, wave, negMc, negMs, negMw); }
    } SEAM(8);
    if (IN(9)) { { TIDS(); for (int it = gw * 4; it < 65536; it += ngw * 4) { hm_item4(P, it, lane); } }
        if (multi) xcd_barrier(xbar);
        pg8::EpiP<2> E{(pg8::bf16_t*)(ws + O_MG), NB, (const float*)(ws + O_BIASB), nullptr, 0, nullptr}; GEMM(pg8::EpiP<2>, O_XN, O_WINB, TOK, NB, DM, E); } SEAM(9);
    if (IN(10)) { pg8::EpiP<4> E{(pg8::bf16_t*)(ws + O_XN), DM, nullptr, (const pg8::bf16_t*)(ws + O_MG), NB, nullptr}; GEMM(pg8::EpiP<4>, O_ONSA, O_WBN, TOK, DM, 1024, E); }
    if (IN(11)) { pg8::EpiP<5> E{(pg8::bf16_t*)(ws + O_XN), DM, nullptr, (const pg8::bf16_t*)(ws + O_MG), NB, nullptr}; GEMM(pg8::EpiP<5>, O_HM, O_WBM, TOK, DM, 1024, E); } SEAM(11);
    if (IN(12)) { pg8::EpiResid E{P.out, P.out, DM, 1.0f}; GEMMNA(pg8::EpiResid, O_XN, O_WOUT, TOK, DM, DM, E); } SEAM(12);
    if (IN(13)) { TIDS(); phase_norm(P.out, (bf16*)(ws + O_XN), gw, ngw, lane); phase_conv_ffn2(P, lds, gw, ngw, wave, lane); } SEAM(13);
    if (IN(14)) { pg8::EpiP<0> E{(pg8::bf16_t*)(ws + O_H), FF, nullptr, nullptr, 0, nullptr}; GEMM(pg8::EpiP<0>, O_XN, O_WGU, TOK, 2 * FF, DM, E); } SEAM(14);
    if (IN(15)) { pg8::EpiResid E{P.out, P.out, DM, 0.5f}; GEMMNA(pg8::EpiResid, O_H, O_WD, TOK, DM, FF, E); }
#undef IN
#undef SEAM
#undef GEMM
#undef GEMMNA
}

#ifndef MK_COOP
#define MK_COOP 0
#endif
extern "C" void kernel_launch(void* const* d_in, const int* in_sizes, int n_in, void* d_out, int out_size, void* d_ws, size_t ws_size, hipStream_t stream) {
    static int grid = 0;
    if (grid == 0) {
        if (n_in != 28 || ws_size < WS_NEED) { fprintf(stderr, "kernel_launch: unexpected n_in %d / ws_size %zu\n", n_in, ws_size); grid = -1; return; }
        int dev = 0, cus = 0, per_cu = 0;
        hipGetDevice(&dev); hipDeviceGetAttribute(&cus, hipDeviceAttributeMultiprocessorCount, dev);
        hipFuncSetAttribute((const void*)mk_fwd, hipFuncAttributeMaxDynamicSharedMemorySize, LDS_BYTES);
        hipOccupancyMaxActiveBlocksPerMultiprocessor(&per_cu, (const void*)mk_fwd, NT, LDS_BYTES);
        (void)hipGetLastError();
        if (per_cu < 1) per_cu = 1;
        grid = cus * 1;
        if (grid < 8) grid = 256;
    }
    if (grid < 0) return;
    Params p{};
    for (int i = 0; i < 28; ++i) p.in[i] = (const float*)d_in[i];
    p.out = (float*)d_out; p.ws = (unsigned char*)d_ws;
    if (hipMemsetAsync(d_ws, 0, 16384, stream) != hipSuccess) fprintf(stderr, "memset failed\n");
#if MK_COOP
    p.ph_lo = 0; p.ph_hi = N_PHASES;
    void* args[] = {&p};
    hipError_t e = hipLaunchCooperativeKernel((const void*)mk_fwd, dim3(grid), dim3(NT), args, LDS_BYTES, stream);
    if (e != hipSuccess) fprintf(stderr, "cooperative launch failed: %s (grid %d)\n", hipGetErrorString(e), grid);
#else
    for (int k = 0; k < N_PHASES; ++k) { p.ph_lo = k; p.ph_hi = k + 1; hipLaunchKernelGGL(mk_fwd, dim3(grid), dim3(NT), LDS_BYTES, stream, p); }
#endif
}
```
